# Optimizing an MI355X kernel written in HIP

```python
import math
import jax, jax.numpy as jnp
from jax import lax
import numpy as np

D_MODEL = 1024
BATCH = 8
SEQ = 8192
DEPTH = 2

N_MIXERS = 4
GROUP_WIDTH = D_MODEL // N_MIXERS
MIX_WIDTH = N_MIXERS * GROUP_WIDTH
HEAD_DIM = 64
N_HEADS = GROUP_WIDTH // HEAD_DIM
IN_WIDTH = 11 * GROUP_WIDTH
SHORT_CONV_WIDTH = 3
CONFORMER_CONV_WIDTH = 31
SB_Q_BLOCK = 128
MOBA_BLOCK = 256
MOBA_TOPK = 3
MOBA_Q_CHUNK = 64
ROPE_THETA = 10000.0
D_FF = 4 * D_MODEL
EPS = 1e-6

kernel_name = 'hybrid_parallel_groups_sb_moba_conv'


def rms_norm(x, g):
    xf = x.astype(jnp.float32)
    y = xf * lax.rsqrt(jnp.mean(xf * xf, axis=-1, keepdims=True) + EPS)
    return (y * g.astype(jnp.float32)).astype(x.dtype)


def layer_norm(x, g, b):
    xf = x.astype(jnp.float32)
    mu = jnp.mean(xf, axis=-1, keepdims=True)
    var = jnp.mean(jnp.square(xf - mu), axis=-1, keepdims=True)
    y = (xf - mu) * lax.rsqrt(var + EPS)
    return (y * g.astype(jnp.float32) + b.astype(jnp.float32)).astype(x.dtype)


def causal_depthwise_conv(x, w):
    k = w.shape[0]
    ch = x.shape[-1]
    return lax.conv_general_dilated(
        x, w.astype(x.dtype)[:, None, :], window_strides=(1,), padding=[(k - 1, 0)],
        dimension_numbers=('NWC', 'WIO', 'NWC'), feature_group_count=ch)


def to_heads(t):
    b, s, _ = t.shape
    return t.reshape(b, s, N_HEADS, HEAD_DIM).transpose(0, 2, 1, 3)


def from_heads(t):
    b, h, s, d = t.shape
    return t.transpose(0, 2, 1, 3).reshape(b, s, h * d)


def apply_rope(t, positions):
    half = HEAD_DIM // 2
    inv_freq = jnp.exp(-math.log(ROPE_THETA) * jnp.arange(half, dtype=jnp.float32) / half)
    ang = positions.astype(jnp.float32)[:, None, :, None] * inv_freq
    cos, sin = jnp.cos(ang), jnp.sin(ang)
    tf = t.astype(jnp.float32)
    t1, t2 = tf[..., :half], tf[..., half:]
    return jnp.concatenate([t1 * cos - t2 * sin, t2 * cos + t1 * sin], axis=-1).astype(t.dtype)


def stick_breaking_attention(q, k, v):
    b, h, s, d = q.shape
    nq = s // SB_Q_BLOCK
    scale = 1.0 / math.sqrt(d)
    q_blocks = q.reshape(b, h, nq, SB_Q_BLOCK, d).transpose(2, 0, 1, 3, 4)
    starts = jnp.arange(nq, dtype=jnp.int32) * SB_Q_BLOCK
    kf = k.astype(jnp.float32)
    vf = v.astype(jnp.float32)
    kpos = jnp.arange(s, dtype=jnp.int32)

    def block(args):
        qi, start = args
        z = jnp.einsum('bhqd,bhkd->bhqk', qi.astype(jnp.float32), kf) * scale
        qpos = start + jnp.arange(SB_Q_BLOCK, dtype=jnp.int32)
        mask = kpos[None, :] < qpos[:, None]
        log_1mb = jnp.where(mask, jax.nn.log_sigmoid(-z), 0.0)
        suffix = lax.cumsum(log_1mb, axis=3, reverse=True) - log_1mb
        a = jnp.where(mask, jnp.exp(jax.nn.log_sigmoid(z) + suffix), 0.0)
        return jnp.einsum('bhqk,bhkd->bhqd', a, vf)

    out = lax.map(block, (q_blocks, starts))
    return out.transpose(1, 2, 0, 3, 4).reshape(b, h, s, d).astype(q.dtype)


def moba_attention(q, k, v):
    b, h, s, d = q.shape
    nb = -(-s // MOBA_BLOCK)
    pad = nb * MOBA_BLOCK - s
    kp = jnp.pad(k, ((0, 0), (0, 0), (0, pad), (0, 0)))
    vp = jnp.pad(v, ((0, 0), (0, 0), (0, pad), (0, 0)))
    k_blocks = kp.reshape(b, h, nb, MOBA_BLOCK, d)
    v_blocks = vp.reshape(b, h, nb, MOBA_BLOCK, d)
    k_mean = jnp.mean(k_blocks.astype(jnp.float32), axis=3)
    topk = min(MOBA_TOPK, nb)
    scale = 1.0 / math.sqrt(d)
    nq = s // MOBA_Q_CHUNK
    q_chunks = q.reshape(b, h, nq, MOBA_Q_CHUNK, d).transpose(2, 0, 1, 3, 4)
    starts = jnp.arange(nq, dtype=jnp.int32) * MOBA_Q_CHUNK
    bidx = jnp.arange(b)[:, None, None, None]
    hidx = jnp.arange(h)[None, :, None, None]
    block_ids = jnp.arange(nb, dtype=jnp.int32)

    def chunk(args):
        qi, start = args
        qf = qi.astype(jnp.float32)
        own = start // MOBA_BLOCK
        gate = jnp.einsum('bhqd,bhnd->bhqn', qf, k_mean)
        gate = jnp.where(block_ids < own, gate, -jnp.inf)
        _, idx = lax.top_k(gate, topk)
        sel_valid = jnp.arange(topk, dtype=jnp.int32) < own
        kg = k_blocks[bidx, hidx, idx].astype(jnp.float32)
        vg = v_blocks[bidx, hidx, idx].astype(jnp.float32)
        s_sel = jnp.einsum('bhqd,bhqnkd->bhqnk', qf, kg) * scale
        s_sel = jnp.where(sel_valid[:, None], s_sel, -jnp.inf)
        s_sel = s_sel.reshape(b, h, MOBA_Q_CHUNK, topk * MOBA_BLOCK)
        k_own = lax.dynamic_slice_in_dim(kp, own * MOBA_BLOCK, MOBA_BLOCK, axis=2).astype(jnp.float32)
        v_own = lax.dynamic_slice_in_dim(vp, own * MOBA_BLOCK, MOBA_BLOCK, axis=2).astype(jnp.float32)
        s_own = jnp.einsum('bhqd,bhkd->bhqk', qf, k_own) * scale
        qpos = start + jnp.arange(MOBA_Q_CHUNK, dtype=jnp.int32)
        kpos = own * MOBA_BLOCK + jnp.arange(MOBA_BLOCK, dtype=jnp.int32)
        s_own = jnp.where(kpos[None, :] <= qpos[:, None], s_own, -jnp.inf)
        p = jax.nn.softmax(jnp.concatenate([s_sel, s_own], axis=-1), axis=-1)
        p_sel, p_own = p[..., :topk * MOBA_BLOCK], p[..., topk * MOBA_BLOCK:]
        vg = vg.reshape(b, h, MOBA_Q_CHUNK, topk * MOBA_BLOCK, d)
        return (jnp.einsum('bhqm,bhqmd->bhqd', p_sel, vg)
                + jnp.einsum('bhqk,bhkd->bhqd', p_own, v_own))

    out = lax.map(chunk, (q_chunks, starts))
    return out.transpose(1, 2, 0, 3, 4).reshape(b, h, s, d).astype(q.dtype)


def qk_norm(t, g):
    return rms_norm(t, g)


def hybrid_layer(x, c_act, positions, w_ada, b_ada, g_norm1, w_in, w_sconv, w_cconv, b_cconv,
                 g_cln, b_cln, g_q, g_k, w_out, g_norm2, w_mlp1, w_mlp2):
    G = GROUP_WIDTH
    mod = (c_act @ w_ada + b_ada)[:, None, :]
    shift1, scale1, gate1, shift2, scale2, gate2 = jnp.split(mod, 6, axis=-1)

    hcur = rms_norm(x, g_norm1) * (1.0 + scale1) + shift1
    proj = hcur @ w_in
    sc_b, sc_c, sc_h = proj[..., 0:G], proj[..., G:2 * G], proj[..., 2 * G:3 * G]
    sb_q, sb_k, sb_v = proj[..., 3 * G:4 * G], proj[..., 4 * G:5 * G], proj[..., 5 * G:6 * G]
    mb_q, mb_k, mb_v = proj[..., 6 * G:7 * G], proj[..., 7 * G:8 * G], proj[..., 8 * G:9 * G]
    cf_a, cf_g = proj[..., 9 * G:10 * G], proj[..., 10 * G:11 * G]

    y_a = sc_b * causal_depthwise_conv(sc_c * sc_h, w_sconv)
    y_b = from_heads(stick_breaking_attention(to_heads(sb_q), to_heads(sb_k), to_heads(sb_v)))
    q = apply_rope(qk_norm(to_heads(mb_q), g_q), positions)
    k = apply_rope(qk_norm(to_heads(mb_k), g_k), positions)
    y_c = from_heads(moba_attention(q, k, to_heads(mb_v)))
    u = cf_a * jax.nn.sigmoid(cf_g)
    u = causal_depthwise_conv(u, w_cconv) + b_cconv
    y_d = jax.nn.silu(layer_norm(u, g_cln, b_cln))

    mix = jnp.concatenate([y_a, y_b, y_c, y_d], axis=-1) @ w_out
    x = x + gate1 * mix

    h2 = rms_norm(x, g_norm2) * (1.0 + scale2) + shift2
    f = jnp.square(jax.nn.relu(h2 @ w_mlp1)) @ w_mlp2
    return x + gate2 * f


def setup_inputs(seed: int = 0) -> dict:
    key = jax.random.key(seed)
    ks = jax.random.split(key, 18)
    nrm = jax.random.normal
    f32 = jnp.float32
    G = GROUP_WIDTH
    x = nrm(ks[0], (BATCH, SEQ, D_MODEL), f32)
    c = nrm(ks[1], (BATCH, D_MODEL), f32)
    offsets = jax.random.randint(ks[2], (BATCH, 1), 0, 4096, dtype=jnp.int32)
    positions = (offsets + jnp.arange(SEQ, dtype=jnp.int32)[None, :]).astype(jnp.int32)
    w_ada = nrm(ks[3], (DEPTH, D_MODEL, 6 * D_MODEL), f32) * (0.5 * D_MODEL ** -0.5)
    b_ada = 0.02 * nrm(ks[4], (DEPTH, 6 * D_MODEL), f32)
    g_norm1 = 1.0 + 0.05 * nrm(ks[5], (DEPTH, D_MODEL), f32)
    w_in = nrm(ks[6], (DEPTH, D_MODEL, IN_WIDTH), f32) * D_MODEL ** -0.5
    w_sconv = nrm(ks[7], (DEPTH, SHORT_CONV_WIDTH, G), f32) * SHORT_CONV_WIDTH ** -0.5
    w_cconv = nrm(ks[8], (DEPTH, CONFORMER_CONV_WIDTH, G), f32) * CONFORMER_CONV_WIDTH ** -0.5
    b_cconv = 0.02 * nrm(ks[9], (DEPTH, G), f32)
    g_cln = 1.0 + 0.05 * nrm(ks[10], (DEPTH, G), f32)
    b_cln = 0.02 * nrm(ks[11], (DEPTH, G), f32)
    g_q = 1.0 + 0.05 * nrm(ks[12], (DEPTH, HEAD_DIM), f32)
    g_k = 1.0 + 0.05 * nrm(ks[13], (DEPTH, HEAD_DIM), f32)
    w_out = nrm(ks[14], (DEPTH, MIX_WIDTH, D_MODEL), f32) * MIX_WIDTH ** -0.5
    g_norm2 = 1.0 + 0.05 * nrm(ks[15], (DEPTH, D_MODEL), f32)
    w_mlp1 = nrm(ks[16], (DEPTH, D_MODEL, D_FF), f32) * D_MODEL ** -0.5
    w_mlp2 = nrm(ks[17], (DEPTH, D_FF, D_MODEL), f32) * D_FF ** -0.5
    return {'x': x, 'c': c, 'positions': positions, 'w_ada': w_ada, 'b_ada': b_ada,
            'g_norm1': g_norm1, 'w_in': w_in, 'w_sconv': w_sconv, 'w_cconv': w_cconv,
            'b_cconv': b_cconv, 'g_cln': g_cln, 'b_cln': b_cln, 'g_q': g_q, 'g_k': g_k,
            'w_out': w_out, 'g_norm2': g_norm2, 'w_mlp1': w_mlp1, 'w_mlp2': w_mlp2}


def reference(x, c, positions, w_ada, b_ada, g_norm1, w_in, w_sconv, w_cconv, b_cconv,
              g_cln, b_cln, g_q, g_k, w_out, g_norm2, w_mlp1, w_mlp2):
    c_act = jax.nn.silu(c)
    for l in range(DEPTH):
        x = hybrid_layer(x, c_act, positions, w_ada[l], b_ada[l], g_norm1[l], w_in[l],
                         w_sconv[l], w_cconv[l], b_cconv[l], g_cln[l], b_cln[l],
                         g_q[l], g_k[l], w_out[l], g_norm2[l], w_mlp1[l], w_mlp2[l])
    return x
```

```cpp
#include <hip/hip_runtime.h>
#include <hip/hip_cooperative_groups.h>
#include <cstdio>
#include <cstdint>
namespace cg = cooperative_groups;
namespace pg8 {
#define PG8_LAS __attribute__((address_space(3)))
typedef unsigned short bf16_t;
typedef short bf16x8 __attribute__((ext_vector_type(8)));
typedef float f32x4 __attribute__((ext_vector_type(4)));
typedef unsigned u32x4 __attribute__((ext_vector_type(4)));
constexpr int BM = 256, BK = 64, HALF = 128, HTB = HALF * BK * 2  , STAGE_BYTES = 8 * HTB, NXCD = 8, WGM = 8;

__host__ __device__ __forceinline__ int lds_byte(int r, int c) { const int st = (r >> 4) * 2 + (c >> 5), rr = r & 15, cc = c & 31, ob = rr * 64 + cc * 2; return st * 1024 + (ob ^ (((ob >> 9) & 1) << 5)); }
__host__ __device__ __forceinline__ void stage_rc(int b, int& R, int& C) { const int st = b / 1024, sb = b % 1024, swz = sb ^ (((sb >> 9) & 1) << 5); R = (st >> 1) * 16 + swz / 64; C = (st & 1) * 32 + (swz % 64) / 2; }
__host__ __device__ __forceinline__ int perm32(int rho) { const int n = rho >> 4, i = rho & 15; return 8 * (i >> 2) + 4 * n + (i & 3); }

struct Unit { int pm, pn; };
struct Gemm { const bf16_t* A; const bf16_t* Bt; int M, N, K; };

struct StaticOrder {
    int nM, nN, nwg, G, c;
    __host__ __device__ void init(int M, int N, int G_, int c_) { nM = M / BM; nN = N / BM; nwg = nM * nN; G = G_; c = c_; }
    __host__ __device__ bool next(int i, Unit& u) const {
        const long L = (long)i * G + c; if (L >= nwg) return false;
        int wgid = (int)L; { const int q = nwg / NXCD, r = nwg % NXCD, xcd = wgid % NXCD, off = wgid / NXCD; wgid = (xcd < r ? xcd * (q + 1) : r * (q + 1) + (xcd - r) * q) + off; }
        const int nig = WGM * nN, gid = wgid / nig, fm = gid * WGM, gsz = (nM - fm) < WGM ? (nM - fm) : WGM;
        u.pm = fm + ((wgid % nig) % gsz); u.pn = (wgid % nig) / gsz; return true;
    }
    __device__ __forceinline__ void a_ready(const Unit&) const {}
    __device__ __forceinline__ void done(const Unit&) const {}
};
__device__ __forceinline__ unsigned cvt_pk_bf16(float lo, float hi) { unsigned r; asm volatile("v_cvt_pk_bf16_f32 %0, %1, %2" : "=v"(r) : "v"(lo), "v"(hi)); return r; }
typedef float f32x2 __attribute__((ext_vector_type(2)));
__device__ __forceinline__ unsigned short bf16_1(float v) { return (unsigned short)(cvt_pk_bf16(v, v) & 0xffffu); }
struct EpiProj {
    static constexpr bool PERM = true, AFTER_DRAIN = false;
    bf16_t* O; int ldc; bf16_t* vt_sb; bf16_t* vt_mb;
    __device__ __forceinline__ void operator()(const f32x4 (&acc)[2][2][4][2], const Unit& u, int wr, int wc, int fr, int fq) const {
        if (u.pn == 5 || u.pn == 8) {
            bf16_t* vt = (u.pn == 5) ? vt_sb : vt_mb;
            const int b = u.pm >> 5, s0 = (u.pm & 31) * 256 + wr * 64 + fr;
#pragma unroll
            for (int bj = 0; bj < 2; ++bj)
#pragma unroll
                for (int n = 0; n < 2; ++n)
#pragma unroll
                    for (int e = 0; e < 4; ++e) {
                        const int c = 128 * bj + 32 * wc + 8 * fq + 4 * n + e;
                        bf16_t* col = vt + ((size_t)((b * 4 + (c >> 6)) * 64 + (c & 63))) * 8192 + s0;
#pragma unroll
                        for (int ai = 0; ai < 2; ++ai)
#pragma unroll
                            for (int m = 0; m < 4; ++m) col[ai * 128 + m * 16] = bf16_1(acc[ai][bj][m][n][e]);
                    }
        } else {
            const int row0 = u.pm * BM + wr * 64 + fr, col0 = u.pn * BM + wc * 32 + 8 * fq;
#pragma unroll
            for (int ai = 0; ai < 2; ++ai)
#pragma unroll
                for (int m = 0; m < 4; ++m) { bf16_t* rowp = O + (size_t)(row0 + ai * HALF + m * 16) * ldc + col0;
#pragma unroll
                    for (int bj = 0; bj < 2; ++bj) { const f32x4 v0 = acc[ai][bj][m][0], v1 = acc[ai][bj][m][1];
                        u32x4 w; w.x = cvt_pk_bf16(v0[0], v0[1]); w.y = cvt_pk_bf16(v0[2], v0[3]); w.z = cvt_pk_bf16(v1[0], v1[1]); w.w = cvt_pk_bf16(v1[2], v1[3]);
                        *(u32x4*)(rowp + bj * HALF) = w; } }
        }
    }
};
struct EpiRelu2 {
    static constexpr bool PERM = true, AFTER_DRAIN = false;
    bf16_t* O; int ldc;
    __device__ __forceinline__ void operator()(const f32x4 (&acc)[2][2][4][2], const Unit& u, int wr, int wc, int fr, int fq) const {
        const int row0 = u.pm * BM + wr * 64 + fr, col0 = u.pn * BM + wc * 32 + 8 * fq;
#pragma unroll
        for (int ai = 0; ai < 2; ++ai)
#pragma unroll
            for (int m = 0; m < 4; ++m) { bf16_t* rowp = O + (size_t)(row0 + ai * HALF + m * 16) * ldc + col0;
#pragma unroll
                for (int bj = 0; bj < 2; ++bj) { f32x4 v0 = acc[ai][bj][m][0], v1 = acc[ai][bj][m][1];
#pragma unroll
                    for (int e = 0; e < 4; ++e) { const float a0 = fmaxf(v0[e], 0.f), a1 = fmaxf(v1[e], 0.f); v0[e] = a0 * a0; v1[e] = a1 * a1; }
                    u32x4 w; w.x = cvt_pk_bf16(v0[0], v0[1]); w.y = cvt_pk_bf16(v0[2], v0[3]); w.z = cvt_pk_bf16(v1[0], v1[1]); w.w = cvt_pk_bf16(v1[2], v1[3]);
                    *(u32x4*)(rowp + bj * HALF) = w; } }
    }
};
struct EpiRes {
    static constexpr bool PERM = false, AFTER_DRAIN = false;
    const float* base; float* out; const float* gate;
    __device__ __forceinline__ void operator()(const f32x4 (&acc)[2][2][4][2], const Unit& u, int wr, int wc, int fr, int fq) const {
        const float* g = gate + (size_t)(u.pm >> 5) * 6144;
        const int col0 = u.pn * BM + wc * 32 + 4 * fq;
        f32x4 gv[2][2];
#pragma unroll
        for (int bj = 0; bj < 2; ++bj)
#pragma unroll
            for (int n = 0; n < 2; ++n) gv[bj][n] = *(const f32x4*)(g + col0 + bj * HALF + n * 16);
#pragma unroll
        for (int ai = 0; ai < 2; ++ai)
#pragma unroll
            for (int m = 0; m < 4; ++m) { const size_t off = (size_t)(u.pm * BM + ai * HALF + wr * 64 + m * 16 + fr) * 1024 + col0;
#pragma unroll
                for (int bj = 0; bj < 2; ++bj)
#pragma unroll
                    for (int n = 0; n < 2; ++n) { const f32x4 bs = *(const f32x4*)(base + off + bj * HALF + n * 16);
                        *(f32x4*)(out + off + bj * HALF + n * 16) = bs + gv[bj][n] * acc[ai][bj][m][n]; } }
    }
};
template <class Epi, class Sched, bool ALIGN_EPI = false, bool SP2 = false>
__device__ __forceinline__ void gemm_phase(PG8_LAS unsigned char* lds, const Gemm g, const Sched& S, const Epi& E, int tid_in) {
    int tid_l = tid_in; asm volatile("" : "+v"(tid_l));
    const int tid = tid_l, wid = __builtin_amdgcn_readfirstlane(tid >> 6), lane = tid & 63, wr = wid >> 2, wc = wid & 3, fr = lane & 15, fq = lane >> 4;
    const int K = g.K, nt = K / BK;
    unsigned voffA[2], voffB[2];
#pragma unroll
    for (int i = 0; i < 2; ++i) { int R, C; stage_rc(tid * 16 + i * 8192, R, C); const int Rb = Epi::PERM ? ((R & ~31) + perm32(R & 31)) : R;
        voffA[i] = (unsigned)(R * K + C) * 2u; voffB[i] = (unsigned)(Rb * K + C) * 2u; }
    const size_t kstep = (size_t)(BK * 2);
    const size_t hstep = (size_t)HALF * K * 2;
    const size_t tstep = 2 * hstep;
    const unsigned ldsw = (unsigned)wid * 1024u;
    const int aoff = lds_byte(wr * 64 + fr, fq * 8), boff = lds_byte(wc * 32 + fr, fq * 8);
#define PG8_SA(b, h) (((b) * 2 + (h)) * HTB)
#define PG8_SB(b, h) ((4 + (b) * 2 + (h)) * HTB)
#define PG8_STAGE(bufoff, gbase, voff) do { _Pragma("unroll") for (int _i = 0; _i < 2; ++_i) \
        __builtin_amdgcn_global_load_lds((const unsigned*)((const char*)(gbase) + (voff)[_i]), (PG8_LAS unsigned*)(lds + (bufoff) + ldsw + _i * 8192), 16, 0, 0); } while (0)
#define PG8_LDA(dst, b, h) do { _Pragma("unroll") for (int m = 0; m < 4; ++m) _Pragma("unroll") for (int k = 0; k < 2; ++k) dst[m][k] = *(const PG8_LAS bf16x8*)(lds + PG8_SA(b, h) + aoff + m * 2048 + k * 1024); } while (0)
#define PG8_LDB(dst, b, h) do { _Pragma("unroll") for (int n = 0; n < 2; ++n) _Pragma("unroll") for (int k = 0; k < 2; ++k) dst[n][k] = *(const PG8_LAS bf16x8*)(lds + PG8_SB(b, h) + boff + n * 2048 + k * 1024); } while (0)
#define PG8_MMA(ai, bj, At, Bt) do { __builtin_amdgcn_s_setprio(1); _Pragma("unroll") for (int m = 0; m < 4; ++m) _Pragma("unroll") for (int n = 0; n < 2; ++n) _Pragma("unroll") for (int k = 0; k < 2; ++k) \
        acc[ai][bj][m][n] = __builtin_amdgcn_mfma_f32_16x16x32_bf16(Bt[n][k], At[m][k], acc[ai][bj][m][n], 0, 0, 0); __builtin_amdgcn_s_setprio(0); } while (0)
#define PG8_WAIT_V(n) asm volatile("s_waitcnt vmcnt(" #n ")" ::: "memory")
#define PG8_WAIT_L(n) asm volatile("s_waitcnt lgkmcnt(" #n ")" ::: "memory")
#define PG8_BAR __builtin_amdgcn_s_barrier()
#define PG8_SCHED __builtin_amdgcn_sched_barrier(0)
    Unit cur, nxt; int ui = 0;
    if (!S.next(0, cur)) return;
    f32x4 acc[2][2][4][2];
#pragma unroll
    for (int a = 0; a < 2; ++a)
#pragma unroll
        for (int b = 0; b < 2; ++b)
#pragma unroll
            for (int m = 0; m < 4; ++m)
#pragma unroll
                for (int n = 0; n < 2; ++n) acc[a][b][m][n] = (f32x4){0.f, 0.f, 0.f, 0.f};
    bf16x8 At[4][2], B0[2][2], B1[2][2];
    const char* cA = (const char*)g.A + (size_t)cur.pm * tstep; const char* cB = (const char*)g.Bt + (size_t)cur.pn * tstep;
    S.a_ready(cur);
    if constexpr (SP2) {
        PG8_STAGE(PG8_SB(0, 0), cB, voffB); PG8_STAGE(PG8_SB(0, 1), cB + hstep, voffB); PG8_STAGE(PG8_SA(0, 0), cA, voffA); PG8_STAGE(PG8_SA(0, 1), cA + hstep, voffA);
        if (wr == 1) PG8_BAR;
        PG8_WAIT_V(2); PG8_BAR;
        PG8_STAGE(PG8_SB(1, 0), cB + kstep, voffB); PG8_STAGE(PG8_SA(1, 0), cA + kstep, voffA); PG8_STAGE(PG8_SB(1, 1), cB + hstep + kstep, voffB);
        PG8_WAIT_V(6); PG8_BAR;
    } else {
        PG8_STAGE(PG8_SB(0, 0), cB, voffB); PG8_STAGE(PG8_SA(0, 0), cA, voffA); PG8_STAGE(PG8_SB(0, 1), cB + hstep, voffB); PG8_STAGE(PG8_SA(0, 1), cA + hstep, voffA);
        if (wr == 1) PG8_BAR;
        PG8_WAIT_V(4); PG8_BAR;
        PG8_STAGE(PG8_SB(1, 0), cB + kstep, voffB); PG8_STAGE(PG8_SA(1, 0), cA + kstep, voffA); PG8_STAGE(PG8_SB(1, 1), cB + hstep + kstep, voffB);
        PG8_WAIT_V(6); PG8_BAR;
    }
    for (;;) {
        const bool has_next = S.next(ui + 1, nxt);
        const char* nA = has_next ? (const char*)g.A + (size_t)nxt.pm * tstep : cA; const char* nB = has_next ? (const char*)g.Bt + (size_t)nxt.pn * tstep : cB;
        for (int t = 0; t < nt; t += 2) {
            const bool last = (t == nt - 2);
            const char* a1 = cA + (size_t)(t + 1) * kstep;
            const char* a2 = last ? nA : cA + (size_t)(t + 2) * kstep; const char* b2 = last ? nB : cB + (size_t)(t + 2) * kstep;
            const char* a3 = a2 + kstep; const char* b3 = b2 + kstep;
            if (last && has_next) S.a_ready(nxt);
            if constexpr (SP2) {
            PG8_LDB(B0, 0, 0); PG8_LDB(B1, 0, 1); PG8_SCHED; PG8_LDA(At, 0, 0); PG8_STAGE(PG8_SA(1, 1), a1 + hstep, voffA);
            PG8_WAIT_V(8); PG8_WAIT_L(0); PG8_BAR; PG8_MMA(0, 0, At, B0); PG8_MMA(0, 1, At, B1); PG8_BAR; PG8_SCHED;
            PG8_LDA(At, 0, 1); PG8_STAGE(PG8_SB(0, 0), b2, voffB); PG8_STAGE(PG8_SB(0, 1), b2 + hstep, voffB); PG8_STAGE(PG8_SA(0, 0), a2, voffA);
            PG8_WAIT_V(8); PG8_WAIT_L(0); PG8_BAR; PG8_MMA(1, 0, At, B0); PG8_MMA(1, 1, At, B1); PG8_BAR; PG8_SCHED;
            PG8_LDB(B0, 1, 0); PG8_LDB(B1, 1, 1); PG8_SCHED; PG8_LDA(At, 1, 0); PG8_STAGE(PG8_SA(0, 1), a2 + hstep, voffA);
            PG8_WAIT_V(8); PG8_WAIT_L(0); PG8_BAR; PG8_MMA(0, 0, At, B0); PG8_MMA(0, 1, At, B1); PG8_BAR; PG8_SCHED;
            PG8_LDA(At, 1, 1); PG8_STAGE(PG8_SB(1, 0), b3, voffB); PG8_STAGE(PG8_SB(1, 1), b3 + hstep, voffB); PG8_STAGE(PG8_SA(1, 0), a3, voffA);
            PG8_WAIT_V(8); PG8_WAIT_L(0); PG8_BAR; PG8_MMA(1, 0, At, B0); PG8_MMA(1, 1, At, B1); PG8_BAR; PG8_SCHED;
            } else {
            PG8_LDB(B0, 0, 0); PG8_SCHED; PG8_LDA(At, 0, 0); PG8_STAGE(PG8_SA(1, 1), a1 + hstep, voffA);
            PG8_WAIT_L(8); PG8_BAR; PG8_WAIT_L(0); PG8_MMA(0, 0, At, B0); PG8_BAR; PG8_SCHED;
            PG8_LDB(B1, 0, 1); PG8_STAGE(PG8_SB(0, 0), b2, voffB);
            PG8_BAR; PG8_WAIT_L(0); PG8_MMA(0, 1, At, B1); PG8_BAR;
            PG8_LDA(At, 0, 1); PG8_STAGE(PG8_SA(0, 0), a2, voffA);
            PG8_BAR; PG8_WAIT_L(0); PG8_MMA(1, 0, At, B0); PG8_BAR; PG8_SCHED;
            PG8_STAGE(PG8_SB(0, 1), b2 + hstep, voffB);
            PG8_WAIT_V(6); PG8_BAR; PG8_MMA(1, 1, At, B1); PG8_BAR;
            PG8_LDB(B0, 1, 0); PG8_SCHED; PG8_LDA(At, 1, 0); PG8_STAGE(PG8_SA(0, 1), a2 + hstep, voffA);
            PG8_WAIT_L(8); PG8_BAR; PG8_WAIT_L(0); PG8_MMA(0, 0, At, B0); PG8_BAR; PG8_SCHED;
            PG8_LDB(B1, 1, 1); PG8_STAGE(PG8_SB(1, 0), b3, voffB);
            PG8_BAR; PG8_WAIT_L(0); PG8_MMA(0, 1, At, B1); PG8_BAR;
            PG8_LDA(At, 1, 1); PG8_STAGE(PG8_SA(1, 0), a3, voffA);
            PG8_BAR; PG8_WAIT_L(0); PG8_MMA(1, 0, At, B0); PG8_BAR; PG8_SCHED;
            PG8_STAGE(PG8_SB(1, 1), b3 + hstep, voffB);
            PG8_WAIT_V(6); PG8_BAR; PG8_MMA(1, 1, At, B1); PG8_BAR;
            }
        }
        if constexpr (ALIGN_EPI) { if (wr == 0) PG8_BAR; }
        if constexpr (!Epi::AFTER_DRAIN) { E(acc, cur, wr, wc, fr, fq); S.done(cur); }
        if (!has_next) break;
#pragma unroll
        for (int a = 0; a < 2; ++a)
#pragma unroll
            for (int b = 0; b < 2; ++b)
#pragma unroll
                for (int m = 0; m < 4; ++m)
#pragma unroll
                    for (int n = 0; n < 2; ++n) acc[a][b][m][n] = (f32x4){0.f, 0.f, 0.f, 0.f};
        cur = nxt; cA = nA; cB = nB; ++ui;
        if constexpr (ALIGN_EPI) { if (wr == 1) PG8_BAR; }
    }
    PG8_WAIT_V(0);
    if constexpr (!ALIGN_EPI) { if (wr == 0) PG8_BAR; }
    PG8_BAR;
    if constexpr (Epi::AFTER_DRAIN) { E.fused(acc, cur, wr, wc, fr, fq, lds, wid, lane); S.done(cur); }
#undef PG8_SA
#undef PG8_SB
#undef PG8_STAGE
#undef PG8_LDA
#undef PG8_LDB
#undef PG8_MMA
#undef PG8_WAIT_V
#undef PG8_WAIT_L
#undef PG8_BAR
#undef PG8_SCHED
}
}

constexpr int NB = 8, SEQ = 8192, DM = 1024, MTOK = NB * SEQ, INW = 2816, FF = 4096, NWAVES = 8;
constexpr size_t MiB = 1u << 20;
constexpr size_t WS_MOD = 0, WS_KMEAN = 512 * 1024;
constexpr size_t WS_WIN = 2 * MiB, WS_WOUT = 14 * MiB, WS_W1 = 18 * MiB, WS_W2 = 34 * MiB;
constexpr size_t WS_VTSB = 50 * MiB, WS_VTMB = 82 * MiB;
constexpr size_t WS_XN = 128 * MiB, WS_Y = 256 * MiB, WS_PROJ = 384 * MiB, WS_END = 896 * MiB;
constexpr int LDS_BYTES = 135168;
constexpr int N_PHASES = 17;

typedef unsigned short bf16;
typedef short bf16x8 __attribute__((ext_vector_type(8)));
typedef float f32x4 __attribute__((ext_vector_type(4)));
typedef float f32x2 __attribute__((ext_vector_type(2)));
typedef float f32x16 __attribute__((ext_vector_type(16)));
typedef unsigned u32x4 __attribute__((ext_vector_type(4)));
typedef unsigned u32x2 __attribute__((ext_vector_type(2)));
typedef __bf16 bf16x2_t __attribute__((ext_vector_type(2)));
#define LAS __attribute__((address_space(3)))
__device__ __forceinline__ unsigned pk2(float lo, float hi) { f32x2 v = {lo, hi}; bf16x2_t b = __builtin_convertvector(v, bf16x2_t); return __builtin_bit_cast(unsigned, b); }
__device__ __forceinline__ float bflo(unsigned w) { return __uint_as_float(w << 16); }
__device__ __forceinline__ float bfhi(unsigned w) { return __uint_as_float(w & 0xffff0000u); }
__device__ __forceinline__ void unpack8(const u32x4 w, float (&f)[8]) {
    f[0] = bflo(w.x); f[1] = bfhi(w.x); f[2] = bflo(w.y); f[3] = bfhi(w.y); f[4] = bflo(w.z); f[5] = bfhi(w.z); f[6] = bflo(w.w); f[7] = bfhi(w.w); }
__device__ __forceinline__ u32x4 pack8(const float (&f)[8]) { u32x4 w; w.x = pk2(f[0], f[1]); w.y = pk2(f[2], f[3]); w.z = pk2(f[4], f[5]); w.w = pk2(f[6], f[7]); return w; }
__device__ __forceinline__ float wave_sum(float v) {
#pragma unroll
    for (int o = 1; o < 64; o <<= 1) v += __shfl_xor(v, o);
    return v;
}
__device__ __forceinline__ float ex2(float x) { return __builtin_amdgcn_exp2f(x); }
__device__ __forceinline__ float lg2(float x) { return __builtin_amdgcn_logf(x); }

struct Args { const float* in[18]; float* out; unsigned char* ws; int ph_lo, ph_hi; };

__device__ __forceinline__ void p0_transpose_item(const float* W, int K, int N, bf16* WT, LAS float* scr, int item, int lane) {
    const int nblk = N / 32, kb = item / nblk, nb = item % nblk, k0 = 64 * kb, n0 = 32 * nb;
#pragma unroll 8
    for (int i = 0; i < 32; ++i) { const int kk = 2 * i + (lane >> 5); scr[kk * 33 + (lane & 31)] = W[(size_t)(k0 + kk) * N + n0 + (lane & 31)]; }
    asm volatile("s_waitcnt lgkmcnt(0)" ::: "memory");
    const int c = lane & 7;
#pragma unroll
    for (int j = 0; j < 4; ++j) { const int n = (lane >> 3) + 8 * j; const LAS float* s = scr + (8 * c) * 33 + n;
        u32x4 o; o.x = pk2(s[0 * 33], s[1 * 33]); o.y = pk2(s[2 * 33], s[3 * 33]); o.z = pk2(s[4 * 33], s[5 * 33]); o.w = pk2(s[6 * 33], s[7 * 33]);
        *(u32x4*)(WT + (size_t)(n0 + n) * K + k0 + 8 * c) = o; }
    asm volatile("s_waitcnt lgkmcnt(0)" ::: "memory");
}

__device__ __forceinline__ void p0_prologue(const Args& a, unsigned char* lds, int tid, int lane, int wave, int bx, int G) {
    {
        float* cact = (float*)lds;
        float* red = (float*)(lds + 32768);
        const float* c = a.in[1]; const float* w_ada = a.in[3]; const float* b_ada = a.in[4];
        float* mod = (float*)(a.ws + WS_MOD);
        if (bx < 192) { for (int i = tid; i < 8192; i += 512) { const float v = c[i]; cact[i] = v / (1.f + __expf(-v)); } }
        __syncthreads();
        for (int it = bx; it < 192; it += G) {
            const int l = it / 96, cgp = it % 96;
            const float* W = w_ada + (size_t)l * 1024 * 6144 + cgp * 64 + lane;
            float acc[8];
#pragma unroll
            for (int b = 0; b < 8; ++b) acc[b] = 0.f;
            for (int k = wave * 128; k < wave * 128 + 128; k += 4) {
                const float w0 = W[(size_t)k * 6144], w1 = W[(size_t)(k + 1) * 6144], w2 = W[(size_t)(k + 2) * 6144], w3 = W[(size_t)(k + 3) * 6144];
#pragma unroll
                for (int b = 0; b < 8; ++b) { const f32x4 cv = *(const f32x4*)(cact + b * 1024 + k); acc[b] += cv.x * w0 + cv.y * w1 + cv.z * w2 + cv.w * w3; }
            }
#pragma unroll
            for (int b = 0; b < 8; ++b) red[(wave * 8 + b) * 64 + lane] = acc[b];
            __syncthreads();
            { const int b = tid >> 6, j = tid & 63; float s = 0.f;
#pragma unroll
              for (int w = 0; w < 8; ++w) s += red[(w * 8 + b) * 64 + j];
              mod[(size_t)(l * 8 + b) * 6144 + cgp * 64 + j] = s + b_ada[l * 6144 + cgp * 64 + j]; }
            __syncthreads();
        }
        __syncthreads();
    }
    {
        LAS float* scr = (LAS float*)((LAS unsigned char*)lds + wave * 16384);
        const int gw = bx * NWAVES + wave, NGW = G * NWAVES;
        constexpr int I_IN = (DM / 64) * (INW / 32), I_OUT = (DM / 64) * (DM / 32), I_1 = (DM / 64) * (FF / 32), I_2 = (FF / 64) * (DM / 32);
        constexpr int PER_L = I_IN + I_OUT + I_1 + I_2;
        for (int it = gw; it < 2 * PER_L; it += NGW) {
            const int l = it / PER_L; int r = it % PER_L;
            if (r < I_IN) { p0_transpose_item(a.in[6] + (size_t)l * DM * INW, DM, INW, (bf16*)(a.ws + WS_WIN) + (size_t)l * INW * DM, scr, r, lane); continue; } r -= I_IN;
            if (r < I_OUT) { p0_transpose_item(a.in[14] + (size_t)l * DM * DM, DM, DM, (bf16*)(a.ws + WS_WOUT) + (size_t)l * DM * DM, scr, r, lane); continue; } r -= I_OUT;
            if (r < I_1) { p0_transpose_item(a.in[16] + (size_t)l * DM * FF, DM, FF, (bf16*)(a.ws + WS_W1) + (size_t)l * FF * DM, scr, r, lane); continue; } r -= I_1;
            p0_transpose_item(a.in[17] + (size_t)l * FF * DM, FF, DM, (bf16*)(a.ws + WS_W2) + (size_t)l * DM * FF, scr, r, lane);
        }
    }
}

__device__ __forceinline__ void norm_phase(const float* x, bf16* xn, const float* g, const float* mod_l, int shift_chunk, int gw, int NGW, int lane) {
    for (int r0 = gw * 32; r0 < MTOK; r0 += NGW * 32) {
        const float* mb = mod_l + (size_t)(r0 >> 13) * 6144 + shift_chunk * 1024;
        f32x4 gs[4], sh[4];
#pragma unroll
        for (int j = 0; j < 4; ++j) { const int c = 4 * lane + 256 * j; const f32x4 g4 = *(const f32x4*)(g + c), sc = *(const f32x4*)(mb + 1024 + c); sh[j] = *(const f32x4*)(mb + c); gs[j] = g4 * (1.f + sc); }
#pragma unroll 2
        for (int i = 0; i < 32; ++i) {
            const float* xr = x + (size_t)(r0 + i) * DM + 4 * lane;
            f32x4 v[4]; float ss = 0.f;
#pragma unroll
            for (int j = 0; j < 4; ++j) { v[j] = *(const f32x4*)(xr + 256 * j); ss += (v[j].x * v[j].x + v[j].y * v[j].y) + (v[j].z * v[j].z + v[j].w * v[j].w); }
            const float rstd = rsqrtf(wave_sum(ss) * (1.f / DM) + 1e-6f);
            bf16* orow = xn + (size_t)(r0 + i) * DM + 4 * lane;
#pragma unroll
            for (int j = 0; j < 4; ++j) { const f32x4 o = v[j] * rstd * gs[j] + sh[j]; u32x2 w; w.x = pk2(o.x, o.y); w.y = pk2(o.z, o.w); *(u32x2*)(orow + 256 * j) = w; }
        }
    }
}

__device__ __forceinline__ void sc_item(const bf16* proj, bf16* Y, const float* wsc, int item, int tid) {
    const int cgp = tid & 31, ts = tid >> 5;
    float w[3][8];
#pragma unroll
    for (int k = 0; k < 3; ++k)
#pragma unroll
        for (int e = 0; e < 8; ++e) w[k][e] = wsc[k * 256 + cgp * 8 + e];
    const int r0 = item * 64;
#pragma unroll
    for (int p = 0; p < 4; ++p) {
        const int row = r0 + p * 16 + ts, t = row & (SEQ - 1);
        const bf16* pr = proj + (size_t)row * INW + cgp * 8;
        const u32x4 Bv = *(const u32x4*)pr;
        float acc[8];
#pragma unroll
        for (int e = 0; e < 8; ++e) acc[e] = 0.f;
#pragma unroll
        for (int k = 0; k < 3; ++k) { const int dt = 2 - k;
            if (t - dt >= 0) { const bf16* q = pr - (size_t)dt * INW; const u32x4 Cv = *(const u32x4*)(q + 256), Hv = *(const u32x4*)(q + 512); float c[8], h[8]; unpack8(Cv, c); unpack8(Hv, h);
#pragma unroll
                for (int e = 0; e < 8; ++e) acc[e] += w[k][e] * (c[e] * h[e]); } }
        float bb[8]; unpack8(Bv, bb);
#pragma unroll
        for (int e = 0; e < 8; ++e) bb[e] *= acc[e];
        *(u32x4*)(Y + (size_t)row * DM + cgp * 8) = pack8(bb);
    }
}

__device__ __forceinline__ void cf_item(const bf16* proj, bf16* Y, const float* wcc, const float* bcc, const float* gcl, const float* bcl, unsigned char* lds, int item, int tid, int lane, int wave) {
    float* U = (float*)lds;
    float* CO = (float*)(lds + 62 * 256 * 4);
    const int r0 = item * 32, t0 = r0 & (SEQ - 1);
    for (int idx = tid; idx < 62 * 32; idx += 512) {
        const int rr = idx >> 5, cgp = idx & 31, t = t0 - 30 + rr;
        float u[8];
#pragma unroll
        for (int e = 0; e < 8; ++e) u[e] = 0.f;
        if (t >= 0) { const bf16* p = proj + (size_t)(r0 - 30 + rr) * INW + 2304 + cgp * 8; const u32x4 av = *(const u32x4*)p, gv = *(const u32x4*)(p + 256); float aa[8], gg[8]; unpack8(av, aa); unpack8(gv, gg);
#pragma unroll
            for (int e = 0; e < 8; ++e) u[e] = aa[e] / (1.f + __expf(-gg[e])); }
        *(f32x4*)(U + rr * 256 + cgp * 8) = (f32x4){u[0], u[1], u[2], u[3]}; *(f32x4*)(U + rr * 256 + cgp * 8 + 4) = (f32x4){u[4], u[5], u[6], u[7]};
    }
    __syncthreads();
    {
        const int ch = tid & 255, half = tid >> 8;
        float w[31];
#pragma unroll
        for (int k = 0; k < 31; ++k) w[k] = wcc[k * 256 + ch];
        float uu[46];
#pragma unroll
        for (int i = 0; i < 46; ++i) uu[i] = U[(half * 16 + i) * 256 + ch];
        const float bias = bcc[ch];
#pragma unroll
        for (int tt = 0; tt < 16; ++tt) { float acc = bias;
#pragma unroll
            for (int k = 0; k < 31; ++k) acc += w[k] * uu[tt + k];
            CO[(half * 16 + tt) * 256 + ch] = acc; }
    }
    __syncthreads();
    {
        const f32x4 g4 = *(const f32x4*)(gcl + lane * 4), b4 = *(const f32x4*)(bcl + lane * 4);
#pragma unroll
        for (int i = 0; i < 4; ++i) { const int tl = wave * 4 + i;
            const f32x4 v = *(const f32x4*)(CO + tl * 256 + lane * 4);
            const float mean = wave_sum((v.x + v.y) + (v.z + v.w)) * (1.f / 256.f);
            const f32x4 d = v - mean;
            const float var = wave_sum((d.x * d.x + d.y * d.y) + (d.z * d.z + d.w * d.w)) * (1.f / 256.f);
            const float rstd = rsqrtf(var + 1e-6f);
            f32x4 y = d * rstd * g4 + b4;
            y.x = y.x / (1.f + __expf(-y.x)); y.y = y.y / (1.f + __expf(-y.y)); y.z = y.z / (1.f + __expf(-y.z)); y.w = y.w / (1.f + __expf(-y.w));
            u32x2 w2; w2.x = pk2(y.x, y.y); w2.y = pk2(y.z, y.w);
            *(u32x2*)(Y + (size_t)(r0 + tl) * DM + 768 + lane * 4) = w2; }
    }
    __syncthreads();
}

constexpr float C2 = 0.125f * 1.4426950408889634f;
__device__ __forceinline__ void prep_item(bf16* proj, const int* positions, const float* gq, const float* gk, float* kmean, unsigned char* lds, int item, int tid) {
    f32x2* cs = (f32x2*)lds;
    float* kacc = (float*)(lds + 4096);
    const int b = item >> 5, n = item & 31;
    const int g = tid >> 3, j = tid & 7, tk = g >> 2, h = g & 3;
    if (tid < 256) kacc[tid] = 0.f;
    float gqv[8], gkv[8], ksum[8];
#pragma unroll
    for (int e = 0; e < 8; ++e) { gqv[e] = gq[8 * j + e]; gkv[e] = gk[8 * j + e]; ksum[e] = 0.f; }
    const int f_t = tid & 31, tk_t = tid >> 5;
    const float inv_freq = expf((-9.210340371976184f * (float)f_t) / 32.0f);
    for (int p = 0; p < 16; ++p) {
        const int rowb = b * SEQ + n * 256 + p * 16;
        { const int pos = positions[rowb + tk_t]; const float ang = (float)pos * inv_freq;
          double rev = (double)ang * 0.15915494309189535; rev -= floor(rev); const float rf = (float)rev;
          cs[tk_t * 32 + f_t] = (f32x2){__builtin_amdgcn_cosf(rf), __builtin_amdgcn_sinf(rf)}; }
        __syncthreads();
#pragma unroll
        for (int which = 0; which < 2; ++which) {
            bf16* ptr = proj + (size_t)(rowb + tk) * INW + (which ? 1792 : 1536) + h * 64 + j * 8;
            float v[8]; unpack8(*(const u32x4*)ptr, v);
            float ss = 0.f;
#pragma unroll
            for (int e = 0; e < 8; ++e) ss += v[e] * v[e];
            ss += __shfl_xor(ss, 1); ss += __shfl_xor(ss, 2); ss += __shfl_xor(ss, 4);
            const float rstd = rsqrtf(ss * (1.f / 64.f) + 1e-6f);
            float o[8];
#pragma unroll
            for (int e = 0; e < 8; ++e) { const float y = v[e] * rstd * (which ? gkv[e] : gqv[e]); const float pt = __shfl_xor(y, 4); const f32x2 c = cs[tk * 32 + ((8 * j + e) & 31)];
                o[e] = (j < 4) ? (y * c.x - pt * c.y) : (y * c.x + pt * c.y); }
            if (which == 0) {
#pragma unroll
                for (int e = 0; e < 8; ++e) o[e] *= C2;
            } else {
#pragma unroll
                for (int e = 0; e < 8; ++e) ksum[e] += o[e];
            }
            *(u32x4*)ptr = pack8(o);
        }
        __syncthreads();
    }
#pragma unroll
    for (int e = 0; e < 8; ++e) atomicAdd(&kacc[h * 64 + 8 * j + e], ksum[e]);
    __syncthreads();
    if (tid < 256) kmean[((size_t)(b * 4 + (tid >> 6)) * 32 + n) * 64 + (tid & 63)] = kacc[tid] * (1.f / 256.f);
    __syncthreads();
}

#define MFMA32(a, b, c) __builtin_amdgcn_mfma_f32_32x32x16_bf16((a), (b), (c), 0, 0, 0)
__device__ __forceinline__ int kperm(int rho) { return (rho & 19) | ((rho & 4) << 1) | ((rho & 8) >> 1); }
__device__ __forceinline__ constexpr int kidx(int r, int hi) { return (r & 7) + 8 * hi + 16 * (r >> 3); }
__device__ __forceinline__ constexpr int crow(int r, int hi) { return (r & 3) + 8 * (r >> 2) + 4 * hi; }
constexpr float NEG = -1e30f;

__device__ __forceinline__ void load_k(bf16x8 (&kf)[4], const bf16* Kb, int key0, int lane) {
    const bf16* p = Kb + (size_t)(key0 + kperm(lane & 31)) * INW + (lane >> 5) * 8;
#pragma unroll
    for (int kk = 0; kk < 4; ++kk) kf[kk] = *(const bf16x8*)(p + 16 * kk);
}
__device__ __forceinline__ void load_v(bf16x8 (&vf)[4], const bf16* VTb, int key0, int lane) {
    const bf16* p = VTb + (size_t)(lane & 31) * SEQ + key0 + 8 * (lane >> 5);
    vf[0] = *(const bf16x8*)p; vf[1] = *(const bf16x8*)(p + 16); vf[2] = *(const bf16x8*)(p + 32 * SEQ); vf[3] = *(const bf16x8*)(p + 32 * SEQ + 16);
}
__device__ __forceinline__ void load_q(bf16x8 (&qf)[4], const bf16* Qrow0, int lane) {
    const bf16* p = Qrow0 + (size_t)(lane & 31) * INW + 8 * (lane >> 5);
#pragma unroll
    for (int kk = 0; kk < 4; ++kk) qf[kk] = *(const bf16x8*)(p + 16 * kk);
}
__device__ __forceinline__ void pv_acc(f32x16 (&o)[2], const bf16x8 (&vf)[4], const float (&a)[16]) {
    u32x4 w0, w1;
    w0.x = pk2(a[0], a[1]); w0.y = pk2(a[2], a[3]); w0.z = pk2(a[4], a[5]); w0.w = pk2(a[6], a[7]);
    w1.x = pk2(a[8], a[9]); w1.y = pk2(a[10], a[11]); w1.z = pk2(a[12], a[13]); w1.w = pk2(a[14], a[15]);
    const bf16x8 p0 = __builtin_bit_cast(bf16x8, w0), p1 = __builtin_bit_cast(bf16x8, w1);
    o[0] = MFMA32(vf[0], p0, o[0]); o[0] = MFMA32(vf[1], p1, o[0]);
    o[1] = MFMA32(vf[2], p0, o[1]); o[1] = MFMA32(vf[3], p1, o[1]);
}
__device__ __forceinline__ void store_o(bf16* Yb, const f32x16 (&o)[2], float sc, int lane) {
    bf16* p = Yb + (size_t)(lane & 31) * DM + 4 * (lane >> 5);
#pragma unroll
    for (int dh = 0; dh < 2; ++dh)
#pragma unroll
        for (int g4 = 0; g4 < 4; ++g4) { u32x2 w; w.x = pk2(o[dh][4 * g4] * sc, o[dh][4 * g4 + 1] * sc); w.y = pk2(o[dh][4 * g4 + 2] * sc, o[dh][4 * g4 + 3] * sc); *(u32x2*)(p + dh * 32 + 8 * g4) = w; }
}

constexpr float SBSC = 0.125f * 1.4426950408889634f, SBTH = -160.f;
template <bool DIAG> __device__ __forceinline__ void sb_qt(const bf16x8 (&kf)[4], const bf16x8 (&vf)[4], const bf16x8 (&qf)[4], f32x16 (&o)[2], float& carry, int ql, int hi) {
    f32x16 s = {};
#pragma unroll
    for (int kk = 0; kk < 4; ++kk) s = MFMA32(kf[kk], qf[kk], s);
    float L[16], zl[16];
    float lo = 0.f, up = 0.f;
#pragma unroll
    for (int r = 0; r < 16; ++r) { const float z = s[r] * SBSC; const float e = ex2(-fabsf(z)); const float sp = fmaxf(z, 0.f) + lg2(1.f + e);
        const bool valid = !DIAG || (kidx(r, hi) < ql);
        L[r] = valid ? -sp : 0.f; zl[r] = valid ? (z - sp) : -INFINITY;
        if (r < 8) lo += L[r]; else up += L[r]; }
    const float plo = __shfl_xor(lo, 32), pup = __shfl_xor(up, 32);
    const float offU = hi ? carry : carry + pup;
    const float offL = hi ? (carry + up + pup) : (carry + pup + up + plo);
    carry += (lo + plo) + (up + pup);
    float a[16];
    float run = offU;
#pragma unroll
    for (int r = 15; r >= 8; --r) { a[r] = ex2(zl[r] + run); run += L[r]; }
    run = offL;
#pragma unroll
    for (int r = 7; r >= 0; --r) { a[r] = ex2(zl[r] + run); run += L[r]; }
    pv_acc(o, vf, a);
}
__device__ __forceinline__ void sb_item(const bf16* proj, const bf16* vt, bf16* Y, int bh, int chunk, int lane) {
    const int b = bh >> 2, h = bh & 3, hi = lane >> 5, ql = lane & 31, qstart = chunk * 64;
    const bf16* Qb = proj + (size_t)b * SEQ * INW + 768 + h * 64;
    const bf16* Kb = proj + (size_t)b * SEQ * INW + 1024 + h * 64;
    const bf16* VTb = vt + (size_t)bh * 64 * SEQ;
    bf16x8 q0[4], q1[4]; load_q(q0, Qb + (size_t)qstart * INW, lane); load_q(q1, Qb + (size_t)(qstart + 32) * INW, lane);
    f32x16 o0[2] = {}, o1[2] = {}; float c0 = 0.f, c1 = 0.f;
    bf16x8 kf[4], vf[4];
    load_k(kf, Kb, qstart + 32, lane); load_v(vf, VTb, qstart + 32, lane);
    sb_qt<true>(kf, vf, q1, o1, c1, ql, hi);
    load_k(kf, Kb, qstart, lane); load_v(vf, VTb, qstart, lane);
    sb_qt<true>(kf, vf, q0, o0, c0, ql, hi); sb_qt<false>(kf, vf, q1, o1, c1, ql, hi);
    for (int key0 = qstart - 32; key0 >= 0; key0 -= 32) {
        if (__all((c0 < SBTH) && (c1 < SBTH))) break;
        load_k(kf, Kb, key0, lane); load_v(vf, VTb, key0, lane);
        sb_qt<false>(kf, vf, q0, o0, c0, ql, hi); sb_qt<false>(kf, vf, q1, o1, c1, ql, hi);
    }
    bf16* Yb = Y + (size_t)(b * SEQ + qstart) * DM + 256 + h * 64;
    store_o(Yb, o0, 1.f, lane); store_o(Yb + (size_t)32 * DM, o1, 1.f, lane);
}

template <int MODE  > __device__ __forceinline__ void mb_qt(const bf16x8 (&kf)[4], const bf16x8 (&vf)[4], const bf16x8 (&qf)[4], f32x16 (&o)[2], float& mref, float& lsum, bool sel, int ql, int hi) {
    f32x16 s = {};
#pragma unroll
    for (int kk = 0; kk < 4; ++kk) s = MFMA32(kf[kk], qf[kk], s);
    if (MODE == 2) {
#pragma unroll
        for (int r = 0; r < 16; ++r) if (kidx(r, hi) > ql) s[r] = NEG;
    }
    float tm = s[0];
#pragma unroll
    for (int r = 1; r < 16; ++r) tm = fmaxf(tm, s[r]);
    tm = fmaxf(tm, __shfl_xor(tm, 32));
    tm = sel ? tm : NEG;
    if (__any(tm > mref + 16.f)) { const float mn = fmaxf(mref, tm), al = ex2(mref - mn); lsum *= al; o[0] *= al; o[1] *= al; mref = mn; }
    const float me = sel ? mref : INFINITY;
    float p[16];
#pragma unroll
    for (int r = 0; r < 16; ++r) { p[r] = ex2(s[r] - me); lsum += p[r]; }
    pv_acc(o, vf, p);
}
__device__ __forceinline__ unsigned topk_mask(const float* km, const bf16x8 (&qf)[4], int own, int lane) {
    const int hi = lane >> 5;
    f32x16 g = {};
#pragma unroll
    for (int kk = 0; kk < 4; ++kk) { const float* kp = km + (lane & 31) * 64 + 16 * kk + 8 * hi; const f32x4 x0 = *(const f32x4*)kp, x1 = *(const f32x4*)(kp + 4);
        u32x4 wh; wh.x = pk2(x0.x, x0.y); wh.y = pk2(x0.z, x0.w); wh.z = pk2(x1.x, x1.y); wh.w = pk2(x1.z, x1.w);
        u32x4 wl; wl.x = pk2(x0.x - bflo(wh.x), x0.y - bfhi(wh.x)); wl.y = pk2(x0.z - bflo(wh.y), x0.w - bfhi(wh.y)); wl.z = pk2(x1.x - bflo(wh.z), x1.y - bfhi(wh.z)); wl.w = pk2(x1.z - bflo(wh.w), x1.w - bfhi(wh.w));
        g = MFMA32(__builtin_bit_cast(bf16x8, wh), qf[kk], g); g = MFMA32(__builtin_bit_cast(bf16x8, wl), qf[kk], g); }
    float gv[16];
#pragma unroll
    for (int r = 0; r < 16; ++r) gv[r] = (crow(r, hi) < own) ? g[r] : NEG;
    unsigned mask = 0u;
#pragma unroll
    for (int round = 0; round < 3; ++round) {
        float bm = gv[0]; int bi = crow(0, hi);
#pragma unroll
        for (int r = 1; r < 16; ++r) if (gv[r] > bm) { bm = gv[r]; bi = crow(r, hi); }
        const float pm = __shfl_xor(bm, 32); const int pi = __shfl_xor(bi, 32);
        const bool takep = (pm > bm) || (pm == bm && pi < bi);
        const float cm = takep ? pm : bm; const int ci = takep ? pi : bi;
        if (cm > -1e29f) mask |= 1u << ci;
#pragma unroll
        for (int r = 0; r < 16; ++r) if (crow(r, hi) == ci) gv[r] = NEG;
    }
    return mask;
}
__device__ __forceinline__ void moba_item(const bf16* proj, const bf16* vt, const float* kmean, bf16* Y, int bh, int chunk, int lane) {
    const int b = bh >> 2, h = bh & 3, hi = lane >> 5, ql = lane & 31, qstart = chunk * 64, own = chunk >> 2;
    const bf16* Qb = proj + (size_t)b * SEQ * INW + 1536 + h * 64;
    const bf16* Kb = proj + (size_t)b * SEQ * INW + 1792 + h * 64;
    const bf16* VTb = vt + (size_t)bh * 64 * SEQ;
    bf16x8 q0[4], q1[4]; load_q(q0, Qb + (size_t)qstart * INW, lane); load_q(q1, Qb + (size_t)(qstart + 32) * INW, lane);
    unsigned m0 = 0u, m1 = 0u;
    if (own > 0) { m0 = topk_mask(kmean + (size_t)bh * 32 * 64, q0, own, lane); m1 = topk_mask(kmean + (size_t)bh * 32 * 64, q1, own, lane); }
    f32x16 o0[2] = {}, o1[2] = {}; float mr0 = NEG, mr1 = NEG, l0 = 0.f, l1 = 0.f;
    bf16x8 kA[4], vA[4];
    load_k(kA, Kb, qstart, lane); load_v(vA, VTb, qstart, lane);
    mb_qt<2>(kA, vA, q0, o0, mr0, l0, true, ql, hi); mb_qt<1>(kA, vA, q1, o1, mr1, l1, true, ql, hi);
    load_k(kA, Kb, qstart + 32, lane); load_v(vA, VTb, qstart + 32, lane);
    mb_qt<2>(kA, vA, q1, o1, mr1, l1, true, ql, hi);
    for (int key0 = own * 256; key0 < qstart; key0 += 32) {
        load_k(kA, Kb, key0, lane); load_v(vA, VTb, key0, lane);
        mb_qt<1>(kA, vA, q0, o0, mr0, l0, true, ql, hi); mb_qt<1>(kA, vA, q1, o1, mr1, l1, true, ql, hi);
    }
    for (int n = 0; n < own; ++n) {
        const bool s0 = (m0 >> n) & 1u, s1 = (m1 >> n) & 1u;
        const bool a0 = __any(s0), a1 = __any(s1);
        if (!(a0 || a1)) continue;
        const int kb0 = n * 256;
        for (int t = 0; t < 8; ++t) {
            load_k(kA, Kb, kb0 + 32 * t, lane); load_v(vA, VTb, kb0 + 32 * t, lane);
            if (a0) mb_qt<1>(kA, vA, q0, o0, mr0, l0, s0, ql, hi);
            if (a1) mb_qt<1>(kA, vA, q1, o1, mr1, l1, s1, ql, hi);
        }
    }
    l0 += __shfl_xor(l0, 32); l1 += __shfl_xor(l1, 32);
    bf16* Yb = Y + (size_t)(b * SEQ + qstart) * DM + 512 + h * 64;
    store_o(Yb, o0, 1.f / l0, lane); store_o(Yb + (size_t)32 * DM, o1, 1.f / l1, lane);
}

__global__ void __launch_bounds__(NWAVES * 64, 2) hybrid_fwd(Args a) {
    extern __shared__ __attribute__((aligned(16))) unsigned char lds[];
    cg::grid_group grid = cg::this_grid();
    const int G = gridDim.x, bx = blockIdx.x;
    const int wave0 = __builtin_amdgcn_readfirstlane((int)threadIdx.x >> 6);
#define PHASE_IDS int lane = (int)__builtin_amdgcn_mbcnt_hi(~0u, __builtin_amdgcn_mbcnt_lo(~0u, 0u)); asm volatile("" : "+v"(lane)); const int wave = wave0; const int tid = wave * 64 + lane; const int gw = bx * NWAVES + wave; (void)tid; (void)gw;
    const int vcu = (G % 8 == 0) ? (bx % 8) * (G / 8) + bx / 8 : bx;
    const int NGW = G * NWAVES;
    unsigned char* ws = a.ws;
    float* mod = (float*)(ws + WS_MOD);
    float* kmean = (float*)(ws + WS_KMEAN);
    bf16* XN = (bf16*)(ws + WS_XN); bf16* Yb = (bf16*)(ws + WS_Y); bf16* PROJ = (bf16*)(ws + WS_PROJ); bf16* HB = (bf16*)(ws + WS_PROJ);
    bf16* VTSB = (bf16*)(ws + WS_VTSB); bf16* VTMB = (bf16*)(ws + WS_VTMB);
    const int lo = a.ph_lo, hi_ = a.ph_hi;
#define IN(k) (lo <= (k) && (k) < hi_)
#define SEAM(k) do { if (IN(k) && IN((k) + 1)) grid.sync(); } while (0)

#ifndef NO_P0
    if (IN(0)) { PHASE_IDS p0_prologue(a, lds, tid, lane, wave, bx, G); }
#endif
    SEAM(0);
    for (int l = 0; l < 2; ++l) {
        const int pb = 1 + 8 * l;
        const float* mod_l = mod + (size_t)l * 8 * 6144;
        const float* xin = (l == 0) ? a.in[0] : a.out;
        if (IN(pb + 0)) { PHASE_IDS norm_phase(xin, XN, a.in[5] + l * DM, mod_l, 0, gw, NGW, lane); }
        SEAM(pb + 0);
        if (IN(pb + 1)) { PHASE_IDS
            pg8::Gemm g{XN, (const bf16*)(ws + WS_WIN) + (size_t)l * INW * DM, MTOK, INW, DM}; pg8::StaticOrder S; S.init(MTOK, INW, G, bx);
            pg8::EpiProj E{PROJ, INW, VTSB, VTMB};
#ifndef NO_G1
            pg8::gemm_phase<pg8::EpiProj, pg8::StaticOrder, true, true>((PG8_LAS unsigned char*)lds, g, S, E, tid);
#endif
        }
        SEAM(pb + 1);
        if (IN(pb + 2)) { PHASE_IDS
#ifndef NO_PREP
            for (int it = bx; it < 256; it += G) prep_item(PROJ, (const int*)a.in[2], a.in[12] + l * 64, a.in[13] + l * 64, kmean, lds, it, tid);
#endif
#ifndef NO_CF
            for (int it = bx; it < MTOK / 32; it += G) cf_item(PROJ, Yb, a.in[8] + l * 31 * 256, a.in[9] + l * 256, a.in[10] + l * 256, a.in[11] + l * 256, lds, it, tid, lane, wave);
#endif
#ifndef NO_SC
            for (int it = bx; it < MTOK / 64; it += G) sc_item(PROJ, Yb, a.in[7] + l * 3 * 256, it, tid);
#endif
#ifndef NO_SB
            for (int it = vcu * NWAVES + wave; it < 32 * 128; it += NGW) sb_item(PROJ, VTSB, Yb, it >> 7, it & 127, lane);
#endif
        }
        SEAM(pb + 2);
        if (IN(pb + 3)) { PHASE_IDS
#ifndef NO_MOBA
            for (int pi = vcu * NWAVES + wave; pi < 32 * 64; pi += NGW) { const int bh = pi >> 6, i = pi & 63;
                moba_item(PROJ, VTMB, kmean, Yb, bh, 127 - i, lane); moba_item(PROJ, VTMB, kmean, Yb, bh, i, lane); }
#endif
        }
        SEAM(pb + 3);
        if (IN(pb + 4)) { PHASE_IDS
            pg8::Gemm g{Yb, (const bf16*)(ws + WS_WOUT) + (size_t)l * DM * DM, MTOK, DM, DM}; pg8::StaticOrder S; S.init(MTOK, DM, G, bx);
            pg8::EpiRes E{xin, a.out, mod_l + 2 * 1024};
#ifndef NO_G2
            pg8::gemm_phase<pg8::EpiRes, pg8::StaticOrder, true, true>((PG8_LAS unsigned char*)lds, g, S, E, tid);
#endif
        }
        SEAM(pb + 4);
        if (IN(pb + 5)) { PHASE_IDS norm_phase(a.out, XN, a.in[15] + l * DM, mod_l, 3, gw, NGW, lane); }
        SEAM(pb + 5);
        if (IN(pb + 6)) { PHASE_IDS
            pg8::Gemm g{XN, (const bf16*)(ws + WS_W1) + (size_t)l * FF * DM, MTOK, FF, DM}; pg8::StaticOrder S; S.init(MTOK, FF, G, bx);
            pg8::EpiRelu2 E{HB, FF};
#ifndef NO_G3
            pg8::gemm_phase<pg8::EpiRelu2, pg8::StaticOrder, true, true>((PG8_LAS unsigned char*)lds, g, S, E, tid);
#endif
        }
        SEAM(pb + 6);
        if (IN(pb + 7)) { PHASE_IDS
            pg8::Gemm g{HB, (const bf16*)(ws + WS_W2) + (size_t)l * DM * FF, MTOK, DM, FF}; pg8::StaticOrder S; S.init(MTOK, DM, G, bx);
            pg8::EpiRes E{a.out, a.out, mod_l + 5 * 1024};
#ifndef NO_G4
            pg8::gemm_phase<pg8::EpiRes, pg8::StaticOrder, true, true>((PG8_LAS unsigned char*)lds, g, S, E, tid);
#endif
        }
        SEAM(pb + 7);
    }
#undef IN
#undef SEAM
}

#ifndef MK_PER_PHASE
#define MK_PER_PHASE 0
#endif
extern "C" void kernel_launch(void* const* d_in, const int* in_sizes, int n_in, void* d_out, int out_size, void* d_ws, size_t ws_size, hipStream_t stream) {
    static int grid = 0;
    if (grid == 0) {
        if (n_in != 18 || out_size != MTOK * DM || ws_size < WS_END) { fprintf(stderr, "kernel_launch: unexpected shapes (n_in %d out %d ws %zu)\n", n_in, out_size, ws_size); grid = -1; return; }
        int dev = 0, cus = 0, per_cu = 0;
        hipGetDevice(&dev); hipDeviceGetAttribute(&cus, hipDeviceAttributeMultiprocessorCount, dev);
        if (hipFuncSetAttribute((const void*)hybrid_fwd, hipFuncAttributeMaxDynamicSharedMemorySize, LDS_BYTES) != hipSuccess) { fprintf(stderr, "kernel_launch: hipFuncSetAttribute failed\n"); grid = -1; return; }
        if (hipOccupancyMaxActiveBlocksPerMultiprocessor(&per_cu, (const void*)hybrid_fwd, NWAVES * 64, LDS_BYTES) != hipSuccess || per_cu < 1) { fprintf(stderr, "kernel_launch: occupancy query says %d\n", per_cu); per_cu = 1; }
        (void)hipGetLastError();
        grid = cus * per_cu;
    }
    if (grid < 0) return;
    Args a{};
    for (int i = 0; i < 18; ++i) a.in[i] = (const float*)d_in[i];
    a.out = (float*)d_out; a.ws = (unsigned char*)d_ws;
#if MK_PER_PHASE
    for (int p = 0; p < N_PHASES; ++p) { a.ph_lo = p; a.ph_hi = p + 1; void* args[] = {&a};
        hipError_t e = hipLaunchCooperativeKernel((const void*)hybrid_fwd, dim3(grid), dim3(NWAVES * 64), args, LDS_BYTES, stream);
        if (e != hipSuccess) { fprintf(stderr, "cooperative launch failed (phase %d): %s (grid %d)\n", p, hipGetErrorString(e), grid); break; } }
#else
    a.ph_lo = 0; a.ph_hi = N_PHASES; void* args[] = {&a};
    hipError_t e = hipLaunchCooperativeKernel((const void*)hybrid_fwd, dim3(grid), dim3(NWAVES * 64), args, LDS_BYTES, stream);
    if (e != hipSuccess) fprintf(stderr, "cooperative launch failed: %s (grid %d)\n", hipGetErrorString(e), grid);
#endif
}
```

```cpp
#include <hip/hip_runtime.h>
#include <hip/hip_cooperative_groups.h>
#include <cstdio>
#include <cstdint>
namespace cg = cooperative_groups;
namespace pg8 {
#define PG8_LAS __attribute__((address_space(3)))
typedef unsigned short bf16_t;
typedef short bf16x8 __attribute__((ext_vector_type(8)));
typedef float f32x4 __attribute__((ext_vector_type(4)));
typedef unsigned u32x4 __attribute__((ext_vector_type(4)));
constexpr int BM = 256, BK = 64, HALF = 128, HTB = HALF * BK * 2  , STAGE_BYTES = 8 * HTB, NXCD = 8, WGM = 8;

__host__ __device__ __forceinline__ int lds_byte(int r, int c) { const int st = (r >> 4) * 2 + (c >> 5), rr = r & 15, cc = c & 31, ob = rr * 64 + cc * 2; return st * 1024 + (ob ^ (((ob >> 9) & 1) << 5)); }
__host__ __device__ __forceinline__ void stage_rc(int b, int& R, int& C) { const int st = b / 1024, sb = b % 1024, swz = sb ^ (((sb >> 9) & 1) << 5); R = (st >> 1) * 16 + swz / 64; C = (st & 1) * 32 + (swz % 64) / 2; }
__host__ __device__ __forceinline__ int perm32(int rho) { const int n = rho >> 4, i = rho & 15; return 8 * (i >> 2) + 4 * n + (i & 3); }

struct Unit { int pm, pn; };
struct Gemm { const bf16_t* A; const bf16_t* Bt; int M, N, K; };

struct StaticOrder {
    int nM, nN, nwg, G, c;
    __host__ __device__ void init(int M, int N, int G_, int c_) { nM = M / BM; nN = N / BM; nwg = nM * nN; G = G_; c = c_; }
    __host__ __device__ bool next(int i, Unit& u) const {
        const long L = (long)i * G + c; if (L >= nwg) return false;
        int wgid = (int)L; { const int q = nwg / NXCD, r = nwg % NXCD, xcd = wgid % NXCD, off = wgid / NXCD; wgid = (xcd < r ? xcd * (q + 1) : r * (q + 1) + (xcd - r) * q) + off; }
        const int nig = WGM * nN, gid = wgid / nig, fm = gid * WGM, gsz = (nM - fm) < WGM ? (nM - fm) : WGM;
        u.pm = fm + ((wgid % nig) % gsz); u.pn = (wgid % nig) / gsz; return true;
    }
    __device__ __forceinline__ void a_ready(const Unit&) const {}
    __device__ __forceinline__ void done(const Unit&) const {}
};
__device__ __forceinline__ unsigned cvt_pk_bf16(float lo, float hi) { unsigned r; asm volatile("v_cvt_pk_bf16_f32 %0, %1, %2" : "=v"(r) : "v"(lo), "v"(hi)); return r; }
typedef float f32x2 __attribute__((ext_vector_type(2)));
__device__ __forceinline__ unsigned short bf16_1(float v) { return (unsigned short)(cvt_pk_bf16(v, v) & 0xffffu); }
struct EpiProj {
    static constexpr bool PERM = true, AFTER_DRAIN = false;
    bf16_t* O; int ldc; bf16_t* vt_sb; bf16_t* vt_mb;
    __device__ __forceinline__ void operator()(const f32x4 (&acc)[2][2][4][2], const Unit& u, int wr, int wc, int fr, int fq) const {
        if (u.pn == 5 || u.pn == 8) {
            bf16_t* vt = (u.pn == 5) ? vt_sb : vt_mb;
            const int b = u.pm >> 5, s0 = (u.pm & 31) * 256 + wr * 64 + fr;
#pragma unroll
            for (int bj = 0; bj < 2; ++bj)
#pragma unroll
                for (int n = 0; n < 2; ++n)
#pragma unroll
                    for (int e = 0; e < 4; ++e) {
                        const int c = 128 * bj + 32 * wc + 8 * fq + 4 * n + e;
                        bf16_t* col = vt + ((size_t)((b * 4 + (c >> 6)) * 64 + (c & 63))) * 8192 + s0;
#pragma unroll
                        for (int ai = 0; ai < 2; ++ai)
#pragma unroll
                            for (int m = 0; m < 4; ++m) col[ai * 128 + m * 16] = bf16_1(acc[ai][bj][m][n][e]);
                    }
        } else {
            const int row0 = u.pm * BM + wr * 64 + fr, col0 = u.pn * BM + wc * 32 + 8 * fq;
#pragma unroll
            for (int ai = 0; ai < 2; ++ai)
#pragma unroll
                for (int m = 0; m < 4; ++m) { bf16_t* rowp = O + (size_t)(row0 + ai * HALF + m * 16) * ldc + col0;
#pragma unroll
                    for (int bj = 0; bj < 2; ++bj) { const f32x4 v0 = acc[ai][bj][m][0], v1 = acc[ai][bj][m][1];
                        u32x4 w; w.x = cvt_pk_bf16(v0[0], v0[1]); w.y = cvt_pk_bf16(v0[2], v0[3]); w.z = cvt_pk_bf16(v1[0], v1[1]); w.w = cvt_pk_bf16(v1[2], v1[3]);
                        *(u32x4*)(rowp + bj * HALF) = w; } }
        }
    }
};
struct EpiRelu2 {
    static constexpr bool PERM = true, AFTER_DRAIN = false;
    bf16_t* O; int ldc;
    __device__ __forceinline__ void operator()(const f32x4 (&acc)[2][2][4][2], const Unit& u, int wr, int wc, int fr, int fq) const {
        const int row0 = u.pm * BM + wr * 64 + fr, col0 = u.pn * BM + wc * 32 + 8 * fq;
#pragma unroll
        for (int ai = 0; ai < 2; ++ai)
#pragma unroll
            for (int m = 0; m < 4; ++m) { bf16_t* rowp = O + (size_t)(row0 + ai * HALF + m * 16) * ldc + col0;
#pragma unroll
                for (int bj = 0; bj < 2; ++bj) { f32x4 v0 = acc[ai][bj][m][0], v1 = acc[ai][bj][m][1];
#pragma unroll
                    for (int e = 0; e < 4; ++e) { const float a0 = fmaxf(v0[e], 0.f), a1 = fmaxf(v1[e], 0.f); v0[e] = a0 * a0; v1[e] = a1 * a1; }
                    u32x4 w; w.x = cvt_pk_bf16(v0[0], v0[1]); w.y = cvt_pk_bf16(v0[2], v0[3]); w.z = cvt_pk_bf16(v1[0], v1[1]); w.w = cvt_pk_bf16(v1[2], v1[3]);
                    *(u32x4*)(rowp + bj * HALF) = w; } }
    }
};
struct EpiRes {
    static constexpr bool PERM = false, AFTER_DRAIN = false;
    const float* base; float* out; const float* gate;
    __device__ __forceinline__ void operator()(const f32x4 (&acc)[2][2][4][2], const Unit& u, int wr, int wc, int fr, int fq) const {
        const float* g = gate + (size_t)(u.pm >> 5) * 6144;
        const int col0 = u.pn * BM + wc * 32 + 4 * fq;
        f32x4 gv[2][2];
#pragma unroll
        for (int bj = 0; bj < 2; ++bj)
#pragma unroll
            for (int n = 0; n < 2; ++n) gv[bj][n] = *(const f32x4*)(g + col0 + bj * HALF + n * 16);
#pragma unroll
        for (int ai = 0; ai < 2; ++ai)
#pragma unroll
            for (int m = 0; m < 4; ++m) { const size_t off = (size_t)(u.pm * BM + ai * HALF + wr * 64 + m * 16 + fr) * 1024 + col0;
#pragma unroll
                for (int bj = 0; bj < 2; ++bj)
#pragma unroll
                    for (int n = 0; n < 2; ++n) { const f32x4 bs = *(const f32x4*)(base + off + bj * HALF + n * 16);
                        *(f32x4*)(out + off + bj * HALF + n * 16) = bs + gv[bj][n] * acc[ai][bj][m][n]; } }
    }
};
template <class Epi, class Sched, bool ALIGN_EPI = false, bool SP2 = false>
__device__ __forceinline__ void gemm_phase(PG8_LAS unsigned char* lds, const Gemm g, const Sched& S, const Epi& E, int tid_in) {
    int tid_l = tid_in; asm volatile("" : "+v"(tid_l));
    const int tid = tid_l, wid = __builtin_amdgcn_readfirstlane(tid >> 6), lane = tid & 63, wr = wid >> 2, wc = wid & 3, fr = lane & 15, fq = lane >> 4;
    const int K = g.K, nt = K / BK;
    unsigned voffA[2], voffB[2];
#pragma unroll
    for (int i = 0; i < 2; ++i) { int R, C; stage_rc(tid * 16 + i * 8192, R, C); const int Rb = Epi::PERM ? ((R & ~31) + perm32(R & 31)) : R;
        voffA[i] = (unsigned)(R * K + C) * 2u; voffB[i] = (unsigned)(Rb * K + C) * 2u; }
    const size_t kstep = (size_t)(BK * 2);
    const size_t hstep = (size_t)HALF * K * 2;
    const size_t tstep = 2 * hstep;
    const unsigned ldsw = (unsigned)wid * 1024u;
    const int aoff = lds_byte(wr * 64 + fr, fq * 8), boff = lds_byte(wc * 32 + fr, fq * 8);
#define PG8_SA(b, h) (((b) * 2 + (h)) * HTB)
#define PG8_SB(b, h) ((4 + (b) * 2 + (h)) * HTB)
#define PG8_STAGE(bufoff, gbase, voff) do { _Pragma("unroll") for (int _i = 0; _i < 2; ++_i) \
        __builtin_amdgcn_global_load_lds((const unsigned*)((const char*)(gbase) + (voff)[_i]), (PG8_LAS unsigned*)(lds + (bufoff) + ldsw + _i * 8192), 16, 0, 0); } while (0)
#define PG8_LDA(dst, b, h) do { _Pragma("unroll") for (int m = 0; m < 4; ++m) _Pragma("unroll") for (int k = 0; k < 2; ++k) dst[m][k] = *(const PG8_LAS bf16x8*)(lds + PG8_SA(b, h) + aoff + m * 2048 + k * 1024); } while (0)
#define PG8_LDB(dst, b, h) do { _Pragma("unroll") for (int n = 0; n < 2; ++n) _Pragma("unroll") for (int k = 0; k < 2; ++k) dst[n][k] = *(const PG8_LAS bf16x8*)(lds + PG8_SB(b, h) + boff + n * 2048 + k * 1024); } while (0)
#define PG8_MMA(ai, bj, At, Bt) do { __builtin_amdgcn_s_setprio(1); _Pragma("unroll") for (int m = 0; m < 4; ++m) _Pragma("unroll") for (int n = 0; n < 2; ++n) _Pragma("unroll") for (int k = 0; k < 2; ++k) \
        acc[ai][bj][m][n] = __builtin_amdgcn_mfma_f32_16x16x32_bf16(Bt[n][k], At[m][k], acc[ai][bj][m][n], 0, 0, 0); __builtin_amdgcn_s_setprio(0); } while (0)
#define PG8_WAIT_V(n) asm volatile("s_waitcnt vmcnt(" #n ")" ::: "memory")
#define PG8_WAIT_L(n) asm volatile("s_waitcnt lgkmcnt(" #n ")" ::: "memory")
#define PG8_BAR __builtin_amdgcn_s_barrier()
#define PG8_SCHED __builtin_amdgcn_sched_barrier(0)
    Unit cur, nxt; int ui = 0;
    if (!S.next(0, cur)) return;
    f32x4 acc[2][2][4][2];
#pragma unroll
    for (int a = 0; a < 2; ++a)
#pragma unroll
        for (int b = 0; b < 2; ++b)
#pragma unroll
            for (int m = 0; m < 4; ++m)
#pragma unroll
                for (int n = 0; n < 2; ++n) acc[a][b][m][n] = (f32x4){0.f, 0.f, 0.f, 0.f};
    bf16x8 At[4][2], B0[2][2], B1[2][2];
    const char* cA = (const char*)g.A + (size_t)cur.pm * tstep; const char* cB = (const char*)g.Bt + (size_t)cur.pn * tstep;
    S.a_ready(cur);
    if constexpr (SP2) {
        PG8_STAGE(PG8_SB(0, 0), cB, voffB); PG8_STAGE(PG8_SB(0, 1), cB + hstep, voffB); PG8_STAGE(PG8_SA(0, 0), cA, voffA); PG8_STAGE(PG8_SA(0, 1), cA + hstep, voffA);
        if (wr == 1) PG8_BAR;
        PG8_WAIT_V(2); PG8_BAR;
        PG8_STAGE(PG8_SB(1, 0), cB + kstep, voffB); PG8_STAGE(PG8_SA(1, 0), cA + kstep, voffA); PG8_STAGE(PG8_SB(1, 1), cB + hstep + kstep, voffB);
        PG8_WAIT_V(6); PG8_BAR;
    } else {
        PG8_STAGE(PG8_SB(0, 0), cB, voffB); PG8_STAGE(PG8_SA(0, 0), cA, voffA); PG8_STAGE(PG8_SB(0, 1), cB + hstep, voffB); PG8_STAGE(PG8_SA(0, 1), cA + hstep, voffA);
        if (wr == 1) PG8_BAR;
        PG8_WAIT_V(4); PG8_BAR;
        PG8_STAGE(PG8_SB(1, 0), cB + kstep, voffB); PG8_STAGE(PG8_SA(1, 0), cA + kstep, voffA); PG8_STAGE(PG8_SB(1, 1), cB + hstep + kstep, voffB);
        PG8_WAIT_V(6); PG8_BAR;
    }
    for (;;) {
        const bool has_next = S.next(ui + 1, nxt);
        const char* nA = has_next ? (const char*)g.A + (size_t)nxt.pm * tstep : cA; const char* nB = has_next ? (const char*)g.Bt + (size_t)nxt.pn * tstep : cB;
        for (int t = 0; t < nt; t += 2) {
            const bool last = (t == nt - 2);
            const char* a1 = cA + (size_t)(t + 1) * kstep;
            const char* a2 = last ? nA : cA + (size_t)(t + 2) * kstep; const char* b2 = last ? nB : cB + (size_t)(t + 2) * kstep;
            const char* a3 = a2 + kstep; const char* b3 = b2 + kstep;
            if (last && has_next) S.a_ready(nxt);
            if constexpr (SP2) {
            PG8_LDB(B0, 0, 0); PG8_LDB(B1, 0, 1); PG8_SCHED; PG8_LDA(At, 0, 0); PG8_STAGE(PG8_SA(1, 1), a1 + hstep, voffA);
            PG8_WAIT_V(8); PG8_WAIT_L(0); PG8_BAR; PG8_MMA(0, 0, At, B0); PG8_MMA(0, 1, At, B1); PG8_BAR; PG8_SCHED;
            PG8_LDA(At, 0, 1); PG8_STAGE(PG8_SB(0, 0), b2, voffB); PG8_STAGE(PG8_SB(0, 1), b2 + hstep, voffB); PG8_STAGE(PG8_SA(0, 0), a2, voffA);
            PG8_WAIT_V(8); PG8_WAIT_L(0); PG8_BAR; PG8_MMA(1, 0, At, B0); PG8_MMA(1, 1, At, B1); PG8_BAR; PG8_SCHED;
            PG8_LDB(B0, 1, 0); PG8_LDB(B1, 1, 1); PG8_SCHED; PG8_LDA(At, 1, 0); PG8_STAGE(PG8_SA(0, 1), a2 + hstep, voffA);
            PG8_WAIT_V(8); PG8_WAIT_L(0); PG8_BAR; PG8_MMA(0, 0, At, B0); PG8_MMA(0, 1, At, B1); PG8_BAR; PG8_SCHED;
            PG8_LDA(At, 1, 1); PG8_STAGE(PG8_SB(1, 0), b3, voffB); PG8_STAGE(PG8_SB(1, 1), b3 + hstep, voffB); PG8_STAGE(PG8_SA(1, 0), a3, voffA);
            PG8_WAIT_V(8); PG8_WAIT_L(0); PG8_BAR; PG8_MMA(1, 0, At, B0); PG8_MMA(1, 1, At, B1); PG8_BAR; PG8_SCHED;
            } else {
            PG8_LDB(B0, 0, 0); PG8_SCHED; PG8_LDA(At, 0, 0); PG8_STAGE(PG8_SA(1, 1), a1 + hstep, voffA);
            PG8_WAIT_L(8); PG8_BAR; PG8_WAIT_L(0); PG8_MMA(0, 0, At, B0); PG8_BAR; PG8_SCHED;
            PG8_LDB(B1, 0, 1); PG8_STAGE(PG8_SB(0, 0), b2, voffB);
            PG8_BAR; PG8_WAIT_L(0); PG8_MMA(0, 1, At, B1); PG8_BAR;
            PG8_LDA(At, 0, 1); PG8_STAGE(PG8_SA(0, 0), a2, voffA);
            PG8_BAR; PG8_WAIT_L(0); PG8_MMA(1, 0, At, B0); PG8_BAR; PG8_SCHED;
            PG8_STAGE(PG8_SB(0, 1), b2 + hstep, voffB);
            PG8_WAIT_V(6); PG8_BAR; PG8_MMA(1, 1, At, B1); PG8_BAR;
            PG8_LDB(B0, 1, 0); PG8_SCHED; PG8_LDA(At, 1, 0); PG8_STAGE(PG8_SA(0, 1), a2 + hstep, voffA);
            PG8_WAIT_L(8); PG8_BAR; PG8_WAIT_L(0); PG8_MMA(0, 0, At, B0); PG8_BAR; PG8_SCHED;
            PG8_LDB(B1, 1, 1); PG8_STAGE(PG8_SB(1, 0), b3, voffB);
            PG8_BAR; PG8_WAIT_L(0); PG8_MMA(0, 1, At, B1); PG8_BAR;
            PG8_LDA(At, 1, 1); PG8_STAGE(PG8_SA(1, 0), a3, voffA);
            PG8_BAR; PG8_WAIT_L(0); PG8_MMA(1, 0, At, B0); PG8_BAR; PG8_SCHED;
            PG8_STAGE(PG8_SB(1, 1), b3 + hstep, voffB);
            PG8_WAIT_V(6); PG8_BAR; PG8_MMA(1, 1, At, B1); PG8_BAR;
            }
        }
        if constexpr (ALIGN_EPI) { if (wr == 0) PG8_BAR; }
        if constexpr (!Epi::AFTER_DRAIN) { E(acc, cur, wr, wc, fr, fq); S.done(cur); }
        if (!has_next) break;
#pragma unroll
        for (int a = 0; a < 2; ++a)
#pragma unroll
            for (int b = 0; b < 2; ++b)
#pragma unroll
                for (int m = 0; m < 4; ++m)
#pragma unroll
                    for (int n = 0; n < 2; ++n) acc[a][b][m][n] = (f32x4){0.f, 0.f, 0.f, 0.f};
        cur = nxt; cA = nA; cB = nB; ++ui;
        if constexpr (ALIGN_EPI) { if (wr == 1) PG8_BAR; }
    }
    PG8_WAIT_V(0);
    if constexpr (!ALIGN_EPI) { if (wr == 0) PG8_BAR; }
    PG8_BAR;
    if constexpr (Epi::AFTER_DRAIN) { E.fused(acc, cur, wr, wc, fr, fq, lds, wid, lane); S.done(cur); }
#undef PG8_SA
#undef PG8_SB
#undef PG8_STAGE
#undef PG8_LDA
#undef PG8_LDB
#undef PG8_MMA
#undef PG8_WAIT_V
#undef PG8_WAIT_L
#undef PG8_BAR
#undef PG8_SCHED
}
}

constexpr int NB = 8, SEQ = 8192, DM = 1024, MTOK = NB * SEQ, INW = 2816, FF = 4096, NWAVES = 8;
constexpr size_t MiB = 1u << 20;
constexpr size_t WS_MOD = 0, WS_KMEAN = 512 * 1024;
constexpr size_t WS_WIN = 2 * MiB, WS_WOUT = 14 * MiB, WS_W1 = 18 * MiB, WS_W2 = 34 * MiB;
constexpr size_t WS_VTSB = 50 * MiB, WS_VTMB = 82 * MiB;
constexpr size_t WS_XN = 128 * MiB, WS_Y = 256 * MiB, WS_PROJ = 384 * MiB;
constexpr size_t WS_POUT = WS_XN;
constexpr size_t WS_PML = 896 * MiB, WS_QM = 904 * MiB, WS_SQ = 906 * MiB, WS_END = 908 * MiB;
constexpr int LDS_BYTES = 135168;
constexpr int N_PHASES = 21;

typedef unsigned short bf16;
typedef short bf16x8 __attribute__((ext_vector_type(8)));
typedef float f32x4 __attribute__((ext_vector_type(4)));
typedef float f32x2 __attribute__((ext_vector_type(2)));
typedef float f32x16 __attribute__((ext_vector_type(16)));
typedef unsigned u32x4 __attribute__((ext_vector_type(4)));
typedef unsigned u32x2 __attribute__((ext_vector_type(2)));
typedef __bf16 bf16x2_t __attribute__((ext_vector_type(2)));
#define LAS __attribute__((address_space(3)))
__device__ __forceinline__ unsigned pk2(float lo, float hi) { f32x2 v = {lo, hi}; bf16x2_t b = __builtin_convertvector(v, bf16x2_t); return __builtin_bit_cast(unsigned, b); }
__device__ __forceinline__ float bflo(unsigned w) { return __uint_as_float(w << 16); }
__device__ __forceinline__ float bfhi(unsigned w) { return __uint_as_float(w & 0xffff0000u); }
__device__ __forceinline__ void unpack8(const u32x4 w, float (&f)[8]) {
    f[0] = bflo(w.x); f[1] = bfhi(w.x); f[2] = bflo(w.y); f[3] = bfhi(w.y); f[4] = bflo(w.z); f[5] = bfhi(w.z); f[6] = bflo(w.w); f[7] = bfhi(w.w); }
__device__ __forceinline__ u32x4 pack8(const float (&f)[8]) { u32x4 w; w.x = pk2(f[0], f[1]); w.y = pk2(f[2], f[3]); w.z = pk2(f[4], f[5]); w.w = pk2(f[6], f[7]); return w; }
__device__ __forceinline__ float wave_sum(float v) {
#pragma unroll
    for (int o = 1; o < 64; o <<= 1) v += __shfl_xor(v, o);
    return v;
}
__device__ __forceinline__ float ex2(float x) { return __builtin_amdgcn_exp2f(x); }
__device__ __forceinline__ float lg2(float x) { return __builtin_amdgcn_logf(x); }

struct Args { const float* in[18]; float* out; unsigned char* ws; int ph_lo, ph_hi; };

__device__ __forceinline__ void p0_transpose_item(const float* W, int K, int N, bf16* WT, LAS float* scr, int item, int lane) {
    const int nblk = N / 32, kb = item / nblk, nb = item % nblk, k0 = 64 * kb, n0 = 32 * nb;
#pragma unroll 8
    for (int i = 0; i < 32; ++i) { const int kk = 2 * i + (lane >> 5); scr[kk * 33 + (lane & 31)] = W[(size_t)(k0 + kk) * N + n0 + (lane & 31)]; }
    asm volatile("s_waitcnt lgkmcnt(0)" ::: "memory");
    const int c = lane & 7;
#pragma unroll
    for (int j = 0; j < 4; ++j) { const int n = (lane >> 3) + 8 * j; const LAS float* s = scr + (8 * c) * 33 + n;
        u32x4 o; o.x = pk2(s[0 * 33], s[1 * 33]); o.y = pk2(s[2 * 33], s[3 * 33]); o.z = pk2(s[4 * 33], s[5 * 33]); o.w = pk2(s[6 * 33], s[7 * 33]);
        *(u32x4*)(WT + (size_t)(n0 + n) * K + k0 + 8 * c) = o; }
    asm volatile("s_waitcnt lgkmcnt(0)" ::: "memory");
}

__device__ __forceinline__ void p0_prologue(const Args& a, unsigned char* lds, int tid, int lane, int wave, int bx, int G) {
    {
        float* cact = (float*)lds;
        float* red = (float*)(lds + 32768);
        const float* c = a.in[1]; const float* w_ada = a.in[3]; const float* b_ada = a.in[4];
        float* mod = (float*)(a.ws + WS_MOD);
        if (bx < 192) { for (int i = tid; i < 8192; i += 512) { const float v = c[i]; cact[i] = v / (1.f + __expf(-v)); } }
        __syncthreads();
        for (int it = bx; it < 192; it += G) {
            const int l = it / 96, cgp = it % 96;
            const float* W = w_ada + (size_t)l * 1024 * 6144 + cgp * 64 + lane;
            float acc[8];
#pragma unroll
            for (int b = 0; b < 8; ++b) acc[b] = 0.f;
            for (int k = wave * 128; k < wave * 128 + 128; k += 4) {
                const float w0 = W[(size_t)k * 6144], w1 = W[(size_t)(k + 1) * 6144], w2 = W[(size_t)(k + 2) * 6144], w3 = W[(size_t)(k + 3) * 6144];
#pragma unroll
                for (int b = 0; b < 8; ++b) { const f32x4 cv = *(const f32x4*)(cact + b * 1024 + k); acc[b] += cv.x * w0 + cv.y * w1 + cv.z * w2 + cv.w * w3; }
            }
#pragma unroll
            for (int b = 0; b < 8; ++b) red[(wave * 8 + b) * 64 + lane] = acc[b];
            __syncthreads();
            { const int b = tid >> 6, j = tid & 63; float s = 0.f;
#pragma unroll
              for (int w = 0; w < 8; ++w) s += red[(w * 8 + b) * 64 + j];
              mod[(size_t)(l * 8 + b) * 6144 + cgp * 64 + j] = s + b_ada[l * 6144 + cgp * 64 + j]; }
            __syncthreads();
        }
        __syncthreads();
    }
    {
        LAS float* scr = (LAS float*)((LAS unsigned char*)lds + wave * 16384);
        const int gw = bx * NWAVES + wave, NGW = G * NWAVES;
        constexpr int I_IN = (DM / 64) * (INW / 32), I_OUT = (DM / 64) * (DM / 32), I_1 = (DM / 64) * (FF / 32), I_2 = (FF / 64) * (DM / 32);
        constexpr int PER_L = I_IN + I_OUT + I_1 + I_2;
        for (int it = gw; it < 2 * PER_L; it += NGW) {
            const int l = it / PER_L; int r = it % PER_L;
            if (r < I_IN) { p0_transpose_item(a.in[6] + (size_t)l * DM * INW, DM, INW, (bf16*)(a.ws + WS_WIN) + (size_t)l * INW * DM, scr, r, lane); continue; } r -= I_IN;
            if (r < I_OUT) { p0_transpose_item(a.in[14] + (size_t)l * DM * DM, DM, DM, (bf16*)(a.ws + WS_WOUT) + (size_t)l * DM * DM, scr, r, lane); continue; } r -= I_OUT;
            if (r < I_1) { p0_transpose_item(a.in[16] + (size_t)l * DM * FF, DM, FF, (bf16*)(a.ws + WS_W1) + (size_t)l * FF * DM, scr, r, lane); continue; } r -= I_1;
            p0_transpose_item(a.in[17] + (size_t)l * FF * DM, FF, DM, (bf16*)(a.ws + WS_W2) + (size_t)l * DM * FF, scr, r, lane);
        }
    }
}

__device__ __forceinline__ void norm_phase(const float* x, bf16* xn, const float* g, const float* mod_l, int shift_chunk, int gw, int NGW, int lane) {
    for (int r0 = gw * 32; r0 < MTOK; r0 += NGW * 32) {
        const float* mb = mod_l + (size_t)(r0 >> 13) * 6144 + shift_chunk * 1024;
        f32x4 gs[4], sh[4];
#pragma unroll
        for (int j = 0; j < 4; ++j) { const int c = 4 * lane + 256 * j; const f32x4 g4 = *(const f32x4*)(g + c), sc = *(const f32x4*)(mb + 1024 + c); sh[j] = *(const f32x4*)(mb + c); gs[j] = g4 * (1.f + sc); }
#pragma unroll 2
        for (int i = 0; i < 32; ++i) {
            const float* xr = x + (size_t)(r0 + i) * DM + 4 * lane;
            f32x4 v[4]; float ss = 0.f;
#pragma unroll
            for (int j = 0; j < 4; ++j) { v[j] = *(const f32x4*)(xr + 256 * j); ss += (v[j].x * v[j].x + v[j].y * v[j].y) + (v[j].z * v[j].z + v[j].w * v[j].w); }
            const float rstd = rsqrtf(wave_sum(ss) * (1.f / DM) + 1e-6f);
            bf16* orow = xn + (size_t)(r0 + i) * DM + 4 * lane;
#pragma unroll
            for (int j = 0; j < 4; ++j) { const f32x4 o = v[j] * rstd * gs[j] + sh[j]; u32x2 w; w.x = pk2(o.x, o.y); w.y = pk2(o.z, o.w); *(u32x2*)(orow + 256 * j) = w; }
        }
    }
}

__device__ __forceinline__ void sc_item(const bf16* proj, bf16* Y, const float* wsc, int item, int tid) {
    const int cgp = tid & 31, ts = tid >> 5;
    float w[3][8];
#pragma unroll
    for (int k = 0; k < 3; ++k)
#pragma unroll
        for (int e = 0; e < 8; ++e) w[k][e] = wsc[k * 256 + cgp * 8 + e];
    const int r0 = item * 64;
#pragma unroll
    for (int p = 0; p < 4; ++p) {
        const int row = r0 + p * 16 + ts, t = row & (SEQ - 1);
        const bf16* pr = proj + (size_t)row * INW + cgp * 8;
        const u32x4 Bv = *(const u32x4*)pr;
        float acc[8];
#pragma unroll
        for (int e = 0; e < 8; ++e) acc[e] = 0.f;
#pragma unroll
        for (int k = 0; k < 3; ++k) { const int dt = 2 - k;
            if (t - dt >= 0) { const bf16* q = pr - (size_t)dt * INW; const u32x4 Cv = *(const u32x4*)(q + 256), Hv = *(const u32x4*)(q + 512); float c[8], h[8]; unpack8(Cv, c); unpack8(Hv, h);
#pragma unroll
                for (int e = 0; e < 8; ++e) acc[e] += w[k][e] * (c[e] * h[e]); } }
        float bb[8]; unpack8(Bv, bb);
#pragma unroll
        for (int e = 0; e < 8; ++e) bb[e] *= acc[e];
        *(u32x4*)(Y + (size_t)row * DM + cgp * 8) = pack8(bb);
    }
}

__device__ __forceinline__ void cf_item(const bf16* proj, bf16* Y, const float* wcc, const float* bcc, const float* gcl, const float* bcl, unsigned char* lds, int item, int tid, int lane, int wave) {
    float* U = (float*)lds;
    float* CO = (float*)(lds + 62 * 256 * 4);
    const int r0 = item * 32, t0 = r0 & (SEQ - 1);
    for (int idx = tid; idx < 62 * 32; idx += 512) {
        const int rr = idx >> 5, cgp = idx & 31, t = t0 - 30 + rr;
        float u[8];
#pragma unroll
        for (int e = 0; e < 8; ++e) u[e] = 0.f;
        if (t >= 0) { const bf16* p = proj + (size_t)(r0 - 30 + rr) * INW + 2304 + cgp * 8; const u32x4 av = *(const u32x4*)p, gv = *(const u32x4*)(p + 256); float aa[8], gg[8]; unpack8(av, aa); unpack8(gv, gg);
#pragma unroll
            for (int e = 0; e < 8; ++e) u[e] = aa[e] / (1.f + __expf(-gg[e])); }
        *(f32x4*)(U + rr * 256 + cgp * 8) = (f32x4){u[0], u[1], u[2], u[3]}; *(f32x4*)(U + rr * 256 + cgp * 8 + 4) = (f32x4){u[4], u[5], u[6], u[7]};
    }
    __syncthreads();
    {
        const int ch = tid & 255, half = tid >> 8;
        float w[31];
#pragma unroll
        for (int k = 0; k < 31; ++k) w[k] = wcc[k * 256 + ch];
        float uu[46];
#pragma unroll
        for (int i = 0; i < 46; ++i) uu[i] = U[(half * 16 + i) * 256 + ch];
        const float bias = bcc[ch];
#pragma unroll
        for (int tt = 0; tt < 16; ++tt) { float acc = bias;
#pragma unroll
            for (int k = 0; k < 31; ++k) acc += w[k] * uu[tt + k];
            CO[(half * 16 + tt) * 256 + ch] = acc; }
    }
    __syncthreads();
    {
        const f32x4 g4 = *(const f32x4*)(gcl + lane * 4), b4 = *(const f32x4*)(bcl + lane * 4);
#pragma unroll
        for (int i = 0; i < 4; ++i) { const int tl = wave * 4 + i;
            const f32x4 v = *(const f32x4*)(CO + tl * 256 + lane * 4);
            const float mean = wave_sum((v.x + v.y) + (v.z + v.w)) * (1.f / 256.f);
            const f32x4 d = v - mean;
            const float var = wave_sum((d.x * d.x + d.y * d.y) + (d.z * d.z + d.w * d.w)) * (1.f / 256.f);
            const float rstd = rsqrtf(var + 1e-6f);
            f32x4 y = d * rstd * g4 + b4;
            y.x = y.x / (1.f + __expf(-y.x)); y.y = y.y / (1.f + __expf(-y.y)); y.z = y.z / (1.f + __expf(-y.z)); y.w = y.w / (1.f + __expf(-y.w));
            u32x2 w2; w2.x = pk2(y.x, y.y); w2.y = pk2(y.z, y.w);
            *(u32x2*)(Y + (size_t)(r0 + tl) * DM + 768 + lane * 4) = w2; }
    }
    __syncthreads();
}

constexpr float C2 = 0.125f * 1.4426950408889634f;
__device__ __forceinline__ void prep_item(bf16* proj, const int* positions, const float* gq, const float* gk, float* kmean, unsigned char* lds, int item, int tid) {
    f32x2* cs = (f32x2*)lds;
    float* kacc = (float*)(lds + 4096);
    const int b = item >> 5, n = item & 31;
    const int g = tid >> 3, j = tid & 7, tk = g >> 2, h = g & 3;
    if (tid < 256) kacc[tid] = 0.f;
    float gqv[8], gkv[8], ksum[8];
#pragma unroll
    for (int e = 0; e < 8; ++e) { gqv[e] = gq[8 * j + e]; gkv[e] = gk[8 * j + e]; ksum[e] = 0.f; }
    const int f_t = tid & 31, tk_t = tid >> 5;
    const float inv_freq = expf((-9.210340371976184f * (float)f_t) / 32.0f);
    for (int p = 0; p < 16; ++p) {
        const int rowb = b * SEQ + n * 256 + p * 16;
        { const int pos = positions[rowb + tk_t]; const float ang = (float)pos * inv_freq;
          double rev = (double)ang * 0.15915494309189535; rev -= floor(rev); const float rf = (float)rev;
          cs[tk_t * 32 + f_t] = (f32x2){__builtin_amdgcn_cosf(rf), __builtin_amdgcn_sinf(rf)}; }
        __syncthreads();
#pragma unroll
        for (int which = 0; which < 2; ++which) {
            bf16* ptr = proj + (size_t)(rowb + tk) * INW + (which ? 1792 : 1536) + h * 64 + j * 8;
            float v[8]; unpack8(*(const u32x4*)ptr, v);
            float ss = 0.f;
#pragma unroll
            for (int e = 0; e < 8; ++e) ss += v[e] * v[e];
            ss += __shfl_xor(ss, 1); ss += __shfl_xor(ss, 2); ss += __shfl_xor(ss, 4);
            const float rstd = rsqrtf(ss * (1.f / 64.f) + 1e-6f);
            float o[8];
#pragma unroll
            for (int e = 0; e < 8; ++e) { const float y = v[e] * rstd * (which ? gkv[e] : gqv[e]); const float pt = __shfl_xor(y, 4); const f32x2 c = cs[tk * 32 + ((8 * j + e) & 31)];
                o[e] = (j < 4) ? (y * c.x - pt * c.y) : (y * c.x + pt * c.y); }
            if (which == 0) {
#pragma unroll
                for (int e = 0; e < 8; ++e) o[e] *= C2;
            } else {
#pragma unroll
                for (int e = 0; e < 8; ++e) ksum[e] += o[e];
            }
            *(u32x4*)ptr = pack8(o);
        }
        __syncthreads();
    }
#pragma unroll
    for (int e = 0; e < 8; ++e) atomicAdd(&kacc[h * 64 + 8 * j + e], ksum[e]);
    __syncthreads();
    if (tid < 256) kmean[((size_t)(b * 4 + (tid >> 6)) * 32 + n) * 64 + (tid & 63)] = kacc[tid] * (1.f / 256.f);
    __syncthreads();
}

#define MFMA32(a, b, c) __builtin_amdgcn_mfma_f32_32x32x16_bf16((a), (b), (c), 0, 0, 0)
__device__ __forceinline__ int kperm(int rho) { return (rho & 19) | ((rho & 4) << 1) | ((rho & 8) >> 1); }
__device__ __forceinline__ constexpr int kidx(int r, int hi) { return (r & 7) + 8 * hi + 16 * (r >> 3); }
__device__ __forceinline__ constexpr int crow(int r, int hi) { return (r & 3) + 8 * (r >> 2) + 4 * hi; }
constexpr float NEG = -1e30f;

__device__ __forceinline__ void load_k(bf16x8 (&kf)[4], const bf16* Kb, int key0, int lane) {
    const bf16* p = Kb + (size_t)(key0 + kperm(lane & 31)) * INW + (lane >> 5) * 8;
#pragma unroll
    for (int kk = 0; kk < 4; ++kk) kf[kk] = *(const bf16x8*)(p + 16 * kk);
}
__device__ __forceinline__ void load_v(bf16x8 (&vf)[4], const bf16* VTb, int key0, int lane) {
    const bf16* p = VTb + (size_t)(lane & 31) * SEQ + key0 + 8 * (lane >> 5);
    vf[0] = *(const bf16x8*)p; vf[1] = *(const bf16x8*)(p + 16); vf[2] = *(const bf16x8*)(p + 32 * SEQ); vf[3] = *(const bf16x8*)(p + 32 * SEQ + 16);
}
__device__ __forceinline__ void load_q(bf16x8 (&qf)[4], const bf16* Qrow0, int lane) {
    const bf16* p = Qrow0 + (size_t)(lane & 31) * INW + 8 * (lane >> 5);
#pragma unroll
    for (int kk = 0; kk < 4; ++kk) qf[kk] = *(const bf16x8*)(p + 16 * kk);
}
__device__ __forceinline__ void pv_acc(f32x16 (&o)[2], const bf16x8 (&vf)[4], const float (&a)[16]) {
    u32x4 w0, w1;
    w0.x = pk2(a[0], a[1]); w0.y = pk2(a[2], a[3]); w0.z = pk2(a[4], a[5]); w0.w = pk2(a[6], a[7]);
    w1.x = pk2(a[8], a[9]); w1.y = pk2(a[10], a[11]); w1.z = pk2(a[12], a[13]); w1.w = pk2(a[14], a[15]);
    const bf16x8 p0 = __builtin_bit_cast(bf16x8, w0), p1 = __builtin_bit_cast(bf16x8, w1);
    o[0] = MFMA32(vf[0], p0, o[0]); o[0] = MFMA32(vf[1], p1, o[0]);
    o[1] = MFMA32(vf[2], p0, o[1]); o[1] = MFMA32(vf[3], p1, o[1]);
}
__device__ __forceinline__ void store_o_p(bf16* p, const f32x16 (&o)[2], float sc) {
#pragma unroll
    for (int dh = 0; dh < 2; ++dh)
#pragma unroll
        for (int g4 = 0; g4 < 4; ++g4) { u32x2 w; w.x = pk2(o[dh][4 * g4] * sc, o[dh][4 * g4 + 1] * sc); w.y = pk2(o[dh][4 * g4 + 2] * sc, o[dh][4 * g4 + 3] * sc); *(u32x2*)(p + dh * 32 + 8 * g4) = w; }
}
__device__ __forceinline__ void store_o(bf16* Yb, const f32x16 (&o)[2], float sc, int lane) { store_o_p(Yb + (size_t)(lane & 31) * DM + 4 * (lane >> 5), o, sc); }

constexpr float SBSC = 0.125f * 1.4426950408889634f, SBTH = -160.f;
template <bool DIAG> __device__ __forceinline__ void sb_qt(const bf16x8 (&kf)[4], const bf16x8 (&vf)[4], const bf16x8 (&qf)[4], f32x16 (&o)[2], float& carry, int ql, int hi) {
    f32x16 s = {};
#pragma unroll
    for (int kk = 0; kk < 4; ++kk) s = MFMA32(kf[kk], qf[kk], s);
    float L[16], zl[16];
    float lo = 0.f, up = 0.f;
#pragma unroll
    for (int r = 0; r < 16; ++r) { const float z = s[r] * SBSC; const float e = ex2(-fabsf(z)); const float sp = fmaxf(z, 0.f) + lg2(1.f + e);
        const bool valid = !DIAG || (kidx(r, hi) < ql);
        L[r] = valid ? -sp : 0.f; zl[r] = valid ? (z - sp) : -INFINITY;
        if (r < 8) lo += L[r]; else up += L[r]; }
    const float plo = __shfl_xor(lo, 32), pup = __shfl_xor(up, 32);
    const float offU = hi ? carry : carry + pup;
    const float offL = hi ? (carry + up + pup) : (carry + pup + up + plo);
    carry += (lo + plo) + (up + pup);
    float a[16];
    float run = offU;
#pragma unroll
    for (int r = 15; r >= 8; --r) { a[r] = ex2(zl[r] + run); run += L[r]; }
    run = offL;
#pragma unroll
    for (int r = 7; r >= 0; --r) { a[r] = ex2(zl[r] + run); run += L[r]; }
    pv_acc(o, vf, a);
}
__device__ __forceinline__ void sb_item(const bf16* proj, const bf16* vt, bf16* Y, int bh, int qt, int lane) {
    const int b = bh >> 2, h = bh & 3, hi = lane >> 5, ql = lane & 31, q0r = qt * 32;
    const bf16* Qb = proj + (size_t)b * SEQ * INW + 768 + h * 64;
    const bf16* Kb = proj + (size_t)b * SEQ * INW + 1024 + h * 64;
    const bf16* VTb = vt + (size_t)bh * 64 * SEQ;
    bf16x8 q[4]; load_q(q, Qb + (size_t)q0r * INW, lane);
    f32x16 o[2] = {}; float c = 0.f;
    bf16x8 kf[4], vf[4];
    load_k(kf, Kb, q0r, lane); load_v(vf, VTb, q0r, lane);
    sb_qt<true>(kf, vf, q, o, c, ql, hi);
    for (int key0 = q0r - 32; key0 >= 0; key0 -= 32) {
        if (__all(c < SBTH)) break;
        load_k(kf, Kb, key0, lane); load_v(vf, VTb, key0, lane);
        sb_qt<false>(kf, vf, q, o, c, ql, hi);
    }
    store_o(Y + (size_t)(b * SEQ + q0r) * DM + 256 + h * 64, o, 1.f, lane);
}

template <int MODE  > __device__ __forceinline__ void mb_qt(const bf16x8 (&kf)[4], const bf16x8 (&vf)[4], const bf16x8 (&qf)[4], f32x16 (&o)[2], float& mref, float& lsum, bool sel, int ql, int hi) {
    f32x16 s = {};
#pragma unroll
    for (int kk = 0; kk < 4; ++kk) s = MFMA32(kf[kk], qf[kk], s);
    if (MODE == 2) {
#pragma unroll
        for (int r = 0; r < 16; ++r) if (kidx(r, hi) > ql) s[r] = NEG;
    }
    float tm = s[0];
#pragma unroll
    for (int r = 1; r < 16; ++r) tm = fmaxf(tm, s[r]);
    tm = fmaxf(tm, __shfl_xor(tm, 32));
    tm = sel ? tm : NEG;
    if (__any(tm > mref + 16.f)) { const float mn = fmaxf(mref, tm), al = ex2(mref - mn); lsum *= al; o[0] *= al; o[1] *= al; mref = mn; }
    const float me = sel ? mref : INFINITY;
    float p[16];
#pragma unroll
    for (int r = 0; r < 16; ++r) { p[r] = ex2(s[r] - me); lsum += p[r]; }
    pv_acc(o, vf, p);
}
__device__ __forceinline__ unsigned topk_mask(const float* km, const bf16x8 (&qf)[4], int own, int lane) {
    const int hi = lane >> 5;
    f32x16 g = {};
#pragma unroll
    for (int kk = 0; kk < 4; ++kk) { const float* kp = km + (lane & 31) * 64 + 16 * kk + 8 * hi; const f32x4 x0 = *(const f32x4*)kp, x1 = *(const f32x4*)(kp + 4);
        u32x4 wh; wh.x = pk2(x0.x, x0.y); wh.y = pk2(x0.z, x0.w); wh.z = pk2(x1.x, x1.y); wh.w = pk2(x1.z, x1.w);
        u32x4 wl; wl.x = pk2(x0.x - bflo(wh.x), x0.y - bfhi(wh.x)); wl.y = pk2(x0.z - bflo(wh.y), x0.w - bfhi(wh.y)); wl.z = pk2(x1.x - bflo(wh.z), x1.y - bfhi(wh.z)); wl.w = pk2(x1.z - bflo(wh.w), x1.w - bfhi(wh.w));
        g = MFMA32(__builtin_bit_cast(bf16x8, wh), qf[kk], g); g = MFMA32(__builtin_bit_cast(bf16x8, wl), qf[kk], g); }
    float gv[16];
#pragma unroll
    for (int r = 0; r < 16; ++r) gv[r] = (crow(r, hi) < own) ? g[r] : NEG;
    unsigned mask = 0u;
#pragma unroll
    for (int round = 0; round < 3; ++round) {
        float bm = gv[0]; int bi = crow(0, hi);
#pragma unroll
        for (int r = 1; r < 16; ++r) if (gv[r] > bm) { bm = gv[r]; bi = crow(r, hi); }
        const float pm = __shfl_xor(bm, 32); const int pi = __shfl_xor(bi, 32);
        const bool takep = (pm > bm) || (pm == bm && pi < bi);
        const float cm = takep ? pm : bm; const int ci = takep ? pi : bi;
        if (cm > -1e29f) mask |= 1u << ci;
#pragma unroll
        for (int r = 0; r < 16; ++r) if (crow(r, hi) == ci) gv[r] = NEG;
    }
    return mask;
}
__device__ __forceinline__ void moba_select(const bf16* proj, const float* kmean, unsigned* QM, unsigned long long* SQ, int bh, int chunk, int lane) {
    const int b = bh >> 2, h = bh & 3, qstart = chunk * 64, own = chunk >> 2;
    const bf16* Qb = proj + (size_t)b * SEQ * INW + 1536 + h * 64;
    unsigned m0 = 0u, m1 = 0u;
    if (own > 0) { bf16x8 q0[4], q1[4]; load_q(q0, Qb + (size_t)qstart * INW, lane); load_q(q1, Qb + (size_t)(qstart + 32) * INW, lane);
        m0 = topk_mask(kmean + (size_t)bh * 32 * 64, q0, own, lane); m1 = topk_mask(kmean + (size_t)bh * 32 * 64, q1, own, lane); }
    if (lane < 32) { QM[(size_t)bh * SEQ + qstart + lane] = m0; QM[(size_t)bh * SEQ + qstart + 32 + lane] = m1; }
    unsigned long long mine = 0ull;
#pragma unroll
    for (int n = 0; n < 32; ++n) { const unsigned long long b0 = __ballot((m0 >> n) & 1u) & 0xffffffffull, b1 = __ballot((m1 >> n) & 1u) & 0xffffffffull; const unsigned long long v = b0 | (b1 << 32); if (lane == n) mine = v; }
    if (lane < 32) SQ[((size_t)bh * 128 + chunk) * 32 + lane] = mine;
}
__device__ __forceinline__ int select_nth(unsigned long long m, int r) {
    int pos = 0; unsigned w = (unsigned)m; int c = __popc(w);
    if (r >= c) { r -= c; w = (unsigned)(m >> 32); pos = 32; }
    c = __popc(w & 0xffffu); if (r >= c) { r -= c; w >>= 16; pos += 16; }
    c = __popc(w & 0xffu); if (r >= c) { r -= c; w >>= 8; pos += 8; }
    c = __popc(w & 0xfu); if (r >= c) { r -= c; w >>= 4; pos += 4; }
    c = __popc(w & 3u); if (r >= c) { r -= c; w >>= 2; pos += 2; }
    if (r >= (int)(w & 1u)) pos += 1;
    return pos;
}
__device__ __forceinline__ void moba_past(const bf16* proj, const bf16* vt, const unsigned* QM, const unsigned long long* SQ, bf16* POUT, f32x2* PML, int bh, int w, int lane) {
    const int b = bh >> 2, h = bh & 3, hi = lane >> 5, ql = lane & 31;
    const bf16* Qb = proj + (size_t)b * SEQ * INW + 1536 + h * 64;
    const bf16* Kb = proj + (size_t)b * SEQ * INW + 1792 + h * 64;
    const bf16* VTb = vt + (size_t)bh * 64 * SEQ;
    const unsigned long long* sq = SQ + (size_t)bh * 128 * 32;
    int gbase = 0;
    for (int n = 0; n < 31; ++n) {
        const int c0 = 2 * lane;
        const unsigned long long m0 = (c0 >= 4 * (n + 1)) ? sq[c0 * 32 + n] : 0ull;
        const unsigned long long m1 = (c0 + 1 >= 4 * (n + 1)) ? sq[(c0 + 1) * 32 + n] : 0ull;
        const int cA = __popcll(m0), tot = cA + __popcll(m1);
        int incl = tot;
#pragma unroll
        for (int o = 1; o < 64; o <<= 1) { const int t = __shfl_up(incl, o); if (lane >= o) incl += t; }
        const int ex = incl - tot, T = __builtin_amdgcn_readlane(incl, 63);
        const int ntile = (T + 31) >> 5;
        for (int k = (w - gbase) & 63; k < ntile; k += 64) {
            const int p = 32 * k + ql;
            unsigned long long cand = __ballot(tot > 0 && ex < 32 * k + 32 && ex + tot > 32 * k);
            int qidx = (n + 1) * 256;
            while (cand) {
                const int j = __ffsll((long long)cand) - 1; cand &= cand - 1ull;
                const int exj = __builtin_amdgcn_readlane(ex, j), totj = __builtin_amdgcn_readlane(tot, j), cAj = __builtin_amdgcn_readlane(cA, j);
                const unsigned m0lo = __builtin_amdgcn_readlane((unsigned)m0, j), m0hi = __builtin_amdgcn_readlane((unsigned)(m0 >> 32), j);
                const unsigned m1lo = __builtin_amdgcn_readlane((unsigned)m1, j), m1hi = __builtin_amdgcn_readlane((unsigned)(m1 >> 32), j);
                if (p >= exj && p < exj + totj) { int r = p - exj; unsigned long long mm = ((unsigned long long)m0hi << 32) | m0lo; int ch = 2 * j;
                    if (r >= cAj) { r -= cAj; mm = ((unsigned long long)m1hi << 32) | m1lo; ch += 1; }
                    qidx = ch * 64 + select_nth(mm, r); }
            }
            const bool valid = p < T;
            bf16x8 q[4];
            { const bf16* qp = Qb + (size_t)qidx * INW + 8 * hi;
#pragma unroll
              for (int kk = 0; kk < 4; ++kk) q[kk] = *(const bf16x8*)(qp + 16 * kk); }
            f32x16 o[2] = {}; float mref = NEG, lsum = 0.f;
            bf16x8 kf[4], vf[4];
            for (int t = 0; t < 8; ++t) { load_k(kf, Kb, n * 256 + 32 * t, lane); load_v(vf, VTb, n * 256 + 32 * t, lane); mb_qt<1>(kf, vf, q, o, mref, lsum, true, ql, hi); }
            lsum += __shfl_xor(lsum, 32);
            if (valid) { const unsigned qm = QM[(size_t)bh * SEQ + qidx]; const int slot = __popc(qm & ((1u << n) - 1u));
                const size_t pi = ((size_t)bh * SEQ + qidx) * 3 + slot;
                store_o_p(POUT + pi * 64 + 4 * hi, o, 1.f / lsum);
                if (hi == 0) PML[pi] = (f32x2){mref, lsum}; }
        }
        gbase += ntile;
    }
}
__device__ __forceinline__ void moba_own(const bf16* proj, const bf16* vt, const bf16* POUT, const f32x2* PML, bf16* Y, int bh, int qt, int lane) {
    const int b = bh >> 2, h = bh & 3, hi = lane >> 5, ql = lane & 31, q0r = qt * 32, own = qt >> 3;
    const bf16* Qb = proj + (size_t)b * SEQ * INW + 1536 + h * 64;
    const bf16* Kb = proj + (size_t)b * SEQ * INW + 1792 + h * 64;
    const bf16* VTb = vt + (size_t)bh * 64 * SEQ;
    bf16x8 q[4]; load_q(q, Qb + (size_t)q0r * INW, lane);
    f32x16 o[2] = {}; float mref = NEG, lsum = 0.f;
    bf16x8 kf[4], vf[4];
    load_k(kf, Kb, q0r, lane); load_v(vf, VTb, q0r, lane);
    mb_qt<2>(kf, vf, q, o, mref, lsum, true, ql, hi);
    for (int key0 = own * 256; key0 < q0r; key0 += 32) { load_k(kf, Kb, key0, lane); load_v(vf, VTb, key0, lane); mb_qt<1>(kf, vf, q, o, mref, lsum, true, ql, hi); }
    lsum += __shfl_xor(lsum, 32);
    const int ns = own < 3 ? own : 3;
    const size_t pi = ((size_t)bh * SEQ + q0r + ql) * 3;
    f32x2 ml[3]; float M = mref;
#pragma unroll
    for (int s = 0; s < 3; ++s) { ml[s] = (f32x2){NEG, 0.f}; if (s < ns) { ml[s] = PML[pi + s]; M = fmaxf(M, ml[s].x); } }
    const float wown = ex2(mref - M); float den = lsum * wown;
    o[0] *= wown; o[1] *= wown;
#pragma unroll
    for (int s = 0; s < 3; ++s) if (s < ns) { const float wsl = ml[s].y * ex2(ml[s].x - M); den += wsl; const bf16* ps = POUT + (pi + s) * 64 + 4 * hi;
#pragma unroll
        for (int dh = 0; dh < 2; ++dh)
#pragma unroll
            for (int g4 = 0; g4 < 4; ++g4) { const u32x2 v = *(const u32x2*)(ps + dh * 32 + 8 * g4);
                o[dh][4 * g4] += wsl * bflo(v.x); o[dh][4 * g4 + 1] += wsl * bfhi(v.x); o[dh][4 * g4 + 2] += wsl * bflo(v.y); o[dh][4 * g4 + 3] += wsl * bfhi(v.y); } }
    store_o(Y + (size_t)(b * SEQ + q0r) * DM + 512 + h * 64, o, 1.f / den, lane);
}

#ifndef MK_PER_PHASE
#define MK_PER_PHASE 0
#endif
__global__ void __launch_bounds__(NWAVES * 64, 2) hybrid_fwd(Args a) {
    extern __shared__ __attribute__((aligned(16))) unsigned char lds[];
    cg::grid_group grid = cg::this_grid();
    const int G = gridDim.x, bx = blockIdx.x;
    const int wave0 = __builtin_amdgcn_readfirstlane((int)threadIdx.x >> 6);
#define PHASE_IDS int lane = (int)__builtin_amdgcn_mbcnt_hi(~0u, __builtin_amdgcn_mbcnt_lo(~0u, 0u)); asm volatile("" : "+v"(lane)); const int wave = wave0; const int tid = wave * 64 + lane; const int gw = bx * NWAVES + wave; (void)tid; (void)gw;
    const int vcu = (G % 8 == 0) ? (bx % 8) * (G / 8) + bx / 8 : bx;
    const int NGW = G * NWAVES;
    unsigned char* ws = a.ws;
    float* mod = (float*)(ws + WS_MOD);
    float* kmean = (float*)(ws + WS_KMEAN);
    bf16* XN = (bf16*)(ws + WS_XN); bf16* Yb = (bf16*)(ws + WS_Y); bf16* PROJ = (bf16*)(ws + WS_PROJ); bf16* HB = (bf16*)(ws + WS_PROJ);
    bf16* VTSB = (bf16*)(ws + WS_VTSB); bf16* VTMB = (bf16*)(ws + WS_VTMB);
    bf16* POUT = (bf16*)(ws + WS_POUT); f32x2* PML = (f32x2*)(ws + WS_PML); unsigned* QM = (unsigned*)(ws + WS_QM); unsigned long long* SQ = (unsigned long long*)(ws + WS_SQ);
    const int lo = a.ph_lo, hi_ = a.ph_hi; (void)lo; (void)hi_;
#if MK_PER_PHASE
#define IN(k) (lo <= (k) && (k) < hi_)
#define SEAM(k) do { if (IN(k) && IN((k) + 1)) grid.sync(); } while (0)
#else
#define IN(k) true
#define SEAM(k) grid.sync()
#endif

#ifndef NO_P0
    if (IN(0)) { PHASE_IDS p0_prologue(a, lds, tid, lane, wave, bx, G); }
#endif
    SEAM(0);
    for (int l = 0; l < 2; ++l) {
        const int pb = 1 + 10 * l;
        const float* mod_l = mod + (size_t)l * 8 * 6144;
        const float* xin = (l == 0) ? a.in[0] : a.out;
        if (IN(pb + 0)) { PHASE_IDS norm_phase(xin, XN, a.in[5] + l * DM, mod_l, 0, gw, NGW, lane); }
        SEAM(pb + 0);
        if (IN(pb + 1)) { PHASE_IDS
            pg8::Gemm g{XN, (const bf16*)(ws + WS_WIN) + (size_t)l * INW * DM, MTOK, INW, DM}; pg8::StaticOrder S; S.init(MTOK, INW, G, bx);
            pg8::EpiProj E{PROJ, INW, VTSB, VTMB};
#ifndef NO_G1
            pg8::gemm_phase<pg8::EpiProj, pg8::StaticOrder, true, true>((PG8_LAS unsigned char*)lds, g, S, E, tid);
#endif
        }
        SEAM(pb + 1);
        if (IN(pb + 2)) { PHASE_IDS
#ifndef NO_PREP
            for (int it = bx; it < 256; it += G) prep_item(PROJ, (const int*)a.in[2], a.in[12] + l * 64, a.in[13] + l * 64, kmean, lds, it, tid);
#endif
#ifndef NO_CF
            for (int it = bx; it < MTOK / 32; it += G) cf_item(PROJ, Yb, a.in[8] + l * 31 * 256, a.in[9] + l * 256, a.in[10] + l * 256, a.in[11] + l * 256, lds, it, tid, lane, wave);
#endif
#ifndef NO_SC
            for (int it = bx; it < MTOK / 64; it += G) sc_item(PROJ, Yb, a.in[7] + l * 3 * 256, it, tid);
#endif
#ifndef NO_SB
            for (int it = vcu * NWAVES + wave; it < 32 * 256; it += NGW) sb_item(PROJ, VTSB, Yb, it >> 8, it & 255, lane);
#endif
        }
        SEAM(pb + 2);
        if (IN(pb + 3)) { PHASE_IDS
#ifndef NO_MOBA
            for (int it = vcu * NWAVES + wave; it < 32 * 128; it += NGW) moba_select(PROJ, kmean, QM, SQ, it >> 7, it & 127, lane);
#endif
        }
        SEAM(pb + 3);
        if (IN(pb + 4)) { PHASE_IDS
#ifndef NO_MOBA
            for (int wi = vcu * NWAVES + wave; wi < 32 * 64; wi += NGW) moba_past(PROJ, VTMB, QM, SQ, POUT, PML, wi >> 6, wi & 63, lane);
#endif
        }
        SEAM(pb + 4);
        if (IN(pb + 5)) { PHASE_IDS
#ifndef NO_MOBA
            for (int it = vcu * NWAVES + wave; it < 32 * 256; it += NGW) moba_own(PROJ, VTMB, POUT, PML, Yb, it >> 8, it & 255, lane);
#endif
        }
        SEAM(pb + 5);
        if (IN(pb + 6)) { PHASE_IDS
            pg8::Gemm g{Yb, (const bf16*)(ws + WS_WOUT) + (size_t)l * DM * DM, MTOK, DM, DM}; pg8::StaticOrder S; S.init(MTOK, DM, G, bx);
            pg8::EpiRes E{xin, a.out, mod_l + 2 * 1024};
#ifndef NO_G2
            pg8::gemm_phase<pg8::EpiRes, pg8::StaticOrder, true, true>((PG8_LAS unsigned char*)lds, g, S, E, tid);
#endif
        }
        SEAM(pb + 6);
        if (IN(pb + 7)) { PHASE_IDS norm_phase(a.out, XN, a.in[15] + l * DM, mod_l, 3, gw, NGW, lane); }
        SEAM(pb + 7);
        if (IN(pb + 8)) { PHASE_IDS
            pg8::Gemm g{XN, (const bf16*)(ws + WS_W1) + (size_t)l * FF * DM, MTOK, FF, DM}; pg8::StaticOrder S; S.init(MTOK, FF, G, bx);
            pg8::EpiRelu2 E{HB, FF};
#ifndef NO_G3
            pg8::gemm_phase<pg8::EpiRelu2, pg8::StaticOrder, true, true>((PG8_LAS unsigned char*)lds, g, S, E, tid);
#endif
        }
        SEAM(pb + 8);
        if (IN(pb + 9)) { PHASE_IDS
            pg8::Gemm g{HB, (const bf16*)(ws + WS_W2) + (size_t)l * DM * FF, MTOK, DM, FF}; pg8::StaticOrder S; S.init(MTOK, DM, G, bx);
            pg8::EpiRes E{a.out, a.out, mod_l + 5 * 1024};
#ifndef NO_G4
            pg8::gemm_phase<pg8::EpiRes, pg8::StaticOrder, true, true>((PG8_LAS unsigned char*)lds, g, S, E, tid);
#endif
        }
        SEAM(pb + 9);
    }
#undef IN
#undef SEAM
}

extern "C" void kernel_launch(void* const* d_in, const int* in_sizes, int n_in, void* d_out, int out_size, void* d_ws, size_t ws_size, hipStream_t stream) {
    static int grid = 0;
    if (grid == 0) {
        if (n_in != 18 || out_size != MTOK * DM || ws_size < WS_END) { fprintf(stderr, "kernel_launch: unexpected shapes (n_in %d out %d ws %zu)\n", n_in, out_size, ws_size); grid = -1; return; }
        int dev = 0, cus = 0, per_cu = 0;
        hipGetDevice(&dev); hipDeviceGetAttribute(&cus, hipDeviceAttributeMultiprocessorCount, dev);
        if (hipFuncSetAttribute((const void*)hybrid_fwd, hipFuncAttributeMaxDynamicSharedMemorySize, LDS_BYTES) != hipSuccess) { fprintf(stderr, "kernel_launch: hipFuncSetAttribute failed\n"); grid = -1; return; }
        if (hipOccupancyMaxActiveBlocksPerMultiprocessor(&per_cu, (const void*)hybrid_fwd, NWAVES * 64, LDS_BYTES) != hipSuccess || per_cu < 1) { fprintf(stderr, "kernel_launch: occupancy query says %d\n", per_cu); per_cu = 1; }
        (void)hipGetLastError();
        grid = cus * per_cu;
    }
    if (grid < 0) return;
    Args a{};
    for (int i = 0; i < 18; ++i) a.in[i] = (const float*)d_in[i];
    a.out = (float*)d_out; a.ws = (unsigned char*)d_ws;
#if MK_PER_PHASE
    for (int p = 0; p < N_PHASES; ++p) { a.ph_lo = p; a.ph_hi = p + 1; void* args[] = {&a};
        hipError_t e = hipLaunchCooperativeKernel((const void*)hybrid_fwd, dim3(grid), dim3(NWAVES * 64), args, LDS_BYTES, stream);
        if (e != hipSuccess) { fprintf(stderr, "cooperative launch failed (phase %d): %s (grid %d)\n", p, hipGetErrorString(e), grid); break; } }
#else
    a.ph_lo = 0; a.ph_hi = N_PHASES; void* args[] = {&a};
    hipError_t e = hipLaunchCooperativeKernel((const void*)hybrid_fwd, dim3(grid), dim3(NWAVES * 64), args, LDS_BYTES, stream);
    if (e != hipSuccess) fprintf(stderr, "cooperative launch failed: %s (grid %d)\n", hipGetErrorString(e), grid);
#endif
}
```

```cpp
#include <hip/hip_runtime.h>
#include <hip/hip_cooperative_groups.h>
#include <cstdio>
#include <cstdint>
namespace cg = cooperative_groups;
namespace pg8 {
#define PG8_LAS __attribute__((address_space(3)))
typedef unsigned short bf16_t;
typedef short bf16x8 __attribute__((ext_vector_type(8)));
typedef float f32x4 __attribute__((ext_vector_type(4)));
typedef unsigned u32x4 __attribute__((ext_vector_type(4)));
constexpr int BM = 256, BK = 64, HALF = 128, HTB = HALF * BK * 2  , STAGE_BYTES = 8 * HTB, NXCD = 8, WGM = 8;

__host__ __device__ __forceinline__ int lds_byte(int r, int c) { const int st = (r >> 4) * 2 + (c >> 5), rr = r & 15, cc = c & 31, ob = rr * 64 + cc * 2; return st * 1024 + (ob ^ (((ob >> 9) & 1) << 5)); }
__host__ __device__ __forceinline__ void stage_rc(int b, int& R, int& C) { const int st = b / 1024, sb = b % 1024, swz = sb ^ (((sb >> 9) & 1) << 5); R = (st >> 1) * 16 + swz / 64; C = (st & 1) * 32 + (swz % 64) / 2; }
__host__ __device__ __forceinline__ int perm32(int rho) { const int n = rho >> 4, i = rho & 15; return 8 * (i >> 2) + 4 * n + (i & 3); }

struct Unit { int pm, pn; };
struct Gemm { const bf16_t* A; const bf16_t* Bt; int M, N, K; };

struct StaticOrder {
    int nM, nN, nwg, G, c;
    __host__ __device__ void init(int M, int N, int G_, int c_) { nM = M / BM; nN = N / BM; nwg = nM * nN; G = G_; c = c_; }
    __host__ __device__ bool next(int i, Unit& u) const {
        const long L = (long)i * G + c; if (L >= nwg) return false;
        int wgid = (int)L; { const int q = nwg / NXCD, r = nwg % NXCD, xcd = wgid % NXCD, off = wgid / NXCD; wgid = (xcd < r ? xcd * (q + 1) : r * (q + 1) + (xcd - r) * q) + off; }
        const int nig = WGM * nN, gid = wgid / nig, fm = gid * WGM, gsz = (nM - fm) < WGM ? (nM - fm) : WGM;
        u.pm = fm + ((wgid % nig) % gsz); u.pn = (wgid % nig) / gsz; return true;
    }
    __device__ __forceinline__ void a_ready(const Unit&) const {}
    __device__ __forceinline__ void done(const Unit&) const {}
};
__device__ __forceinline__ unsigned cvt_pk_bf16(float lo, float hi) { unsigned r; asm volatile("v_cvt_pk_bf16_f32 %0, %1, %2" : "=v"(r) : "v"(lo), "v"(hi)); return r; }
typedef float f32x2 __attribute__((ext_vector_type(2)));
__device__ __forceinline__ unsigned short bf16_1(float v) { return (unsigned short)(cvt_pk_bf16(v, v) & 0xffffu); }
struct EpiProj {
    static constexpr bool PERM = true, AFTER_DRAIN = false;
    bf16_t* O; int ldc; bf16_t* vt_sb; bf16_t* vt_mb;
    __device__ __forceinline__ void operator()(const f32x4 (&acc)[2][2][4][2], const Unit& u, int wr, int wc, int fr, int fq) const {
        if (u.pn == 5 || u.pn == 8) {
            bf16_t* vt = (u.pn == 5) ? vt_sb : vt_mb;
            const int b = u.pm >> 5, s0 = (u.pm & 31) * 256 + wr * 64 + fr;
#pragma unroll
            for (int bj = 0; bj < 2; ++bj)
#pragma unroll
                for (int n = 0; n < 2; ++n)
#pragma unroll
                    for (int e = 0; e < 4; ++e) {
                        const int c = 128 * bj + 32 * wc + 8 * fq + 4 * n + e;
                        bf16_t* col = vt + ((size_t)((b * 4 + (c >> 6)) * 64 + (c & 63))) * 8192 + s0;
#pragma unroll
                        for (int ai = 0; ai < 2; ++ai)
#pragma unroll
                            for (int m = 0; m < 4; ++m) col[ai * 128 + m * 16] = bf16_1(acc[ai][bj][m][n][e]);
                    }
        } else {
            const int row0 = u.pm * BM + wr * 64 + fr, col0 = u.pn * BM + wc * 32 + 8 * fq;
#pragma unroll
            for (int ai = 0; ai < 2; ++ai)
#pragma unroll
                for (int m = 0; m < 4; ++m) { bf16_t* rowp = O + (size_t)(row0 + ai * HALF + m * 16) * ldc + col0;
#pragma unroll
                    for (int bj = 0; bj < 2; ++bj) { const f32x4 v0 = acc[ai][bj][m][0], v1 = acc[ai][bj][m][1];
                        u32x4 w; w.x = cvt_pk_bf16(v0[0], v0[1]); w.y = cvt_pk_bf16(v0[2], v0[3]); w.z = cvt_pk_bf16(v1[0], v1[1]); w.w = cvt_pk_bf16(v1[2], v1[3]);
                        *(u32x4*)(rowp + bj * HALF) = w; } }
        }
    }
};
struct EpiRelu2 {
    static constexpr bool PERM = true, AFTER_DRAIN = false;
    bf16_t* O; int ldc;
    __device__ __forceinline__ void operator()(const f32x4 (&acc)[2][2][4][2], const Unit& u, int wr, int wc, int fr, int fq) const {
        const int row0 = u.pm * BM + wr * 64 + fr, col0 = u.pn * BM + wc * 32 + 8 * fq;
#pragma unroll
        for (int ai = 0; ai < 2; ++ai)
#pragma unroll
            for (int m = 0; m < 4; ++m) { bf16_t* rowp = O + (size_t)(row0 + ai * HALF + m * 16) * ldc + col0;
#pragma unroll
                for (int bj = 0; bj < 2; ++bj) { f32x4 v0 = acc[ai][bj][m][0], v1 = acc[ai][bj][m][1];
#pragma unroll
                    for (int e = 0; e < 4; ++e) { const float a0 = fmaxf(v0[e], 0.f), a1 = fmaxf(v1[e], 0.f); v0[e] = a0 * a0; v1[e] = a1 * a1; }
                    u32x4 w; w.x = cvt_pk_bf16(v0[0], v0[1]); w.y = cvt_pk_bf16(v0[2], v0[3]); w.z = cvt_pk_bf16(v1[0], v1[1]); w.w = cvt_pk_bf16(v1[2], v1[3]);
                    *(u32x4*)(rowp + bj * HALF) = w; } }
    }
};
struct EpiRes {
    static constexpr bool PERM = false, AFTER_DRAIN = false;
    const float* base; float* out; const float* gate;
    __device__ __forceinline__ void operator()(const f32x4 (&acc)[2][2][4][2], const Unit& u, int wr, int wc, int fr, int fq) const {
        const float* g = gate + (size_t)(u.pm >> 5) * 6144;
        const int col0 = u.pn * BM + wc * 32 + 4 * fq;
        f32x4 gv[2][2];
#pragma unroll
        for (int bj = 0; bj < 2; ++bj)
#pragma unroll
            for (int n = 0; n < 2; ++n) gv[bj][n] = *(const f32x4*)(g + col0 + bj * HALF + n * 16);
#pragma unroll
        for (int ai = 0; ai < 2; ++ai)
#pragma unroll
            for (int m = 0; m < 4; ++m) { const size_t off = (size_t)(u.pm * BM + ai * HALF + wr * 64 + m * 16 + fr) * 1024 + col0;
#pragma unroll
                for (int bj = 0; bj < 2; ++bj)
#pragma unroll
                    for (int n = 0; n < 2; ++n) { const f32x4 bs = *(const f32x4*)(base + off + bj * HALF + n * 16);
                        *(f32x4*)(out + off + bj * HALF + n * 16) = bs + gv[bj][n] * acc[ai][bj][m][n]; } }
    }
};
template <class Epi, class Sched, bool ALIGN_EPI = false, bool SP2 = false>
__device__ __forceinline__ void gemm_phase(PG8_LAS unsigned char* lds, const Gemm g, const Sched& S, const Epi& E, int tid_in) {
    int tid_l = tid_in; asm volatile("" : "+v"(tid_l));
    const int tid = tid_l, wid = __builtin_amdgcn_readfirstlane(tid >> 6), lane = tid & 63, wr = wid >> 2, wc = wid & 3, fr = lane & 15, fq = lane >> 4;
    const int K = g.K, nt = K / BK;
    unsigned voffA[2], voffB[2];
#pragma unroll
    for (int i = 0; i < 2; ++i) { int R, C; stage_rc(tid * 16 + i * 8192, R, C); const int Rb = Epi::PERM ? ((R & ~31) + perm32(R & 31)) : R;
        voffA[i] = (unsigned)(R * K + C) * 2u; voffB[i] = (unsigned)(Rb * K + C) * 2u; }
    const size_t kstep = (size_t)(BK * 2);
    const size_t hstep = (size_t)HALF * K * 2;
    const size_t tstep = 2 * hstep;
    const unsigned ldsw = (unsigned)wid * 1024u;
    const int aoff = lds_byte(wr * 64 + fr, fq * 8), boff = lds_byte(wc * 32 + fr, fq * 8);
#define PG8_SA(b, h) (((b) * 2 + (h)) * HTB)
#define PG8_SB(b, h) ((4 + (b) * 2 + (h)) * HTB)
#define PG8_STAGE(bufoff, gbase, voff) do { _Pragma("unroll") for (int _i = 0; _i < 2; ++_i) \
        __builtin_amdgcn_global_load_lds((const unsigned*)((const char*)(gbase) + (voff)[_i]), (PG8_LAS unsigned*)(lds + (bufoff) + ldsw + _i * 8192), 16, 0, 0); } while (0)
#define PG8_LDA(dst, b, h) do { _Pragma("unroll") for (int m = 0; m < 4; ++m) _Pragma("unroll") for (int k = 0; k < 2; ++k) dst[m][k] = *(const PG8_LAS bf16x8*)(lds + PG8_SA(b, h) + aoff + m * 2048 + k * 1024); } while (0)
#define PG8_LDB(dst, b, h) do { _Pragma("unroll") for (int n = 0; n < 2; ++n) _Pragma("unroll") for (int k = 0; k < 2; ++k) dst[n][k] = *(const PG8_LAS bf16x8*)(lds + PG8_SB(b, h) + boff + n * 2048 + k * 1024); } while (0)
#define PG8_MMA(ai, bj, At, Bt) do { __builtin_amdgcn_s_setprio(1); _Pragma("unroll") for (int m = 0; m < 4; ++m) _Pragma("unroll") for (int n = 0; n < 2; ++n) _Pragma("unroll") for (int k = 0; k < 2; ++k) \
        acc[ai][bj][m][n] = __builtin_amdgcn_mfma_f32_16x16x32_bf16(Bt[n][k], At[m][k], acc[ai][bj][m][n], 0, 0, 0); __builtin_amdgcn_s_setprio(0); } while (0)
#define PG8_WAIT_V(n) asm volatile("s_waitcnt vmcnt(" #n ")" ::: "memory")
#define PG8_WAIT_L(n) asm volatile("s_waitcnt lgkmcnt(" #n ")" ::: "memory")
#define PG8_BAR __builtin_amdgcn_s_barrier()
#define PG8_SCHED __builtin_amdgcn_sched_barrier(0)
    Unit cur, nxt; int ui = 0;
    if (!S.next(0, cur)) return;
    f32x4 acc[2][2][4][2];
#pragma unroll
    for (int a = 0; a < 2; ++a)
#pragma unroll
        for (int b = 0; b < 2; ++b)
#pragma unroll
            for (int m = 0; m < 4; ++m)
#pragma unroll
                for (int n = 0; n < 2; ++n) acc[a][b][m][n] = (f32x4){0.f, 0.f, 0.f, 0.f};
    bf16x8 At[4][2], B0[2][2], B1[2][2];
    const char* cA = (const char*)g.A + (size_t)cur.pm * tstep; const char* cB = (const char*)g.Bt + (size_t)cur.pn * tstep;
    S.a_ready(cur);
    if constexpr (SP2) {
        PG8_STAGE(PG8_SB(0, 0), cB, voffB); PG8_STAGE(PG8_SB(0, 1), cB + hstep, voffB); PG8_STAGE(PG8_SA(0, 0), cA, voffA); PG8_STAGE(PG8_SA(0, 1), cA + hstep, voffA);
        if (wr == 1) PG8_BAR;
        PG8_WAIT_V(2); PG8_BAR;
        PG8_STAGE(PG8_SB(1, 0), cB + kstep, voffB); PG8_STAGE(PG8_SA(1, 0), cA + kstep, voffA); PG8_STAGE(PG8_SB(1, 1), cB + hstep + kstep, voffB);
        PG8_WAIT_V(6); PG8_BAR;
    } else {
        PG8_STAGE(PG8_SB(0, 0), cB, voffB); PG8_STAGE(PG8_SA(0, 0), cA, voffA); PG8_STAGE(PG8_SB(0, 1), cB + hstep, voffB); PG8_STAGE(PG8_SA(0, 1), cA + hstep, voffA);
        if (wr == 1) PG8_BAR;
        PG8_WAIT_V(4); PG8_BAR;
        PG8_STAGE(PG8_SB(1, 0), cB + kstep, voffB); PG8_STAGE(PG8_SA(1, 0), cA + kstep, voffA); PG8_STAGE(PG8_SB(1, 1), cB + hstep + kstep, voffB);
        PG8_WAIT_V(6); PG8_BAR;
    }
    for (;;) {
        const bool has_next = S.next(ui + 1, nxt);
        const char* nA = has_next ? (const char*)g.A + (size_t)nxt.pm * tstep : cA; const char* nB = has_next ? (const char*)g.Bt + (size_t)nxt.pn * tstep : cB;
        for (int t = 0; t < nt; t += 2) {
            const bool last = (t == nt - 2);
            const char* a1 = cA + (size_t)(t + 1) * kstep;
            const char* a2 = last ? nA : cA + (size_t)(t + 2) * kstep; const char* b2 = last ? nB : cB + (size_t)(t + 2) * kstep;
            const char* a3 = a2 + kstep; const char* b3 = b2 + kstep;
            if (last && has_next) S.a_ready(nxt);
            if constexpr (SP2) {
            PG8_LDB(B0, 0, 0); PG8_LDB(B1, 0, 1); PG8_SCHED; PG8_LDA(At, 0, 0); PG8_STAGE(PG8_SA(1, 1), a1 + hstep, voffA);
            PG8_WAIT_V(8); PG8_WAIT_L(0); PG8_BAR; PG8_MMA(0, 0, At, B0); PG8_MMA(0, 1, At, B1); PG8_BAR; PG8_SCHED;
            PG8_LDA(At, 0, 1); PG8_STAGE(PG8_SB(0, 0), b2, voffB); PG8_STAGE(PG8_SB(0, 1), b2 + hstep, voffB); PG8_STAGE(PG8_SA(0, 0), a2, voffA);
            PG8_WAIT_V(8); PG8_WAIT_L(0); PG8_BAR; PG8_MMA(1, 0, At, B0); PG8_MMA(1, 1, At, B1); PG8_BAR; PG8_SCHED;
            PG8_LDB(B0, 1, 0); PG8_LDB(B1, 1, 1); PG8_SCHED; PG8_LDA(At, 1, 0); PG8_STAGE(PG8_SA(0, 1), a2 + hstep, voffA);
            PG8_WAIT_V(8); PG8_WAIT_L(0); PG8_BAR; PG8_MMA(0, 0, At, B0); PG8_MMA(0, 1, At, B1); PG8_BAR; PG8_SCHED;
            PG8_LDA(At, 1, 1); PG8_STAGE(PG8_SB(1, 0), b3, voffB); PG8_STAGE(PG8_SB(1, 1), b3 + hstep, voffB); PG8_STAGE(PG8_SA(1, 0), a3, voffA);
            PG8_WAIT_V(8); PG8_WAIT_L(0); PG8_BAR; PG8_MMA(1, 0, At, B0); PG8_MMA(1, 1, At, B1); PG8_BAR; PG8_SCHED;
            } else {
            PG8_LDB(B0, 0, 0); PG8_SCHED; PG8_LDA(At, 0, 0); PG8_STAGE(PG8_SA(1, 1), a1 + hstep, voffA);
            PG8_WAIT_L(8); PG8_BAR; PG8_WAIT_L(0); PG8_MMA(0, 0, At, B0); PG8_BAR; PG8_SCHED;
            PG8_LDB(B1, 0, 1); PG8_STAGE(PG8_SB(0, 0), b2, voffB);
            PG8_BAR; PG8_WAIT_L(0); PG8_MMA(0, 1, At, B1); PG8_BAR;
            PG8_LDA(At, 0, 1); PG8_STAGE(PG8_SA(0, 0), a2, voffA);
            PG8_BAR; PG8_WAIT_L(0); PG8_MMA(1, 0, At, B0); PG8_BAR; PG8_SCHED;
            PG8_STAGE(PG8_SB(0, 1), b2 + hstep, voffB);
            PG8_WAIT_V(6); PG8_BAR; PG8_MMA(1, 1, At, B1); PG8_BAR;
            PG8_LDB(B0, 1, 0); PG8_SCHED; PG8_LDA(At, 1, 0); PG8_STAGE(PG8_SA(0, 1), a2 + hstep, voffA);
            PG8_WAIT_L(8); PG8_BAR; PG8_WAIT_L(0); PG8_MMA(0, 0, At, B0); PG8_BAR; PG8_SCHED;
            PG8_LDB(B1, 1, 1); PG8_STAGE(PG8_SB(1, 0), b3, voffB);
            PG8_BAR; PG8_WAIT_L(0); PG8_MMA(0, 1, At, B1); PG8_BAR;
            PG8_LDA(At, 1, 1); PG8_STAGE(PG8_SA(1, 0), a3, voffA);
            PG8_BAR; PG8_WAIT_L(0); PG8_MMA(1, 0, At, B0); PG8_BAR; PG8_SCHED;
            PG8_STAGE(PG8_SB(1, 1), b3 + hstep, voffB);
            PG8_WAIT_V(6); PG8_BAR; PG8_MMA(1, 1, At, B1); PG8_BAR;
            }
        }
        if constexpr (ALIGN_EPI) { if (wr == 0) PG8_BAR; }
        if constexpr (!Epi::AFTER_DRAIN) { E(acc, cur, wr, wc, fr, fq); S.done(cur); }
        if (!has_next) break;
#pragma unroll
        for (int a = 0; a < 2; ++a)
#pragma unroll
            for (int b = 0; b < 2; ++b)
#pragma unroll
                for (int m = 0; m < 4; ++m)
#pragma unroll
                    for (int n = 0; n < 2; ++n) acc[a][b][m][n] = (f32x4){0.f, 0.f, 0.f, 0.f};
        cur = nxt; cA = nA; cB = nB; ++ui;
        if constexpr (ALIGN_EPI) { if (wr == 1) PG8_BAR; }
    }
    PG8_WAIT_V(0);
    if constexpr (!ALIGN_EPI) { if (wr == 0) PG8_BAR; }
    PG8_BAR;
    if constexpr (Epi::AFTER_DRAIN) { E.fused(acc, cur, wr, wc, fr, fq, lds, wid, lane); S.done(cur); }
#undef PG8_SA
#undef PG8_SB
#undef PG8_STAGE
#undef PG8_LDA
#undef PG8_LDB
#undef PG8_MMA
#undef PG8_WAIT_V
#undef PG8_WAIT_L
#undef PG8_BAR
#undef PG8_SCHED
}
}

constexpr int NB = 8, SEQ = 8192, DM = 1024, MTOK = NB * SEQ, INW = 2816, FF = 4096, NWAVES = 8;
constexpr size_t MiB = 1u << 20;
constexpr size_t WS_CTL = 1 * MiB, CTL_ZERO_BYTES = 16384;
constexpr size_t WS_MOD = 0, WS_KMEAN = 512 * 1024;
constexpr size_t WS_WIN = 2 * MiB, WS_WOUT = 14 * MiB, WS_W1 = 18 * MiB, WS_W2 = 34 * MiB;
constexpr size_t WS_VTSB = 50 * MiB, WS_VTMB = 82 * MiB;
constexpr size_t WS_XN = 128 * MiB, WS_Y = 256 * MiB, WS_PROJ = 384 * MiB;
constexpr size_t WS_POUT = WS_XN;
constexpr size_t WS_PML = 896 * MiB, WS_QM = 904 * MiB, WS_SQ = 906 * MiB, WS_END = 908 * MiB;
constexpr int LDS_BYTES = 135168;
constexpr int N_PHASES = 21;

typedef unsigned short bf16;
typedef short bf16x8 __attribute__((ext_vector_type(8)));
typedef float f32x4 __attribute__((ext_vector_type(4)));
typedef float f32x2 __attribute__((ext_vector_type(2)));
typedef float f32x16 __attribute__((ext_vector_type(16)));
typedef unsigned u32x4 __attribute__((ext_vector_type(4)));
typedef unsigned u32x2 __attribute__((ext_vector_type(2)));
typedef __bf16 bf16x2_t __attribute__((ext_vector_type(2)));
#define LAS __attribute__((address_space(3)))
__device__ __forceinline__ unsigned pk2(float lo, float hi) { f32x2 v = {lo, hi}; bf16x2_t b = __builtin_convertvector(v, bf16x2_t); return __builtin_bit_cast(unsigned, b); }
__device__ __forceinline__ float bflo(unsigned w) { return __uint_as_float(w << 16); }
__device__ __forceinline__ float bfhi(unsigned w) { return __uint_as_float(w & 0xffff0000u); }
__device__ __forceinline__ void unpack8(const u32x4 w, float (&f)[8]) {
    f[0] = bflo(w.x); f[1] = bfhi(w.x); f[2] = bflo(w.y); f[3] = bfhi(w.y); f[4] = bflo(w.z); f[5] = bfhi(w.z); f[6] = bflo(w.w); f[7] = bfhi(w.w); }
__device__ __forceinline__ u32x4 pack8(const float (&f)[8]) { u32x4 w; w.x = pk2(f[0], f[1]); w.y = pk2(f[2], f[3]); w.z = pk2(f[4], f[5]); w.w = pk2(f[6], f[7]); return w; }
__device__ __forceinline__ float wave_sum(float v) {
#pragma unroll
    for (int o = 1; o < 64; o <<= 1) v += __shfl_xor(v, o);
    return v;
}
__device__ __forceinline__ float ex2(float x) { return __builtin_amdgcn_exp2f(x); }
__device__ __forceinline__ float lg2(float x) { return __builtin_amdgcn_logf(x); }

struct Args { const float* in[18]; float* out; unsigned char* ws; int ph_lo, ph_hi; };

__device__ __forceinline__ void p0_transpose_item(const float* W, int K, int N, bf16* WT, LAS float* scr, int item, int lane) {
    const int nblk = N / 32, kb = item / nblk, nb = item % nblk, k0 = 64 * kb, n0 = 32 * nb;
#pragma unroll 8
    for (int i = 0; i < 32; ++i) { const int kk = 2 * i + (lane >> 5); scr[kk * 33 + (lane & 31)] = W[(size_t)(k0 + kk) * N + n0 + (lane & 31)]; }
    asm volatile("s_waitcnt lgkmcnt(0)" ::: "memory");
    const int c = lane & 7;
#pragma unroll
    for (int j = 0; j < 4; ++j) { const int n = (lane >> 3) + 8 * j; const LAS float* s = scr + (8 * c) * 33 + n;
        u32x4 o; o.x = pk2(s[0 * 33], s[1 * 33]); o.y = pk2(s[2 * 33], s[3 * 33]); o.z = pk2(s[4 * 33], s[5 * 33]); o.w = pk2(s[6 * 33], s[7 * 33]);
        *(u32x4*)(WT + (size_t)(n0 + n) * K + k0 + 8 * c) = o; }
    asm volatile("s_waitcnt lgkmcnt(0)" ::: "memory");
}

__device__ __forceinline__ void p0_prologue(const Args& a, unsigned char* lds, int tid, int lane, int wave, int bx, int G) {
    {
        float* cact = (float*)lds;
        float* red = (float*)(lds + 32768);
        const float* c = a.in[1]; const float* w_ada = a.in[3]; const float* b_ada = a.in[4];
        float* mod = (float*)(a.ws + WS_MOD);
        if (bx < 192) { for (int i = tid; i < 8192; i += 512) { const float v = c[i]; cact[i] = v / (1.f + __expf(-v)); } }
        __syncthreads();
        for (int it = bx; it < 192; it += G) {
            const int l = it / 96, cgp = it % 96;
            const float* W = w_ada + (size_t)l * 1024 * 6144 + cgp * 64 + lane;
            float acc[8];
#pragma unroll
            for (int b = 0; b < 8; ++b) acc[b] = 0.f;
            for (int k = wave * 128; k < wave * 128 + 128; k += 4) {
                const float w0 = W[(size_t)k * 6144], w1 = W[(size_t)(k + 1) * 6144], w2 = W[(size_t)(k + 2) * 6144], w3 = W[(size_t)(k + 3) * 6144];
#pragma unroll
                for (int b = 0; b < 8; ++b) { const f32x4 cv = *(const f32x4*)(cact + b * 1024 + k); acc[b] += cv.x * w0 + cv.y * w1 + cv.z * w2 + cv.w * w3; }
            }
#pragma unroll
            for (int b = 0; b < 8; ++b) red[(wave * 8 + b) * 64 + lane] = acc[b];
            __syncthreads();
            { const int b = tid >> 6, j = tid & 63; float s = 0.f;
#pragma unroll
              for (int w = 0; w < 8; ++w) s += red[(w * 8 + b) * 64 + j];
              mod[(size_t)(l * 8 + b) * 6144 + cgp * 64 + j] = s + b_ada[l * 6144 + cgp * 64 + j]; }
            __syncthreads();
        }
        __syncthreads();
    }
    {
        LAS float* scr = (LAS float*)((LAS unsigned char*)lds + wave * 16384);
        const int gw = bx * NWAVES + wave, NGW = G * NWAVES;
        constexpr int I_IN = (DM / 64) * (INW / 32), I_OUT = (DM / 64) * (DM / 32), I_1 = (DM / 64) * (FF / 32), I_2 = (FF / 64) * (DM / 32);
        constexpr int PER_L = I_IN + I_OUT + I_1 + I_2;
        for (int it = gw; it < 2 * PER_L; it += NGW) {
            const int l = it / PER_L; int r = it % PER_L;
            if (r < I_IN) { p0_transpose_item(a.in[6] + (size_t)l * DM * INW, DM, INW, (bf16*)(a.ws + WS_WIN) + (size_t)l * INW * DM, scr, r, lane); continue; } r -= I_IN;
            if (r < I_OUT) { p0_transpose_item(a.in[14] + (size_t)l * DM * DM, DM, DM, (bf16*)(a.ws + WS_WOUT) + (size_t)l * DM * DM, scr, r, lane); continue; } r -= I_OUT;
            if (r < I_1) { p0_transpose_item(a.in[16] + (size_t)l * DM * FF, DM, FF, (bf16*)(a.ws + WS_W1) + (size_t)l * FF * DM, scr, r, lane); continue; } r -= I_1;
            p0_transpose_item(a.in[17] + (size_t)l * FF * DM, FF, DM, (bf16*)(a.ws + WS_W2) + (size_t)l * DM * FF, scr, r, lane);
        }
    }
}

__device__ __forceinline__ void norm_phase(const float* x, bf16* xn, const float* g, const float* mod_l, int shift_chunk, int gw, int NGW, int lane) {
    for (int r0 = gw * 32; r0 < MTOK; r0 += NGW * 32) {
        const float* mb = mod_l + (size_t)(r0 >> 13) * 6144 + shift_chunk * 1024;
        f32x4 gs[4], sh[4];
#pragma unroll
        for (int j = 0; j < 4; ++j) { const int c = 4 * lane + 256 * j; const f32x4 g4 = *(const f32x4*)(g + c), sc = *(const f32x4*)(mb + 1024 + c); sh[j] = *(const f32x4*)(mb + c); gs[j] = g4 * (1.f + sc); }
#pragma unroll 2
        for (int i = 0; i < 32; ++i) {
            const float* xr = x + (size_t)(r0 + i) * DM + 4 * lane;
            f32x4 v[4]; float ss = 0.f;
#pragma unroll
            for (int j = 0; j < 4; ++j) { v[j] = *(const f32x4*)(xr + 256 * j); ss += (v[j].x * v[j].x + v[j].y * v[j].y) + (v[j].z * v[j].z + v[j].w * v[j].w); }
            const float rstd = rsqrtf(wave_sum(ss) * (1.f / DM) + 1e-6f);
            bf16* orow = xn + (size_t)(r0 + i) * DM + 4 * lane;
#pragma unroll
            for (int j = 0; j < 4; ++j) { const f32x4 o = v[j] * rstd * gs[j] + sh[j]; u32x2 w; w.x = pk2(o.x, o.y); w.y = pk2(o.z, o.w); *(u32x2*)(orow + 256 * j) = w; }
        }
    }
}

__device__ __forceinline__ void sc_item(const bf16* proj, bf16* Y, const float* wsc, int item, int tid) {
    const int cgp = tid & 31, ts = tid >> 5;
    float w[3][8];
#pragma unroll
    for (int k = 0; k < 3; ++k)
#pragma unroll
        for (int e = 0; e < 8; ++e) w[k][e] = wsc[k * 256 + cgp * 8 + e];
    const int r0 = item * 64;
#pragma unroll
    for (int p = 0; p < 4; ++p) {
        const int row = r0 + p * 16 + ts, t = row & (SEQ - 1);
        const bf16* pr = proj + (size_t)row * INW + cgp * 8;
        const u32x4 Bv = *(const u32x4*)pr;
        float acc[8];
#pragma unroll
        for (int e = 0; e < 8; ++e) acc[e] = 0.f;
#pragma unroll
        for (int k = 0; k < 3; ++k) { const int dt = 2 - k;
            if (t - dt >= 0) { const bf16* q = pr - (size_t)dt * INW; const u32x4 Cv = *(const u32x4*)(q + 256), Hv = *(const u32x4*)(q + 512); float c[8], h[8]; unpack8(Cv, c); unpack8(Hv, h);
#pragma unroll
                for (int e = 0; e < 8; ++e) acc[e] += w[k][e] * (c[e] * h[e]); } }
        float bb[8]; unpack8(Bv, bb);
#pragma unroll
        for (int e = 0; e < 8; ++e) bb[e] *= acc[e];
        *(u32x4*)(Y + (size_t)row * DM + cgp * 8) = pack8(bb);
    }
}

__device__ __forceinline__ void cf_item(const bf16* proj, bf16* Y, const float* wcc, const float* bcc, const float* gcl, const float* bcl, unsigned char* lds, int item, int tid, int lane, int wave) {
    float* U = (float*)lds;
    float* CO = (float*)(lds + 62 * 256 * 4);
    const int r0 = item * 32, t0 = r0 & (SEQ - 1);
    for (int idx = tid; idx < 62 * 32; idx += 512) {
        const int rr = idx >> 5, cgp = idx & 31, t = t0 - 30 + rr;
        float u[8];
#pragma unroll
        for (int e = 0; e < 8; ++e) u[e] = 0.f;
        if (t >= 0) { const bf16* p = proj + (size_t)(r0 - 30 + rr) * INW + 2304 + cgp * 8; const u32x4 av = *(const u32x4*)p, gv = *(const u32x4*)(p + 256); float aa[8], gg[8]; unpack8(av, aa); unpack8(gv, gg);
#pragma unroll
            for (int e = 0; e < 8; ++e) u[e] = aa[e] / (1.f + __expf(-gg[e])); }
        *(f32x4*)(U + rr * 256 + cgp * 8) = (f32x4){u[0], u[1], u[2], u[3]}; *(f32x4*)(U + rr * 256 + cgp * 8 + 4) = (f32x4){u[4], u[5], u[6], u[7]};
    }
    __syncthreads();
    {
        const int ch = tid & 255, half = tid >> 8;
        float w[31];
#pragma unroll
        for (int k = 0; k < 31; ++k) w[k] = wcc[k * 256 + ch];
        float uu[46];
#pragma unroll
        for (int i = 0; i < 46; ++i) uu[i] = U[(half * 16 + i) * 256 + ch];
        const float bias = bcc[ch];
#pragma unroll
        for (int tt = 0; tt < 16; ++tt) { float acc = bias;
#pragma unroll
            for (int k = 0; k < 31; ++k) acc += w[k] * uu[tt + k];
            CO[(half * 16 + tt) * 256 + ch] = acc; }
    }
    __syncthreads();
    {
        const f32x4 g4 = *(const f32x4*)(gcl + lane * 4), b4 = *(const f32x4*)(bcl + lane * 4);
#pragma unroll
        for (int i = 0; i < 4; ++i) { const int tl = wave * 4 + i;
            const f32x4 v = *(const f32x4*)(CO + tl * 256 + lane * 4);
            const float mean = wave_sum((v.x + v.y) + (v.z + v.w)) * (1.f / 256.f);
            const f32x4 d = v - mean;
            const float var = wave_sum((d.x * d.x + d.y * d.y) + (d.z * d.z + d.w * d.w)) * (1.f / 256.f);
            const float rstd = rsqrtf(var + 1e-6f);
            f32x4 y = d * rstd * g4 + b4;
            y.x = y.x / (1.f + __expf(-y.x)); y.y = y.y / (1.f + __expf(-y.y)); y.z = y.z / (1.f + __expf(-y.z)); y.w = y.w / (1.f + __expf(-y.w));
            u32x2 w2; w2.x = pk2(y.x, y.y); w2.y = pk2(y.z, y.w);
            *(u32x2*)(Y + (size_t)(r0 + tl) * DM + 768 + lane * 4) = w2; }
    }
    __syncthreads();
}

constexpr float C2 = 0.125f * 1.4426950408889634f;
__device__ __forceinline__ void prep_item(bf16* proj, const int* positions, const float* gq, const float* gk, float* kmean, unsigned char* lds, int item, int tid) {
    f32x2* cs = (f32x2*)lds;
    float* kacc = (float*)(lds + 4096);
    const int b = item >> 5, n = item & 31;
    const int g = tid >> 3, j = tid & 7, tk = g >> 2, h = g & 3;
    if (tid < 256) kacc[tid] = 0.f;
    float gqv[8], gkv[8], ksum[8];
#pragma unroll
    for (int e = 0; e < 8; ++e) { gqv[e] = gq[8 * j + e]; gkv[e] = gk[8 * j + e]; ksum[e] = 0.f; }
    const int f_t = tid & 31, tk_t = tid >> 5;
    const float inv_freq = expf((-9.210340371976184f * (float)f_t) / 32.0f);
    for (int p = 0; p < 16; ++p) {
        const int rowb = b * SEQ + n * 256 + p * 16;
        { const int pos = positions[rowb + tk_t]; const float ang = (float)pos * inv_freq;
          double rev = (double)ang * 0.15915494309189535; rev -= floor(rev); const float rf = (float)rev;
          cs[tk_t * 32 + f_t] = (f32x2){__builtin_amdgcn_cosf(rf), __builtin_amdgcn_sinf(rf)}; }
        __syncthreads();
#pragma unroll
        for (int which = 0; which < 2; ++which) {
            bf16* ptr = proj + (size_t)(rowb + tk) * INW + (which ? 1792 : 1536) + h * 64 + j * 8;
            float v[8]; unpack8(*(const u32x4*)ptr, v);
            float ss = 0.f;
#pragma unroll
            for (int e = 0; e < 8; ++e) ss += v[e] * v[e];
            ss += __shfl_xor(ss, 1); ss += __shfl_xor(ss, 2); ss += __shfl_xor(ss, 4);
            const float rstd = rsqrtf(ss * (1.f / 64.f) + 1e-6f);
            float o[8];
#pragma unroll
            for (int e = 0; e < 8; ++e) { const float y = v[e] * rstd * (which ? gkv[e] : gqv[e]); const float pt = __shfl_xor(y, 4); const f32x2 c = cs[tk * 32 + ((8 * j + e) & 31)];
                o[e] = (j < 4) ? (y * c.x - pt * c.y) : (y * c.x + pt * c.y); }
            if (which == 0) {
#pragma unroll
                for (int e = 0; e < 8; ++e) o[e] *= C2;
            } else {
#pragma unroll
                for (int e = 0; e < 8; ++e) ksum[e] += o[e];
            }
            *(u32x4*)ptr = pack8(o);
        }
        __syncthreads();
    }
#pragma unroll
    for (int e = 0; e < 8; ++e) atomicAdd(&kacc[h * 64 + 8 * j + e], ksum[e]);
    __syncthreads();
    if (tid < 256) kmean[((size_t)(b * 4 + (tid >> 6)) * 32 + n) * 64 + (tid & 63)] = kacc[tid] * (1.f / 256.f);
    __syncthreads();
}

#define MFMA32(a, b, c) __builtin_amdgcn_mfma_f32_32x32x16_bf16((a), (b), (c), 0, 0, 0)
__device__ __forceinline__ int kperm(int rho) { return (rho & 19) | ((rho & 4) << 1) | ((rho & 8) >> 1); }
__device__ __forceinline__ constexpr int kidx(int r, int hi) { return (r & 7) + 8 * hi + 16 * (r >> 3); }
__device__ __forceinline__ constexpr int crow(int r, int hi) { return (r & 3) + 8 * (r >> 2) + 4 * hi; }
constexpr float NEG = -1e30f;

__device__ __forceinline__ void load_k(bf16x8 (&kf)[4], const bf16* Kb, int key0, int lane) {
    const bf16* p = Kb + (size_t)(key0 + kperm(lane & 31)) * INW + (lane >> 5) * 8;
#pragma unroll
    for (int kk = 0; kk < 4; ++kk) kf[kk] = *(const bf16x8*)(p + 16 * kk);
}
__device__ __forceinline__ void load_v(bf16x8 (&vf)[4], const bf16* VTb, int key0, int lane) {
    const bf16* p = VTb + (size_t)(lane & 31) * SEQ + key0 + 8 * (lane >> 5);
    vf[0] = *(const bf16x8*)p; vf[1] = *(const bf16x8*)(p + 16); vf[2] = *(const bf16x8*)(p + 32 * SEQ); vf[3] = *(const bf16x8*)(p + 32 * SEQ + 16);
}
__device__ __forceinline__ void load_q(bf16x8 (&qf)[4], const bf16* Qrow0, int lane) {
    const bf16* p = Qrow0 + (size_t)(lane & 31) * INW + 8 * (lane >> 5);
#pragma unroll
    for (int kk = 0; kk < 4; ++kk) qf[kk] = *(const bf16x8*)(p + 16 * kk);
}
__device__ __forceinline__ void pv_acc(f32x16 (&o)[2], const bf16x8 (&vf)[4], const float (&a)[16]) {
    u32x4 w0, w1;
    w0.x = pk2(a[0], a[1]); w0.y = pk2(a[2], a[3]); w0.z = pk2(a[4], a[5]); w0.w = pk2(a[6], a[7]);
    w1.x = pk2(a[8], a[9]); w1.y = pk2(a[10], a[11]); w1.z = pk2(a[12], a[13]); w1.w = pk2(a[14], a[15]);
    const bf16x8 p0 = __builtin_bit_cast(bf16x8, w0), p1 = __builtin_bit_cast(bf16x8, w1);
    o[0] = MFMA32(vf[0], p0, o[0]); o[0] = MFMA32(vf[1], p1, o[0]);
    o[1] = MFMA32(vf[2], p0, o[1]); o[1] = MFMA32(vf[3], p1, o[1]);
}
__device__ __forceinline__ void store_o_p(bf16* p, const f32x16 (&o)[2], float sc) {
#pragma unroll
    for (int dh = 0; dh < 2; ++dh)
#pragma unroll
        for (int g4 = 0; g4 < 4; ++g4) { u32x2 w; w.x = pk2(o[dh][4 * g4] * sc, o[dh][4 * g4 + 1] * sc); w.y = pk2(o[dh][4 * g4 + 2] * sc, o[dh][4 * g4 + 3] * sc); *(u32x2*)(p + dh * 32 + 8 * g4) = w; }
}
__device__ __forceinline__ void store_o(bf16* Yb, const f32x16 (&o)[2], float sc, int lane) { store_o_p(Yb + (size_t)(lane & 31) * DM + 4 * (lane >> 5), o, sc); }

constexpr float SBSC = 0.125f * 1.4426950408889634f, SBTH = -160.f;
template <bool DIAG> __device__ __forceinline__ void sb_qt(const bf16x8 (&kf)[4], const bf16x8 (&vf)[4], const bf16x8 (&qf)[4], f32x16 (&o)[2], float& carry, int ql, int hi) {
    f32x16 s = {};
#pragma unroll
    for (int kk = 0; kk < 4; ++kk) s = MFMA32(kf[kk], qf[kk], s);
    float L[16], zl[16];
    float lo = 0.f, up = 0.f;
#pragma unroll
    for (int r = 0; r < 16; ++r) { const float z = s[r] * SBSC; const float e = ex2(-fabsf(z)); const float sp = fmaxf(z, 0.f) + lg2(1.f + e);
        const bool valid = !DIAG || (kidx(r, hi) < ql);
        L[r] = valid ? -sp : 0.f; zl[r] = valid ? (z - sp) : -INFINITY;
        if (r < 8) lo += L[r]; else up += L[r]; }
    const float plo = __shfl_xor(lo, 32), pup = __shfl_xor(up, 32);
    const float offU = hi ? carry : carry + pup;
    const float offL = hi ? (carry + up + pup) : (carry + pup + up + plo);
    carry += (lo + plo) + (up + pup);
    float a[16];
    float run = offU;
#pragma unroll
    for (int r = 15; r >= 8; --r) { a[r] = ex2(zl[r] + run); run += L[r]; }
    run = offL;
#pragma unroll
    for (int r = 7; r >= 0; --r) { a[r] = ex2(zl[r] + run); run += L[r]; }
    pv_acc(o, vf, a);
}
__device__ __forceinline__ void sb_item(const bf16* proj, const bf16* vt, bf16* Y, int bh, int qt, int lane) {
    const int b = bh >> 2, h = bh & 3, hi = lane >> 5, ql = lane & 31, q0r = qt * 32;
    const bf16* Qb = proj + (size_t)b * SEQ * INW + 768 + h * 64;
    const bf16* Kb = proj + (size_t)b * SEQ * INW + 1024 + h * 64;
    const bf16* VTb = vt + (size_t)bh * 64 * SEQ;
    bf16x8 q[4]; load_q(q, Qb + (size_t)q0r * INW, lane);
    f32x16 o[2] = {}; float c = 0.f;
    bf16x8 kf[4], vf[4];
    load_k(kf, Kb, q0r, lane); load_v(vf, VTb, q0r, lane);
    sb_qt<true>(kf, vf, q, o, c, ql, hi);
    for (int key0 = q0r - 32; key0 >= 0; key0 -= 32) {
        if (__all(c < SBTH)) break;
        load_k(kf, Kb, key0, lane); load_v(vf, VTb, key0, lane);
        sb_qt<false>(kf, vf, q, o, c, ql, hi);
    }
    store_o(Y + (size_t)(b * SEQ + q0r) * DM + 256 + h * 64, o, 1.f, lane);
}

template <int MODE  > __device__ __forceinline__ void mb_qt(const bf16x8 (&kf)[4], const bf16x8 (&vf)[4], const bf16x8 (&qf)[4], f32x16 (&o)[2], float& mref, float& lsum, bool sel, int ql, int hi) {
    f32x16 s = {};
#pragma unroll
    for (int kk = 0; kk < 4; ++kk) s = MFMA32(kf[kk], qf[kk], s);
    if (MODE == 2) {
#pragma unroll
        for (int r = 0; r < 16; ++r) if (kidx(r, hi) > ql) s[r] = NEG;
    }
    float tm = s[0];
#pragma unroll
    for (int r = 1; r < 16; ++r) tm = fmaxf(tm, s[r]);
    tm = fmaxf(tm, __shfl_xor(tm, 32));
    tm = sel ? tm : NEG;
    if (__any(tm > mref + 16.f)) { const float mn = fmaxf(mref, tm), al = ex2(mref - mn); lsum *= al; o[0] *= al; o[1] *= al; mref = mn; }
    const float me = sel ? mref : INFINITY;
    float p[16];
#pragma unroll
    for (int r = 0; r < 16; ++r) { p[r] = ex2(s[r] - me); lsum += p[r]; }
    pv_acc(o, vf, p);
}
__device__ __forceinline__ unsigned topk_mask(const float* km, const bf16x8 (&qf)[4], int own, int lane) {
    const int hi = lane >> 5;
    f32x16 g = {};
#pragma unroll
    for (int kk = 0; kk < 4; ++kk) { const float* kp = km + (lane & 31) * 64 + 16 * kk + 8 * hi; const f32x4 x0 = *(const f32x4*)kp, x1 = *(const f32x4*)(kp + 4);
        u32x4 wh; wh.x = pk2(x0.x, x0.y); wh.y = pk2(x0.z, x0.w); wh.z = pk2(x1.x, x1.y); wh.w = pk2(x1.z, x1.w);
        u32x4 wl; wl.x = pk2(x0.x - bflo(wh.x), x0.y - bfhi(wh.x)); wl.y = pk2(x0.z - bflo(wh.y), x0.w - bfhi(wh.y)); wl.z = pk2(x1.x - bflo(wh.z), x1.y - bfhi(wh.z)); wl.w = pk2(x1.z - bflo(wh.w), x1.w - bfhi(wh.w));
        g = MFMA32(__builtin_bit_cast(bf16x8, wh), qf[kk], g); g = MFMA32(__builtin_bit_cast(bf16x8, wl), qf[kk], g); }
    float gv[16];
#pragma unroll
    for (int r = 0; r < 16; ++r) gv[r] = (crow(r, hi) < own) ? g[r] : NEG;
    unsigned mask = 0u;
#pragma unroll
    for (int round = 0; round < 3; ++round) {
        float bm = gv[0]; int bi = crow(0, hi);
#pragma unroll
        for (int r = 1; r < 16; ++r) if (gv[r] > bm) { bm = gv[r]; bi = crow(r, hi); }
        const float pm = __shfl_xor(bm, 32); const int pi = __shfl_xor(bi, 32);
        const bool takep = (pm > bm) || (pm == bm && pi < bi);
        const float cm = takep ? pm : bm; const int ci = takep ? pi : bi;
        if (cm > -1e29f) mask |= 1u << ci;
#pragma unroll
        for (int r = 0; r < 16; ++r) if (crow(r, hi) == ci) gv[r] = NEG;
    }
    return mask;
}
__device__ __forceinline__ void moba_select(const bf16* proj, const float* kmean, unsigned* QM, unsigned long long* SQ, int bh, int chunk, int lane) {
    const int b = bh >> 2, h = bh & 3, qstart = chunk * 64, own = chunk >> 2;
    const bf16* Qb = proj + (size_t)b * SEQ * INW + 1536 + h * 64;
    unsigned m0 = 0u, m1 = 0u;
    if (own > 0) { bf16x8 q0[4], q1[4]; load_q(q0, Qb + (size_t)qstart * INW, lane); load_q(q1, Qb + (size_t)(qstart + 32) * INW, lane);
        m0 = topk_mask(kmean + (size_t)bh * 32 * 64, q0, own, lane); m1 = topk_mask(kmean + (size_t)bh * 32 * 64, q1, own, lane); }
    if (lane < 32) { QM[(size_t)bh * SEQ + qstart + lane] = m0; QM[(size_t)bh * SEQ + qstart + 32 + lane] = m1; }
    unsigned long long mine = 0ull;
#pragma unroll
    for (int n = 0; n < 32; ++n) { const unsigned long long b0 = __ballot((m0 >> n) & 1u) & 0xffffffffull, b1 = __ballot((m1 >> n) & 1u) & 0xffffffffull; const unsigned long long v = b0 | (b1 << 32); if (lane == n) mine = v; }
    if (lane < 32) SQ[((size_t)bh * 128 + chunk) * 32 + lane] = mine;
}
__device__ __forceinline__ int select_nth(unsigned long long m, int r) {
    int pos = 0; unsigned w = (unsigned)m; int c = __popc(w);
    if (r >= c) { r -= c; w = (unsigned)(m >> 32); pos = 32; }
    c = __popc(w & 0xffffu); if (r >= c) { r -= c; w >>= 16; pos += 16; }
    c = __popc(w & 0xffu); if (r >= c) { r -= c; w >>= 8; pos += 8; }
    c = __popc(w & 0xfu); if (r >= c) { r -= c; w >>= 4; pos += 4; }
    c = __popc(w & 3u); if (r >= c) { r -= c; w >>= 2; pos += 2; }
    if (r >= (int)(w & 1u)) pos += 1;
    return pos;
}
__device__ __forceinline__ void moba_past(const bf16* proj, const bf16* vt, const unsigned* QM, const unsigned long long* SQ, bf16* POUT, f32x2* PML, int bh, int w, int lane) {
    const int b = bh >> 2, h = bh & 3, hi = lane >> 5, ql = lane & 31;
    const bf16* Qb = proj + (size_t)b * SEQ * INW + 1536 + h * 64;
    const bf16* Kb = proj + (size_t)b * SEQ * INW + 1792 + h * 64;
    const bf16* VTb = vt + (size_t)bh * 64 * SEQ;
    const unsigned long long* sq = SQ + (size_t)bh * 128 * 32;
    int gbase = 0;
    for (int n = 0; n < 31; ++n) {
        const int c0 = 2 * lane;
        const unsigned long long m0 = (c0 >= 4 * (n + 1)) ? sq[c0 * 32 + n] : 0ull;
        const unsigned long long m1 = (c0 + 1 >= 4 * (n + 1)) ? sq[(c0 + 1) * 32 + n] : 0ull;
        const int cA = __popcll(m0), tot = cA + __popcll(m1);
        int incl = tot;
#pragma unroll
        for (int o = 1; o < 64; o <<= 1) { const int t = __shfl_up(incl, o); if (lane >= o) incl += t; }
        const int ex = incl - tot, T = __builtin_amdgcn_readlane(incl, 63);
        const int ntile = (T + 31) >> 5;
        for (int k = (w - gbase) & 63; k < ntile; k += 64) {
            bf16x8 kf[4], vf[4], kg[4], vg[4];
            load_k(kf, Kb, n * 256, lane); load_v(vf, VTb, n * 256, lane);
            const int p = 32 * k + ql;
            unsigned long long cand = __ballot(tot > 0 && ex < 32 * k + 32 && ex + tot > 32 * k);
            int qidx = (n + 1) * 256;
            while (cand) {
                const int j = __ffsll((long long)cand) - 1; cand &= cand - 1ull;
                const int exj = __builtin_amdgcn_readlane(ex, j), totj = __builtin_amdgcn_readlane(tot, j), cAj = __builtin_amdgcn_readlane(cA, j);
                const unsigned m0lo = __builtin_amdgcn_readlane((unsigned)m0, j), m0hi = __builtin_amdgcn_readlane((unsigned)(m0 >> 32), j);
                const unsigned m1lo = __builtin_amdgcn_readlane((unsigned)m1, j), m1hi = __builtin_amdgcn_readlane((unsigned)(m1 >> 32), j);
                if (p >= exj && p < exj + totj) { int r = p - exj; unsigned long long mm = ((unsigned long long)m0hi << 32) | m0lo; int ch = 2 * j;
                    if (r >= cAj) { r -= cAj; mm = ((unsigned long long)m1hi << 32) | m1lo; ch += 1; }
                    qidx = ch * 64 + select_nth(mm, r); }
            }
            const bool valid = p < T;
            bf16x8 q[4];
            { const bf16* qp = Qb + (size_t)qidx * INW + 8 * hi;
#pragma unroll
              for (int kk = 0; kk < 4; ++kk) q[kk] = *(const bf16x8*)(qp + 16 * kk); }
            f32x16 o[2] = {}; float mref = NEG, lsum = 0.f;
            for (int t = 0; t < 8; t += 2) {
                load_k(kg, Kb, n * 256 + 32 * (t + 1), lane); load_v(vg, VTb, n * 256 + 32 * (t + 1), lane);
                mb_qt<1>(kf, vf, q, o, mref, lsum, true, ql, hi);
                if (t + 2 < 8) { load_k(kf, Kb, n * 256 + 32 * (t + 2), lane); load_v(vf, VTb, n * 256 + 32 * (t + 2), lane); }
                mb_qt<1>(kg, vg, q, o, mref, lsum, true, ql, hi);
            }
            lsum += __shfl_xor(lsum, 32);
            if (valid) { const unsigned qm = QM[(size_t)bh * SEQ + qidx]; const int slot = __popc(qm & ((1u << n) - 1u));
                const size_t pi = ((size_t)bh * SEQ + qidx) * 3 + slot;
                store_o_p(POUT + pi * 64 + 4 * hi, o, 1.f / lsum);
                if (hi == 0) PML[pi] = (f32x2){mref, lsum}; }
        }
        gbase += ntile;
    }
}
__device__ __forceinline__ void moba_own(const bf16* proj, const bf16* vt, const bf16* POUT, const f32x2* PML, bf16* Y, int bh, int qt, int lane) {
    const int b = bh >> 2, h = bh & 3, hi = lane >> 5, ql = lane & 31, q0r = qt * 32, own = qt >> 3;
    const bf16* Qb = proj + (size_t)b * SEQ * INW + 1536 + h * 64;
    const bf16* Kb = proj + (size_t)b * SEQ * INW + 1792 + h * 64;
    const bf16* VTb = vt + (size_t)bh * 64 * SEQ;
    bf16x8 q[4]; load_q(q, Qb + (size_t)q0r * INW, lane);
    f32x16 o[2] = {}; float mref = NEG, lsum = 0.f;
    bf16x8 kf[4], vf[4];
    load_k(kf, Kb, q0r, lane); load_v(vf, VTb, q0r, lane);
    mb_qt<2>(kf, vf, q, o, mref, lsum, true, ql, hi);
    for (int key0 = own * 256; key0 < q0r; key0 += 32) { load_k(kf, Kb, key0, lane); load_v(vf, VTb, key0, lane); mb_qt<1>(kf, vf, q, o, mref, lsum, true, ql, hi); }
    lsum += __shfl_xor(lsum, 32);
    const int ns = own < 3 ? own : 3;
    const size_t pi = ((size_t)bh * SEQ + q0r + ql) * 3;
    f32x2 ml[3]; float M = mref;
#pragma unroll
    for (int s = 0; s < 3; ++s) { ml[s] = (f32x2){NEG, 0.f}; if (s < ns) { ml[s] = PML[pi + s]; M = fmaxf(M, ml[s].x); } }
    const float wown = ex2(mref - M); float den = lsum * wown;
    o[0] *= wown; o[1] *= wown;
#pragma unroll
    for (int s = 0; s < 3; ++s) if (s < ns) { const float wsl = ml[s].y * ex2(ml[s].x - M); den += wsl; const bf16* ps = POUT + (pi + s) * 64 + 4 * hi;
#pragma unroll
        for (int dh = 0; dh < 2; ++dh)
#pragma unroll
            for (int g4 = 0; g4 < 4; ++g4) { const u32x2 v = *(const u32x2*)(ps + dh * 32 + 8 * g4);
                o[dh][4 * g4] += wsl * bflo(v.x); o[dh][4 * g4 + 1] += wsl * bfhi(v.x); o[dh][4 * g4 + 2] += wsl * bflo(v.y); o[dh][4 * g4 + 3] += wsl * bfhi(v.y); } }
    store_o(Y + (size_t)(b * SEQ + q0r) * DM + 512 + h * 64, o, 1.f / den, lane);
}

#define XB_TMO      128
#define XB_XCNT(j)  (256  + 64 * (j))
#define XB_XSUB(j)  (1280 + 64 * (j))
#define XB_XGEN(j)  (2304 + 64 * (j))
#define XB_TOP      3328
#define XB_TOPGEN   3392
#define XCD_BAR_WORDS 3456
#define XB_SPIN_CAP (1u << 18)

__device__ __forceinline__ unsigned xb_ld(unsigned* p)              { return __hip_atomic_load(p, __ATOMIC_RELAXED, __HIP_MEMORY_SCOPE_AGENT); }
__device__ __forceinline__ unsigned xb_add(unsigned* p, unsigned v) { return __hip_atomic_fetch_add(p, v, __ATOMIC_RELAXED, __HIP_MEMORY_SCOPE_AGENT); }
__device__ __forceinline__ unsigned xb_xcc_id() { return (unsigned)__builtin_amdgcn_s_getreg((3 << 11) | 20) & 0xFu; }
#define XB_SPIN(cond, bar) do { unsigned _sp = 0; while (cond) { __builtin_amdgcn_s_sleep(1); \
    if ((++_sp & 255u) == 0u) { if (xb_ld(&(bar)[XB_TMO])) break; if (_sp > XB_SPIN_CAP) { atomicAdd(&(bar)[XB_TMO], 1u); break; } } } } while (0)

struct XcdBarrier {
    unsigned* bar; unsigned x;
    volatile LAS unsigned* st;
};

__device__ __forceinline__ XcdBarrier xcd_barrier_post(unsigned* bar, volatile LAS unsigned* st, bool t0) {
    XcdBarrier b; b.bar = bar; b.x = xb_xcc_id(); b.st = st;
    if (t0) (void)xb_add(&bar[XB_XCNT(b.x)], 1u);
    return b;
}
__device__ __forceinline__ void xcd_barrier_complete(unsigned* bar, unsigned x, unsigned& nloc, unsigned& nx) {
    const unsigned G = gridDim.x * gridDim.y * gridDim.z;
    unsigned sum, cnt, mine, sp = 0u;
    for (;;) {
        sum = 0u; cnt = 0u; mine = 0u;
#pragma unroll
        for (unsigned j = 0; j < 16; ++j) { const unsigned c = xb_ld(&bar[XB_XCNT(j)]); sum += c; cnt += (c > 0u) ? 1u : 0u; mine = (j == x) ? c : mine; }
        if (sum == G) break;
        __builtin_amdgcn_s_sleep(1);
        if ((++sp & 255u) == 0u) { if (xb_ld(&bar[XB_TMO])) break; if (sp > XB_SPIN_CAP) { atomicAdd(&bar[XB_TMO], 1u); break; } }
    }
    nloc = mine > 0u ? mine : 1u; nx = cnt > 0u ? cnt : 1u;
}

__device__ __forceinline__ void xcd_barrier(const XcdBarrier& b, bool t0) {
    asm volatile("s_waitcnt vmcnt(0)" ::: "memory");
    __syncthreads();
    if (t0) {
        unsigned* bar = b.bar;
        __builtin_amdgcn_s_waitcnt(0);
        unsigned nloc = b.st[0], nx = b.st[1];
        if (nloc == 0u) { xcd_barrier_complete(bar, b.x, nloc, nx); b.st[0] = nloc; b.st[1] = nx; }
        const unsigned old = xb_add(&bar[XB_XSUB(b.x)], 1u);
        const unsigned gen = old / nloc;
        if (old + 1u == (gen + 1u) * nloc) {
            __builtin_amdgcn_fence(__ATOMIC_RELEASE, "agent");
            asm volatile("s_waitcnt vmcnt(0)" ::: "memory");
            const unsigned og = xb_add(&bar[XB_TOP], 1u);
            const unsigned tg = og / nx;
            if (og + 1u == (tg + 1u) * nx) xb_add(&bar[XB_TOPGEN], 1u);
            else XB_SPIN(xb_ld(&bar[XB_TOPGEN]) == tg, bar);
            __builtin_amdgcn_fence(__ATOMIC_ACQUIRE, "agent");
            xb_add(&bar[XB_XGEN(b.x)], 1u);
            asm volatile("s_waitcnt vmcnt(0)" ::: "memory");
        } else {
            XB_SPIN(xb_ld(&bar[XB_XGEN(b.x)]) == gen, bar);
            __builtin_amdgcn_fence(__ATOMIC_ACQUIRE, "agent");
            asm volatile("s_waitcnt vmcnt(0)" ::: "memory");
        }
    }
    __syncthreads();
}
#ifndef MK_PER_PHASE
#define MK_PER_PHASE 0
#endif
__global__ void __launch_bounds__(NWAVES * 64, 2) hybrid_fwd(Args a) {
    extern __shared__ __attribute__((aligned(16))) unsigned char lds[];
    cg::grid_group grid = cg::this_grid();
    const int G0 = gridDim.x, bx0 = blockIdx.x;
    volatile LAS unsigned* MISC = (volatile LAS unsigned*)((LAS unsigned char*)lds + 131072);
    if (threadIdx.x < 32) MISC[threadIdx.x] = 0u;
    __syncthreads();
    const int wave0 = __builtin_amdgcn_readfirstlane((int)threadIdx.x >> 6);
#define PHASE_IDS int lane = (int)__builtin_amdgcn_mbcnt_hi(~0u, __builtin_amdgcn_mbcnt_lo(~0u, 0u)); asm volatile("" : "+v"(lane)); int bx = bx0, G = G0; asm volatile("" : "+s"(bx), "+s"(G));   \
    const int wave = wave0; const int tid = wave * 64 + lane; const int gw = bx * NWAVES + wave, NGW = G * NWAVES; const int vcu = (G % 8 == 0) ? (bx % 8) * (G / 8) + bx / 8 : bx; (void)tid; (void)gw; (void)NGW; (void)vcu;
    XcdBarrier bar = xcd_barrier_post((unsigned*)(a.ws + WS_CTL), MISC + 8, threadIdx.x == 0);
    unsigned char* ws = a.ws;
    float* mod = (float*)(ws + WS_MOD);
    float* kmean = (float*)(ws + WS_KMEAN);
    bf16* XN = (bf16*)(ws + WS_XN); bf16* Yb = (bf16*)(ws + WS_Y); bf16* PROJ = (bf16*)(ws + WS_PROJ); bf16* HB = (bf16*)(ws + WS_PROJ);
    bf16* VTSB = (bf16*)(ws + WS_VTSB); bf16* VTMB = (bf16*)(ws + WS_VTMB);
    bf16* POUT = (bf16*)(ws + WS_POUT); f32x2* PML = (f32x2*)(ws + WS_PML); unsigned* QM = (unsigned*)(ws + WS_QM); unsigned long long* SQ = (unsigned long long*)(ws + WS_SQ);
    const int lo = a.ph_lo, hi_ = a.ph_hi; (void)lo; (void)hi_;
#if MK_PER_PHASE
#define IN(k) (lo <= (k) && (k) < hi_)
#define SEAM(k) do { if (IN(k) && IN((k) + 1)) grid.sync(); } while (0)
#else
#define IN(k) true
#define SEAM(k) do { unsigned ln_ = __builtin_amdgcn_mbcnt_hi(~0u, __builtin_amdgcn_mbcnt_lo(~0u, 0u)); asm volatile("" : "+v"(ln_)); const bool t0_ = (wave0 == 0) && (ln_ == 0u); xcd_barrier(bar, t0_); } while (0)
#endif

#ifndef NO_P0
    if (IN(0)) { PHASE_IDS p0_prologue(a, lds, tid, lane, wave, bx, G); }
#endif
    grid.sync();
    for (int l = 0; l < 2; ++l) {
        const int pb = 1 + 10 * l;
        const float* mod_l = mod + (size_t)l * 8 * 6144;
        const float* xin = (l == 0) ? a.in[0] : a.out;
        if (IN(pb + 0)) { PHASE_IDS norm_phase(xin, XN, a.in[5] + l * DM, mod_l, 0, gw, NGW, lane); }
        SEAM(pb + 0);
        if (IN(pb + 1)) { PHASE_IDS
            pg8::Gemm g{XN, (const bf16*)(ws + WS_WIN) + (size_t)l * INW * DM, MTOK, INW, DM}; pg8::StaticOrder S; S.init(MTOK, INW, G, bx);
            pg8::EpiProj E{PROJ, INW, VTSB, VTMB};
#ifndef NO_G1
            pg8::gemm_phase<pg8::EpiProj, pg8::StaticOrder, true, true>((PG8_LAS unsigned char*)lds, g, S, E, tid);
#endif
        }
        SEAM(pb + 1);
        if (IN(pb + 2)) { PHASE_IDS
#ifndef NO_PREP
            for (int it = bx; it < 256; it += G) prep_item(PROJ, (const int*)a.in[2], a.in[12] + l * 64, a.in[13] + l * 64, kmean, lds, it, tid);
#endif
#ifndef NO_CF
            for (int it = bx; it < MTOK / 32; it += G) cf_item(PROJ, Yb, a.in[8] + l * 31 * 256, a.in[9] + l * 256, a.in[10] + l * 256, a.in[11] + l * 256, lds, it, tid, lane, wave);
#endif
#ifndef NO_SC
            for (int it = bx; it < MTOK / 64; it += G) sc_item(PROJ, Yb, a.in[7] + l * 3 * 256, it, tid);
#endif
#ifndef NO_SB
            for (int it = vcu * NWAVES + wave; it < 32 * 256; it += NGW) sb_item(PROJ, VTSB, Yb, it >> 8, it & 255, lane);
#endif
        }
        SEAM(pb + 2);
        if (IN(pb + 3)) { PHASE_IDS
#ifndef NO_MOBA
            for (int it = vcu * NWAVES + wave; it < 32 * 128; it += NGW) moba_select(PROJ, kmean, QM, SQ, it >> 7, it & 127, lane);
#endif
        }
        SEAM(pb + 3);
        if (IN(pb + 4)) { PHASE_IDS
#ifndef NO_MOBA
            for (int wi = vcu * NWAVES + wave; wi < 32 * 64; wi += NGW) moba_past(PROJ, VTMB, QM, SQ, POUT, PML, wi >> 6, wi & 63, lane);
#endif
        }
        SEAM(pb + 4);
        if (IN(pb + 5)) { PHASE_IDS
#ifndef NO_MOBA
            for (int it = vcu * NWAVES + wave; it < 32 * 256; it += NGW) moba_own(PROJ, VTMB, POUT, PML, Yb, it >> 8, it & 255, lane);
#endif
        }
        SEAM(pb + 5);
        if (IN(pb + 6)) { PHASE_IDS
            pg8::Gemm g{Yb, (const bf16*)(ws + WS_WOUT) + (size_t)l * DM * DM, MTOK, DM, DM}; pg8::StaticOrder S; S.init(MTOK, DM, G, bx);
            pg8::EpiRes E{xin, a.out, mod_l + 2 * 1024};
#ifndef NO_G2
            pg8::gemm_phase<pg8::EpiRes, pg8::StaticOrder, true, true>((PG8_LAS unsigned char*)lds, g, S, E, tid);
#endif
        }
        SEAM(pb + 6);
        if (IN(pb + 7)) { PHASE_IDS norm_phase(a.out, XN, a.in[15] + l * DM, mod_l, 3, gw, NGW, lane); }
        SEAM(pb + 7);
        if (IN(pb + 8)) { PHASE_IDS
            pg8::Gemm g{XN, (const bf16*)(ws + WS_W1) + (size_t)l * FF * DM, MTOK, FF, DM}; pg8::StaticOrder S; S.init(MTOK, FF, G, bx);
            pg8::EpiRelu2 E{HB, FF};
#ifndef NO_G3
            pg8::gemm_phase<pg8::EpiRelu2, pg8::StaticOrder, true, true>((PG8_LAS unsigned char*)lds, g, S, E, tid);
#endif
        }
        SEAM(pb + 8);
        if (IN(pb + 9)) { PHASE_IDS
            pg8::Gemm g{HB, (const bf16*)(ws + WS_W2) + (size_t)l * DM * FF, MTOK, DM, FF}; pg8::StaticOrder S; S.init(MTOK, DM, G, bx);
            pg8::EpiRes E{a.out, a.out, mod_l + 5 * 1024};
#ifndef NO_G4
            pg8::gemm_phase<pg8::EpiRes, pg8::StaticOrder, true, true>((PG8_LAS unsigned char*)lds, g, S, E, tid);
#endif
        }
        SEAM(pb + 9);
    }
#undef IN
#undef SEAM
}

extern "C" void kernel_launch(void* const* d_in, const int* in_sizes, int n_in, void* d_out, int out_size, void* d_ws, size_t ws_size, hipStream_t stream) {
    static int grid = 0;
    if (grid == 0) {
        if (n_in != 18 || out_size != MTOK * DM || ws_size < WS_END) { fprintf(stderr, "kernel_launch: unexpected shapes (n_in %d out %d ws %zu)\n", n_in, out_size, ws_size); grid = -1; return; }
        int dev = 0, cus = 0, per_cu = 0;
        hipGetDevice(&dev); hipDeviceGetAttribute(&cus, hipDeviceAttributeMultiprocessorCount, dev);
        if (hipFuncSetAttribute((const void*)hybrid_fwd, hipFuncAttributeMaxDynamicSharedMemorySize, LDS_BYTES) != hipSuccess) { fprintf(stderr, "kernel_launch: hipFuncSetAttribute failed\n"); grid = -1; return; }
        if (hipOccupancyMaxActiveBlocksPerMultiprocessor(&per_cu, (const void*)hybrid_fwd, NWAVES * 64, LDS_BYTES) != hipSuccess || per_cu < 1) { fprintf(stderr, "kernel_launch: occupancy query says %d\n", per_cu); per_cu = 1; }
        (void)hipGetLastError();
        grid = cus * per_cu;
    }
    if (grid < 0) return;
    if (hipMemsetAsync((char*)d_ws + WS_CTL, 0, CTL_ZERO_BYTES, stream) != hipSuccess) { fprintf(stderr, "kernel_launch: memset failed\n"); return; }
    Args a{};
    for (int i = 0; i < 18; ++i) a.in[i] = (const float*)d_in[i];
    a.out = (float*)d_out; a.ws = (unsigned char*)d_ws;
#if MK_PER_PHASE
    for (int p = 0; p < N_PHASES; ++p) { a.ph_lo = p; a.ph_hi = p + 1; void* args[] = {&a};
        hipError_t e = hipLaunchCooperativeKernel((const void*)hybrid_fwd, dim3(grid), dim3(NWAVES * 64), args, LDS_BYTES, stream);
        if (e != hipSuccess) { fprintf(stderr, "cooperative launch failed (phase %d): %s (grid %d)\n", p, hipGetErrorString(e), grid); break; } }
#else
    a.ph_lo = 0; a.ph_hi = N_PHASES; void* args[] = {&a};
    hipError_t e = hipLaunchCooperativeKernel((const void*)hybrid_fwd, dim3(grid), dim3(NWAVES * 64), args, LDS_BYTES, stream);
    if (e != hipSuccess) fprintf(stderr, "cooperative launch failed: %s (grid %d)\n", hipGetErrorString(e), grid);
#endif
}
```

```cpp
#include <hip/hip_runtime.h>
#include <hip/hip_cooperative_groups.h>
#include <cstdio>
#include <cstdint>
namespace cg = cooperative_groups;
namespace pg8 {
#define PG8_LAS __attribute__((address_space(3)))
typedef unsigned short bf16_t;
typedef short bf16x8 __attribute__((ext_vector_type(8)));
typedef float f32x4 __attribute__((ext_vector_type(4)));
typedef unsigned u32x4 __attribute__((ext_vector_type(4)));
constexpr int BM = 256, BK = 64, HALF = 128, HTB = HALF * BK * 2  , STAGE_BYTES = 8 * HTB, NXCD = 8, WGM = 8;

__host__ __device__ __forceinline__ int lds_byte(int r, int c) { const int st = (r >> 4) * 2 + (c >> 5), rr = r & 15, cc = c & 31, ob = rr * 64 + cc * 2; return st * 1024 + (ob ^ (((ob >> 9) & 1) << 5)); }
__host__ __device__ __forceinline__ void stage_rc(int b, int& R, int& C) { const int st = b / 1024, sb = b % 1024, swz = sb ^ (((sb >> 9) & 1) << 5); R = (st >> 1) * 16 + swz / 64; C = (st & 1) * 32 + (swz % 64) / 2; }
__host__ __device__ __forceinline__ int perm32(int rho) { const int n = rho >> 4, i = rho & 15; return 8 * (i >> 2) + 4 * n + (i & 3); }

struct Unit { int pm, pn; };
struct Gemm { const bf16_t* A; const bf16_t* Bt; int M, N, K; };

struct StaticOrder {
    int nM, nN, nwg, G, c;
    __host__ __device__ void init(int M, int N, int G_, int c_) { nM = M / BM; nN = N / BM; nwg = nM * nN; G = G_; c = c_; }
    __host__ __device__ bool next(int i, Unit& u) const {
        const long L = (long)i * G + c; if (L >= nwg) return false;
        int wgid = (int)L; { const int q = nwg / NXCD, r = nwg % NXCD, xcd = wgid % NXCD, off = wgid / NXCD; wgid = (xcd < r ? xcd * (q + 1) : r * (q + 1) + (xcd - r) * q) + off; }
        const int nig = WGM * nN, gid = wgid / nig, fm = gid * WGM, gsz = (nM - fm) < WGM ? (nM - fm) : WGM;
        u.pm = fm + ((wgid % nig) % gsz); u.pn = (wgid % nig) / gsz; return true;
    }
    __device__ __forceinline__ void a_ready(const Unit&) const {}
    __device__ __forceinline__ void done(const Unit&) const {}
};
__device__ __forceinline__ unsigned cvt_pk_bf16(float lo, float hi) { unsigned r; asm volatile("v_cvt_pk_bf16_f32 %0, %1, %2" : "=v"(r) : "v"(lo), "v"(hi)); return r; }
typedef float f32x2 __attribute__((ext_vector_type(2)));
__device__ __forceinline__ unsigned short bf16_1(float v) { return (unsigned short)(cvt_pk_bf16(v, v) & 0xffffu); }
struct EpiProj {
    static constexpr bool PERM = true, AFTER_DRAIN = false;
    bf16_t* O; int ldc; bf16_t* vt_sb; bf16_t* vt_mb; const float* rowss; const float* bias2;
    __device__ __forceinline__ void operator()(const f32x4 (&acc)[2][2][4][2], const Unit& u, int wr, int wc, int fr, int fq) const {
        const float* bb = bias2 + (size_t)(u.pm >> 5) * ldc + u.pn * BM + wc * 32 + 8 * fq;
        f32x4 bv[2][2]; float rs[2][4];
#pragma unroll
        for (int bj = 0; bj < 2; ++bj)
#pragma unroll
            for (int n = 0; n < 2; ++n) bv[bj][n] = *(const f32x4*)(bb + bj * HALF + 4 * n);
#pragma unroll
        for (int ai = 0; ai < 2; ++ai)
#pragma unroll
            for (int m = 0; m < 4; ++m) rs[ai][m] = rsqrtf(rowss[u.pm * BM + ai * HALF + wr * 64 + m * 16 + fr] * (1.f / 1024.f) + 1e-6f);
        if (u.pn == 5 || u.pn == 8) {
            bf16_t* vt = (u.pn == 5) ? vt_sb : vt_mb;
            const int b = u.pm >> 5, s0 = (u.pm & 31) * 256 + wr * 64 + fr;
#pragma unroll
            for (int bj = 0; bj < 2; ++bj)
#pragma unroll
                for (int n = 0; n < 2; ++n)
#pragma unroll
                    for (int e = 0; e < 4; ++e) {
                        const int c = 128 * bj + 32 * wc + 8 * fq + 4 * n + e;
                        bf16_t* col = vt + ((size_t)((b * 4 + (c >> 6)) * 64 + (c & 63))) * 8192 + s0;
#pragma unroll
                        for (int ai = 0; ai < 2; ++ai)
#pragma unroll
                            for (int m = 0; m < 4; ++m) col[ai * 128 + m * 16] = bf16_1(acc[ai][bj][m][n][e] * rs[ai][m] + bv[bj][n][e]);
                    }
        } else {
            const int row0 = u.pm * BM + wr * 64 + fr, col0 = u.pn * BM + wc * 32 + 8 * fq;
#pragma unroll
            for (int ai = 0; ai < 2; ++ai)
#pragma unroll
                for (int m = 0; m < 4; ++m) { bf16_t* rowp = O + (size_t)(row0 + ai * HALF + m * 16) * ldc + col0;
#pragma unroll
                    for (int bj = 0; bj < 2; ++bj) { const f32x4 v0 = acc[ai][bj][m][0] * rs[ai][m] + bv[bj][0], v1 = acc[ai][bj][m][1] * rs[ai][m] + bv[bj][1];
                        u32x4 w; w.x = cvt_pk_bf16(v0[0], v0[1]); w.y = cvt_pk_bf16(v0[2], v0[3]); w.z = cvt_pk_bf16(v1[0], v1[1]); w.w = cvt_pk_bf16(v1[2], v1[3]);
                        *(u32x4*)(rowp + bj * HALF) = w; } }
        }
    }
};
struct EpiRelu2 {
    static constexpr bool PERM = true, AFTER_DRAIN = false;
    bf16_t* O; int ldc; const float* rowss; const float* bias2;
    __device__ __forceinline__ void operator()(const f32x4 (&acc)[2][2][4][2], const Unit& u, int wr, int wc, int fr, int fq) const {
        const int row0 = u.pm * BM + wr * 64 + fr, col0 = u.pn * BM + wc * 32 + 8 * fq;
        const float* bb = bias2 + (size_t)(u.pm >> 5) * ldc + col0;
        f32x4 bv[2][2];
#pragma unroll
        for (int bj = 0; bj < 2; ++bj)
#pragma unroll
            for (int n = 0; n < 2; ++n) bv[bj][n] = *(const f32x4*)(bb + bj * HALF + 4 * n);
#pragma unroll
        for (int ai = 0; ai < 2; ++ai)
#pragma unroll
            for (int m = 0; m < 4; ++m) { bf16_t* rowp = O + (size_t)(row0 + ai * HALF + m * 16) * ldc + col0; const float rs = rsqrtf(rowss[row0 + ai * HALF + m * 16] * (1.f / 1024.f) + 1e-6f);
#pragma unroll
                for (int bj = 0; bj < 2; ++bj) { f32x4 v0 = acc[ai][bj][m][0] * rs + bv[bj][0], v1 = acc[ai][bj][m][1] * rs + bv[bj][1];
#pragma unroll
                    for (int e = 0; e < 4; ++e) { const float a0 = fmaxf(v0[e], 0.f), a1 = fmaxf(v1[e], 0.f); v0[e] = a0 * a0; v1[e] = a1 * a1; }
                    u32x4 w; w.x = cvt_pk_bf16(v0[0], v0[1]); w.y = cvt_pk_bf16(v0[2], v0[3]); w.z = cvt_pk_bf16(v1[0], v1[1]); w.w = cvt_pk_bf16(v1[2], v1[3]);
                    *(u32x4*)(rowp + bj * HALF) = w; } }
    }
};
struct EpiRes {
    static constexpr bool PERM = true, AFTER_DRAIN = false;
    const float* base; float* out; const float* gate; bf16_t* xn; float* rowss; const float* gnext; const float* scnext;
    __device__ __forceinline__ void operator()(const f32x4 (&acc)[2][2][4][2], const Unit& u, int wr, int wc, int fr, int fq) const {
        const float* g = gate + (size_t)(u.pm >> 5) * 6144;
        const int col0 = u.pn * BM + wc * 32 + 8 * fq;
        f32x4 gv[2][2], gs[2][2];
#pragma unroll
        for (int bj = 0; bj < 2; ++bj)
#pragma unroll
            for (int n = 0; n < 2; ++n) { gv[bj][n] = *(const f32x4*)(g + col0 + bj * HALF + n * 4);
                if (xn) gs[bj][n] = *(const f32x4*)(gnext + col0 + bj * HALF + n * 4) * (1.f + *(const f32x4*)(scnext + (size_t)(u.pm >> 5) * 6144 + col0 + bj * HALF + n * 4));
                else gs[bj][n] = (f32x4){0.f, 0.f, 0.f, 0.f}; }
#pragma unroll
        for (int ai = 0; ai < 2; ++ai)
#pragma unroll
            for (int m = 0; m < 4; ++m) { const int row = u.pm * BM + ai * HALF + wr * 64 + m * 16 + fr; const size_t off = (size_t)row * 1024 + col0; float ss = 0.f;
#pragma unroll
                for (int bj = 0; bj < 2; ++bj) {
                    const f32x4 b0 = *(const f32x4*)(base + off + bj * HALF), b1 = *(const f32x4*)(base + off + bj * HALF + 4);
                    const f32x4 o0 = b0 + gv[bj][0] * acc[ai][bj][m][0], o1 = b1 + gv[bj][1] * acc[ai][bj][m][1];
                    *(f32x4*)(out + off + bj * HALF) = o0; *(f32x4*)(out + off + bj * HALF + 4) = o1;
                    if (xn) { const f32x4 y0 = o0 * gs[bj][0], y1 = o1 * gs[bj][1];
                        u32x4 w; w.x = cvt_pk_bf16(y0[0], y0[1]); w.y = cvt_pk_bf16(y0[2], y0[3]); w.z = cvt_pk_bf16(y1[0], y1[1]); w.w = cvt_pk_bf16(y1[2], y1[3]);
                        *(u32x4*)(xn + off + bj * HALF) = w;
                        ss += ((o0[0] * o0[0] + o0[1] * o0[1]) + (o0[2] * o0[2] + o0[3] * o0[3])) + ((o1[0] * o1[0] + o1[1] * o1[1]) + (o1[2] * o1[2] + o1[3] * o1[3])); } }
                if (xn) { ss += __shfl_xor(ss, 16); ss += __shfl_xor(ss, 32); if (fq == 0) atomicAdd(rowss + row, ss); } }
    }
};
template <class Epi, class Sched, bool ALIGN_EPI = false, bool SP2 = false>
__device__ __forceinline__ void gemm_phase(PG8_LAS unsigned char* lds, const Gemm g, const Sched& S, const Epi& E, int tid_in) {
    int tid_l = tid_in; asm volatile("" : "+v"(tid_l));
    const int tid = tid_l, wid = __builtin_amdgcn_readfirstlane(tid >> 6), lane = tid & 63, wr = wid >> 2, wc = wid & 3, fr = lane & 15, fq = lane >> 4;
    const int K = g.K, nt = K / BK;
    unsigned voffA[2], voffB[2];
#pragma unroll
    for (int i = 0; i < 2; ++i) { int R, C; stage_rc(tid * 16 + i * 8192, R, C); const int Rb = Epi::PERM ? ((R & ~31) + perm32(R & 31)) : R;
        voffA[i] = (unsigned)(R * K + C) * 2u; voffB[i] = (unsigned)(Rb * K + C) * 2u; }
    const size_t kstep = (size_t)(BK * 2);
    const size_t hstep = (size_t)HALF * K * 2;
    const size_t tstep = 2 * hstep;
    const unsigned ldsw = (unsigned)wid * 1024u;
    const int aoff = lds_byte(wr * 64 + fr, fq * 8), boff = lds_byte(wc * 32 + fr, fq * 8);
#define PG8_SA(b, h) (((b) * 2 + (h)) * HTB)
#define PG8_SB(b, h) ((4 + (b) * 2 + (h)) * HTB)
#define PG8_STAGE(bufoff, gbase, voff) do { _Pragma("unroll") for (int _i = 0; _i < 2; ++_i) \
        __builtin_amdgcn_global_load_lds((const unsigned*)((const char*)(gbase) + (voff)[_i]), (PG8_LAS unsigned*)(lds + (bufoff) + ldsw + _i * 8192), 16, 0, 0); } while (0)
#define PG8_LDA(dst, b, h) do { _Pragma("unroll") for (int m = 0; m < 4; ++m) _Pragma("unroll") for (int k = 0; k < 2; ++k) dst[m][k] = *(const PG8_LAS bf16x8*)(lds + PG8_SA(b, h) + aoff + m * 2048 + k * 1024); } while (0)
#define PG8_LDB(dst, b, h) do { _Pragma("unroll") for (int n = 0; n < 2; ++n) _Pragma("unroll") for (int k = 0; k < 2; ++k) dst[n][k] = *(const PG8_LAS bf16x8*)(lds + PG8_SB(b, h) + boff + n * 2048 + k * 1024); } while (0)
#define PG8_MMA(ai, bj, At, Bt) do { __builtin_amdgcn_s_setprio(1); _Pragma("unroll") for (int m = 0; m < 4; ++m) _Pragma("unroll") for (int n = 0; n < 2; ++n) _Pragma("unroll") for (int k = 0; k < 2; ++k) \
        acc[ai][bj][m][n] = __builtin_amdgcn_mfma_f32_16x16x32_bf16(Bt[n][k], At[m][k], acc[ai][bj][m][n], 0, 0, 0); __builtin_amdgcn_s_setprio(0); } while (0)
#define PG8_WAIT_V(n) asm volatile("s_waitcnt vmcnt(" #n ")" ::: "memory")
#define PG8_WAIT_L(n) asm volatile("s_waitcnt lgkmcnt(" #n ")" ::: "memory")
#define PG8_BAR __builtin_amdgcn_s_barrier()
#define PG8_SCHED __builtin_amdgcn_sched_barrier(0)
    Unit cur, nxt; int ui = 0;
    if (!S.next(0, cur)) return;
    f32x4 acc[2][2][4][2];
#pragma unroll
    for (int a = 0; a < 2; ++a)
#pragma unroll
        for (int b = 0; b < 2; ++b)
#pragma unroll
            for (int m = 0; m < 4; ++m)
#pragma unroll
                for (int n = 0; n < 2; ++n) acc[a][b][m][n] = (f32x4){0.f, 0.f, 0.f, 0.f};
    bf16x8 At[4][2], B0[2][2], B1[2][2];
    const char* cA = (const char*)g.A + (size_t)cur.pm * tstep; const char* cB = (const char*)g.Bt + (size_t)cur.pn * tstep;
    S.a_ready(cur);
    if constexpr (SP2) {
        PG8_STAGE(PG8_SB(0, 0), cB, voffB); PG8_STAGE(PG8_SB(0, 1), cB + hstep, voffB); PG8_STAGE(PG8_SA(0, 0), cA, voffA); PG8_STAGE(PG8_SA(0, 1), cA + hstep, voffA);
        if (wr == 1) PG8_BAR;
        PG8_WAIT_V(2); PG8_BAR;
        PG8_STAGE(PG8_SB(1, 0), cB + kstep, voffB); PG8_STAGE(PG8_SA(1, 0), cA + kstep, voffA); PG8_STAGE(PG8_SB(1, 1), cB + hstep + kstep, voffB);
        PG8_WAIT_V(6); PG8_BAR;
    } else {
        PG8_STAGE(PG8_SB(0, 0), cB, voffB); PG8_STAGE(PG8_SA(0, 0), cA, voffA); PG8_STAGE(PG8_SB(0, 1), cB + hstep, voffB); PG8_STAGE(PG8_SA(0, 1), cA + hstep, voffA);
        if (wr == 1) PG8_BAR;
        PG8_WAIT_V(4); PG8_BAR;
        PG8_STAGE(PG8_SB(1, 0), cB + kstep, voffB); PG8_STAGE(PG8_SA(1, 0), cA + kstep, voffA); PG8_STAGE(PG8_SB(1, 1), cB + hstep + kstep, voffB);
        PG8_WAIT_V(6); PG8_BAR;
    }
    for (;;) {
        const bool has_next = S.next(ui + 1, nxt);
        const char* nA = has_next ? (const char*)g.A + (size_t)nxt.pm * tstep : cA; const char* nB = has_next ? (const char*)g.Bt + (size_t)nxt.pn * tstep : cB;
        for (int t = 0; t < nt; t += 2) {
            const bool last = (t == nt - 2);
            const char* a1 = cA + (size_t)(t + 1) * kstep;
            const char* a2 = last ? nA : cA + (size_t)(t + 2) * kstep; const char* b2 = last ? nB : cB + (size_t)(t + 2) * kstep;
            const char* a3 = a2 + kstep; const char* b3 = b2 + kstep;
            if (last && has_next) S.a_ready(nxt);
            if constexpr (SP2) {
            PG8_LDB(B0, 0, 0); PG8_LDB(B1, 0, 1); PG8_SCHED; PG8_LDA(At, 0, 0); PG8_STAGE(PG8_SA(1, 1), a1 + hstep, voffA);
            PG8_WAIT_V(8); PG8_WAIT_L(0); PG8_BAR; PG8_MMA(0, 0, At, B0); PG8_MMA(0, 1, At, B1); PG8_BAR; PG8_SCHED;
            PG8_LDA(At, 0, 1); PG8_STAGE(PG8_SB(0, 0), b2, voffB); PG8_STAGE(PG8_SB(0, 1), b2 + hstep, voffB); PG8_STAGE(PG8_SA(0, 0), a2, voffA);
            PG8_WAIT_V(8); PG8_WAIT_L(0); PG8_BAR; PG8_MMA(1, 0, At, B0); PG8_MMA(1, 1, At, B1); PG8_BAR; PG8_SCHED;
            PG8_LDB(B0, 1, 0); PG8_LDB(B1, 1, 1); PG8_SCHED; PG8_LDA(At, 1, 0); PG8_STAGE(PG8_SA(0, 1), a2 + hstep, voffA);
            PG8_WAIT_V(8); PG8_WAIT_L(0); PG8_BAR; PG8_MMA(0, 0, At, B0); PG8_MMA(0, 1, At, B1); PG8_BAR; PG8_SCHED;
            PG8_LDA(At, 1, 1); PG8_STAGE(PG8_SB(1, 0), b3, voffB); PG8_STAGE(PG8_SB(1, 1), b3 + hstep, voffB); PG8_STAGE(PG8_SA(1, 0), a3, voffA);
            PG8_WAIT_V(8); PG8_WAIT_L(0); PG8_BAR; PG8_MMA(1, 0, At, B0); PG8_MMA(1, 1, At, B1); PG8_BAR; PG8_SCHED;
            } else {
            PG8_LDB(B0, 0, 0); PG8_SCHED; PG8_LDA(At, 0, 0); PG8_STAGE(PG8_SA(1, 1), a1 + hstep, voffA);
            PG8_WAIT_L(8); PG8_BAR; PG8_WAIT_L(0); PG8_MMA(0, 0, At, B0); PG8_BAR; PG8_SCHED;
            PG8_LDB(B1, 0, 1); PG8_STAGE(PG8_SB(0, 0), b2, voffB);
            PG8_BAR; PG8_WAIT_L(0); PG8_MMA(0, 1, At, B1); PG8_BAR;
            PG8_LDA(At, 0, 1); PG8_STAGE(PG8_SA(0, 0), a2, voffA);
            PG8_BAR; PG8_WAIT_L(0); PG8_MMA(1, 0, At, B0); PG8_BAR; PG8_SCHED;
            PG8_STAGE(PG8_SB(0, 1), b2 + hstep, voffB);
            PG8_WAIT_V(6); PG8_BAR; PG8_MMA(1, 1, At, B1); PG8_BAR;
            PG8_LDB(B0, 1, 0); PG8_SCHED; PG8_LDA(At, 1, 0); PG8_STAGE(PG8_SA(0, 1), a2 + hstep, voffA);
            PG8_WAIT_L(8); PG8_BAR; PG8_WAIT_L(0); PG8_MMA(0, 0, At, B0); PG8_BAR; PG8_SCHED;
            PG8_LDB(B1, 1, 1); PG8_STAGE(PG8_SB(1, 0), b3, voffB);
            PG8_BAR; PG8_WAIT_L(0); PG8_MMA(0, 1, At, B1); PG8_BAR;
            PG8_LDA(At, 1, 1); PG8_STAGE(PG8_SA(1, 0), a3, voffA);
            PG8_BAR; PG8_WAIT_L(0); PG8_MMA(1, 0, At, B0); PG8_BAR; PG8_SCHED;
            PG8_STAGE(PG8_SB(1, 1), b3 + hstep, voffB);
            PG8_WAIT_V(6); PG8_BAR; PG8_MMA(1, 1, At, B1); PG8_BAR;
            }
        }
        if constexpr (ALIGN_EPI) { if (wr == 0) PG8_BAR; }
        if constexpr (!Epi::AFTER_DRAIN) { E(acc, cur, wr, wc, fr, fq); S.done(cur); }
        if (!has_next) break;
#pragma unroll
        for (int a = 0; a < 2; ++a)
#pragma unroll
            for (int b = 0; b < 2; ++b)
#pragma unroll
                for (int m = 0; m < 4; ++m)
#pragma unroll
                    for (int n = 0; n < 2; ++n) acc[a][b][m][n] = (f32x4){0.f, 0.f, 0.f, 0.f};
        cur = nxt; cA = nA; cB = nB; ++ui;
        if constexpr (ALIGN_EPI) { if (wr == 1) PG8_BAR; }
    }
    PG8_WAIT_V(0);
    if constexpr (!ALIGN_EPI) { if (wr == 0) PG8_BAR; }
    PG8_BAR;
    if constexpr (Epi::AFTER_DRAIN) { E.fused(acc, cur, wr, wc, fr, fq, lds, wid, lane); S.done(cur); }
#undef PG8_SA
#undef PG8_SB
#undef PG8_STAGE
#undef PG8_LDA
#undef PG8_LDB
#undef PG8_MMA
#undef PG8_WAIT_V
#undef PG8_WAIT_L
#undef PG8_BAR
#undef PG8_SCHED
}
}

constexpr int NB = 8, SEQ = 8192, DM = 1024, MTOK = NB * SEQ, INW = 2816, FF = 4096, NWAVES = 8;
constexpr size_t MiB = 1u << 20;
constexpr size_t WS_CTL = 1 * MiB, CTL_ZERO_BYTES = 16384;
constexpr size_t WS_MOD = 0, WS_KMEAN = 512 * 1024;
constexpr size_t WS_WIN = 2 * MiB, WS_WOUT = 14 * MiB, WS_W1 = 18 * MiB, WS_W2 = 34 * MiB;
constexpr size_t WS_VTSB = 50 * MiB, WS_VTMB = 82 * MiB;
constexpr size_t WS_XN = 128 * MiB, WS_Y = 256 * MiB, WS_PROJ = 384 * MiB;
constexpr size_t WS_POUT = WS_XN;
constexpr size_t WS_PML = 896 * MiB, WS_QM = 904 * MiB, WS_SQ = 906 * MiB, WS_ROWSS = 908 * MiB, WS_BIAS2 = 909 * MiB, WS_END = 910 * MiB;
constexpr int LDS_BYTES = 135168;
constexpr int N_PHASES = 18;
constexpr int BIAS2_L = 8 * INW + 8 * FF;

typedef unsigned short bf16;
typedef short bf16x8 __attribute__((ext_vector_type(8)));
typedef float f32x4 __attribute__((ext_vector_type(4)));
typedef float f32x2 __attribute__((ext_vector_type(2)));
typedef float f32x16 __attribute__((ext_vector_type(16)));
typedef unsigned u32x4 __attribute__((ext_vector_type(4)));
typedef unsigned u32x2 __attribute__((ext_vector_type(2)));
typedef __bf16 bf16x2_t __attribute__((ext_vector_type(2)));
#define LAS __attribute__((address_space(3)))
__device__ __forceinline__ unsigned pk2(float lo, float hi) { f32x2 v = {lo, hi}; bf16x2_t b = __builtin_convertvector(v, bf16x2_t); return __builtin_bit_cast(unsigned, b); }
__device__ __forceinline__ float bflo(unsigned w) { return __uint_as_float(w << 16); }
__device__ __forceinline__ float bfhi(unsigned w) { return __uint_as_float(w & 0xffff0000u); }
__device__ __forceinline__ void unpack8(const u32x4 w, float (&f)[8]) {
    f[0] = bflo(w.x); f[1] = bfhi(w.x); f[2] = bflo(w.y); f[3] = bfhi(w.y); f[4] = bflo(w.z); f[5] = bfhi(w.z); f[6] = bflo(w.w); f[7] = bfhi(w.w); }
__device__ __forceinline__ u32x4 pack8(const float (&f)[8]) { u32x4 w; w.x = pk2(f[0], f[1]); w.y = pk2(f[2], f[3]); w.z = pk2(f[4], f[5]); w.w = pk2(f[6], f[7]); return w; }
__device__ __forceinline__ float wave_sum(float v) {
#pragma unroll
    for (int o = 1; o < 64; o <<= 1) v += __shfl_xor(v, o);
    return v;
}
__device__ __forceinline__ float ex2(float x) { return __builtin_amdgcn_exp2f(x); }
__device__ __forceinline__ float lg2(float x) { return __builtin_amdgcn_logf(x); }

struct Args { const float* in[18]; float* out; unsigned char* ws; int ph_lo, ph_hi; };

__device__ __forceinline__ void p0_transpose_item(const float* W, int K, int N, bf16* WT, LAS float* scr, int item, int lane) {
    const int nblk = N / 32, kb = item / nblk, nb = item % nblk, k0 = 64 * kb, n0 = 32 * nb;
#pragma unroll 8
    for (int i = 0; i < 32; ++i) { const int kk = 2 * i + (lane >> 5); scr[kk * 33 + (lane & 31)] = W[(size_t)(k0 + kk) * N + n0 + (lane & 31)]; }
    asm volatile("s_waitcnt lgkmcnt(0)" ::: "memory");
    const int c = lane & 7;
#pragma unroll
    for (int j = 0; j < 4; ++j) { const int n = (lane >> 3) + 8 * j; const LAS float* s = scr + (8 * c) * 33 + n;
        u32x4 o; o.x = pk2(s[0 * 33], s[1 * 33]); o.y = pk2(s[2 * 33], s[3 * 33]); o.z = pk2(s[4 * 33], s[5 * 33]); o.w = pk2(s[6 * 33], s[7 * 33]);
        *(u32x4*)(WT + (size_t)(n0 + n) * K + k0 + 8 * c) = o; }
    asm volatile("s_waitcnt lgkmcnt(0)" ::: "memory");
}

__device__ __forceinline__ void p0_prologue(const Args& a, unsigned char* lds, int tid, int lane, int wave, int bx, int G) {
    {
        float* cact = (float*)lds;
        float* red = (float*)(lds + 32768);
        const float* c = a.in[1]; const float* w_ada = a.in[3]; const float* b_ada = a.in[4];
        float* mod = (float*)(a.ws + WS_MOD);
        if (bx < 192) { for (int i = tid; i < 8192; i += 512) { const float v = c[i]; cact[i] = v / (1.f + __expf(-v)); } }
        __syncthreads();
        for (int it = bx; it < 192; it += G) {
            const int l = it / 96, cgp = it % 96;
            const float* W = w_ada + (size_t)l * 1024 * 6144 + cgp * 64 + lane;
            float acc[8];
#pragma unroll
            for (int b = 0; b < 8; ++b) acc[b] = 0.f;
            for (int k = wave * 128; k < wave * 128 + 128; k += 4) {
                const float w0 = W[(size_t)k * 6144], w1 = W[(size_t)(k + 1) * 6144], w2 = W[(size_t)(k + 2) * 6144], w3 = W[(size_t)(k + 3) * 6144];
#pragma unroll
                for (int b = 0; b < 8; ++b) { const f32x4 cv = *(const f32x4*)(cact + b * 1024 + k); acc[b] += cv.x * w0 + cv.y * w1 + cv.z * w2 + cv.w * w3; }
            }
#pragma unroll
            for (int b = 0; b < 8; ++b) red[(wave * 8 + b) * 64 + lane] = acc[b];
            __syncthreads();
            { const int b = tid >> 6, j = tid & 63; float s = 0.f;
#pragma unroll
              for (int w = 0; w < 8; ++w) s += red[(w * 8 + b) * 64 + j];
              mod[(size_t)(l * 8 + b) * 6144 + cgp * 64 + j] = s + b_ada[l * 6144 + cgp * 64 + j]; }
            __syncthreads();
        }
        __syncthreads();
    }
    {
        LAS float* scr = (LAS float*)((LAS unsigned char*)lds + wave * 16384);
        const int gw = bx * NWAVES + wave, NGW = G * NWAVES;
        constexpr int I_IN = (DM / 64) * (INW / 32), I_OUT = (DM / 64) * (DM / 32), I_1 = (DM / 64) * (FF / 32), I_2 = (FF / 64) * (DM / 32);
        constexpr int PER_L = I_IN + I_OUT + I_1 + I_2;
        for (int it = gw; it < 2 * PER_L; it += NGW) {
            const int l = it / PER_L; int r = it % PER_L;
            if (r < I_IN) { p0_transpose_item(a.in[6] + (size_t)l * DM * INW, DM, INW, (bf16*)(a.ws + WS_WIN) + (size_t)l * INW * DM, scr, r, lane); continue; } r -= I_IN;
            if (r < I_OUT) { p0_transpose_item(a.in[14] + (size_t)l * DM * DM, DM, DM, (bf16*)(a.ws + WS_WOUT) + (size_t)l * DM * DM, scr, r, lane); continue; } r -= I_OUT;
            if (r < I_1) { p0_transpose_item(a.in[16] + (size_t)l * DM * FF, DM, FF, (bf16*)(a.ws + WS_W1) + (size_t)l * FF * DM, scr, r, lane); continue; } r -= I_1;
            p0_transpose_item(a.in[17] + (size_t)l * FF * DM, FF, DM, (bf16*)(a.ws + WS_W2) + (size_t)l * DM * FF, scr, r, lane);
        }
    }
}

__device__ __forceinline__ void norm_phase0(const float* x, bf16* xn, float* rowss, const float* g, const float* mod_l, int shift_chunk, int gw, int NGW, int lane) {
    for (int r0 = gw * 32; r0 < MTOK; r0 += NGW * 32) {
        const float* mb = mod_l + (size_t)(r0 >> 13) * 6144 + shift_chunk * 1024;
        f32x4 gs[4];
#pragma unroll
        for (int j = 0; j < 4; ++j) { const int c = 4 * lane + 256 * j; const f32x4 g4 = *(const f32x4*)(g + c), sc = *(const f32x4*)(mb + 1024 + c); gs[j] = g4 * (1.f + sc); }
#pragma unroll 2
        for (int i = 0; i < 32; ++i) {
            const float* xr = x + (size_t)(r0 + i) * DM + 4 * lane;
            f32x4 v[4]; float ss = 0.f;
#pragma unroll
            for (int j = 0; j < 4; ++j) { v[j] = *(const f32x4*)(xr + 256 * j); ss += (v[j].x * v[j].x + v[j].y * v[j].y) + (v[j].z * v[j].z + v[j].w * v[j].w); }
            const float tot = wave_sum(ss); if (lane == 0) rowss[r0 + i] = tot;
            bf16* orow = xn + (size_t)(r0 + i) * DM + 4 * lane;
#pragma unroll
            for (int j = 0; j < 4; ++j) { const f32x4 o = v[j] * gs[j]; u32x2 w; w.x = pk2(o.x, o.y); w.y = pk2(o.z, o.w); *(u32x2*)(orow + 256 * j) = w; }
        }
    }
}

__device__ __forceinline__ void bias2_item(const bf16* WT, const float* shift  , float* outp  , int N, int n, int lane) {
    const bf16* wr = WT + (size_t)n * DM + 8 * lane;
    float w[16]; { float t[8]; unpack8(*(const u32x4*)wr, t);
#pragma unroll
        for (int e = 0; e < 8; ++e) w[e] = t[e];
        unpack8(*(const u32x4*)(wr + 512), t);
#pragma unroll
        for (int e = 0; e < 8; ++e) w[8 + e] = t[e]; }
#pragma unroll
    for (int b = 0; b < 8; ++b) { const float* sp = shift + (size_t)b * 6144 + 8 * lane;
        const f32x4 s0 = *(const f32x4*)sp, s1 = *(const f32x4*)(sp + 4), s2 = *(const f32x4*)(sp + 512), s3 = *(const f32x4*)(sp + 516);
        float acc = (s0.x * w[0] + s0.y * w[1]) + (s0.z * w[2] + s0.w * w[3]) + (s1.x * w[4] + s1.y * w[5]) + (s1.z * w[6] + s1.w * w[7])
                  + (s2.x * w[8] + s2.y * w[9]) + (s2.z * w[10] + s2.w * w[11]) + (s3.x * w[12] + s3.y * w[13]) + (s3.z * w[14] + s3.w * w[15]);
        acc = wave_sum(acc);
        if (lane == 0) outp[(size_t)b * N + n] = acc; }
}

__device__ __forceinline__ void sc_item(const bf16* proj, bf16* Y, const float* wsc, int item, int tid) {
    const int cgp = tid & 31, ts = tid >> 5;
    float w[3][8];
#pragma unroll
    for (int k = 0; k < 3; ++k)
#pragma unroll
        for (int e = 0; e < 8; ++e) w[k][e] = wsc[k * 256 + cgp * 8 + e];
    const int r0 = item * 64;
#pragma unroll
    for (int p = 0; p < 4; ++p) {
        const int row = r0 + p * 16 + ts, t = row & (SEQ - 1);
        const bf16* pr = proj + (size_t)row * INW + cgp * 8;
        const u32x4 Bv = *(const u32x4*)pr;
        float acc[8];
#pragma unroll
        for (int e = 0; e < 8; ++e) acc[e] = 0.f;
#pragma unroll
        for (int k = 0; k < 3; ++k) { const int dt = 2 - k;
            if (t - dt >= 0) { const bf16* q = pr - (size_t)dt * INW; const u32x4 Cv = *(const u32x4*)(q + 256), Hv = *(const u32x4*)(q + 512); float c[8], h[8]; unpack8(Cv, c); unpack8(Hv, h);
#pragma unroll
                for (int e = 0; e < 8; ++e) acc[e] += w[k][e] * (c[e] * h[e]); } }
        float bb[8]; unpack8(Bv, bb);
#pragma unroll
        for (int e = 0; e < 8; ++e) bb[e] *= acc[e];
        *(u32x4*)(Y + (size_t)row * DM + cgp * 8) = pack8(bb);
    }
}

__device__ __forceinline__ void cf_item(const bf16* proj, bf16* Y, const float* wcc, const float* bcc, const float* gcl, const float* bcl, unsigned char* lds, int item, int tid, int lane, int wave) {
    float* U = (float*)lds;
    float* CO = (float*)(lds + 62 * 256 * 4);
    const int r0 = item * 32, t0 = r0 & (SEQ - 1);
    for (int idx = tid; idx < 62 * 32; idx += 512) {
        const int rr = idx >> 5, cgp = idx & 31, t = t0 - 30 + rr;
        float u[8];
#pragma unroll
        for (int e = 0; e < 8; ++e) u[e] = 0.f;
        if (t >= 0) { const bf16* p = proj + (size_t)(r0 - 30 + rr) * INW + 2304 + cgp * 8; const u32x4 av = *(const u32x4*)p, gv = *(const u32x4*)(p + 256); float aa[8], gg[8]; unpack8(av, aa); unpack8(gv, gg);
#pragma unroll
            for (int e = 0; e < 8; ++e) u[e] = aa[e] / (1.f + __expf(-gg[e])); }
        *(f32x4*)(U + rr * 256 + cgp * 8) = (f32x4){u[0], u[1], u[2], u[3]}; *(f32x4*)(U + rr * 256 + cgp * 8 + 4) = (f32x4){u[4], u[5], u[6], u[7]};
    }
    __syncthreads();
    {
        const int ch = tid & 255, half = tid >> 8;
        float w[31];
#pragma unroll
        for (int k = 0; k < 31; ++k) w[k] = wcc[k * 256 + ch];
        float uu[46];
#pragma unroll
        for (int i = 0; i < 46; ++i) uu[i] = U[(half * 16 + i) * 256 + ch];
        const float bias = bcc[ch];
#pragma unroll
        for (int tt = 0; tt < 16; ++tt) { float acc = bias;
#pragma unroll
            for (int k = 0; k < 31; ++k) acc += w[k] * uu[tt + k];
            CO[(half * 16 + tt) * 256 + ch] = acc; }
    }
    __syncthreads();
    {
        const f32x4 g4 = *(const f32x4*)(gcl + lane * 4), b4 = *(const f32x4*)(bcl + lane * 4);
#pragma unroll
        for (int i = 0; i < 4; ++i) { const int tl = wave * 4 + i;
            const f32x4 v = *(const f32x4*)(CO + tl * 256 + lane * 4);
            const float mean = wave_sum((v.x + v.y) + (v.z + v.w)) * (1.f / 256.f);
            const f32x4 d = v - mean;
            const float var = wave_sum((d.x * d.x + d.y * d.y) + (d.z * d.z + d.w * d.w)) * (1.f / 256.f);
            const float rstd = rsqrtf(var + 1e-6f);
            f32x4 y = d * rstd * g4 + b4;
            y.x = y.x / (1.f + __expf(-y.x)); y.y = y.y / (1.f + __expf(-y.y)); y.z = y.z / (1.f + __expf(-y.z)); y.w = y.w / (1.f + __expf(-y.w));
            u32x2 w2; w2.x = pk2(y.x, y.y); w2.y = pk2(y.z, y.w);
            *(u32x2*)(Y + (size_t)(r0 + tl) * DM + 768 + lane * 4) = w2; }
    }
    __syncthreads();
}

constexpr float C2 = 0.125f * 1.4426950408889634f;
__device__ __forceinline__ void prep_item(bf16* proj, const int* positions, const float* gq, const float* gk, float* kmean, unsigned char* lds, int item, int tid) {
    f32x2* cs = (f32x2*)lds;
    float* kacc = (float*)(lds + 4096);
    const int b = item >> 5, n = item & 31;
    const int g = tid >> 3, j = tid & 7, tk = g >> 2, h = g & 3;
    if (tid < 256) kacc[tid] = 0.f;
    float gqv[8], gkv[8], ksum[8];
#pragma unroll
    for (int e = 0; e < 8; ++e) { gqv[e] = gq[8 * j + e]; gkv[e] = gk[8 * j + e]; ksum[e] = 0.f; }
    const int f_t = tid & 31, tk_t = tid >> 5;
    const float inv_freq = expf((-9.210340371976184f * (float)f_t) / 32.0f);
    for (int p = 0; p < 16; ++p) {
        const int rowb = b * SEQ + n * 256 + p * 16;
        { const int pos = positions[rowb + tk_t]; const float ang = (float)pos * inv_freq;
          double rev = (double)ang * 0.15915494309189535; rev -= floor(rev); const float rf = (float)rev;
          cs[tk_t * 32 + f_t] = (f32x2){__builtin_amdgcn_cosf(rf), __builtin_amdgcn_sinf(rf)}; }
        __syncthreads();
#pragma unroll
        for (int which = 0; which < 2; ++which) {
            bf16* ptr = proj + (size_t)(rowb + tk) * INW + (which ? 1792 : 1536) + h * 64 + j * 8;
            float v[8]; unpack8(*(const u32x4*)ptr, v);
            float ss = 0.f;
#pragma unroll
            for (int e = 0; e < 8; ++e) ss += v[e] * v[e];
            ss += __shfl_xor(ss, 1); ss += __shfl_xor(ss, 2); ss += __shfl_xor(ss, 4);
            const float rstd = rsqrtf(ss * (1.f / 64.f) + 1e-6f);
            float o[8];
#pragma unroll
            for (int e = 0; e < 8; ++e) { const float y = v[e] * rstd * (which ? gkv[e] : gqv[e]); const float pt = __shfl_xor(y, 4); const f32x2 c = cs[tk * 32 + ((8 * j + e) & 31)];
                o[e] = (j < 4) ? (y * c.x - pt * c.y) : (y * c.x + pt * c.y); }
            if (which == 0) {
#pragma unroll
                for (int e = 0; e < 8; ++e) o[e] *= C2;
            } else {
#pragma unroll
                for (int e = 0; e < 8; ++e) ksum[e] += o[e];
            }
            *(u32x4*)ptr = pack8(o);
        }
        __syncthreads();
    }
#pragma unroll
    for (int e = 0; e < 8; ++e) atomicAdd(&kacc[h * 64 + 8 * j + e], ksum[e]);
    __syncthreads();
    if (tid < 256) kmean[((size_t)(b * 4 + (tid >> 6)) * 32 + n) * 64 + (tid & 63)] = kacc[tid] * (1.f / 256.f);
    __syncthreads();
}

#define MFMA32(a, b, c) __builtin_amdgcn_mfma_f32_32x32x16_bf16((a), (b), (c), 0, 0, 0)
__device__ __forceinline__ int kperm(int rho) { return (rho & 19) | ((rho & 4) << 1) | ((rho & 8) >> 1); }
__device__ __forceinline__ constexpr int kidx(int r, int hi) { return (r & 7) + 8 * hi + 16 * (r >> 3); }
__device__ __forceinline__ constexpr int crow(int r, int hi) { return (r & 3) + 8 * (r >> 2) + 4 * hi; }
constexpr float NEG = -1e30f;

__device__ __forceinline__ void load_k(bf16x8 (&kf)[4], const bf16* Kb, int key0, int lane) {
    const bf16* p = Kb + (size_t)(key0 + kperm(lane & 31)) * INW + (lane >> 5) * 8;
#pragma unroll
    for (int kk = 0; kk < 4; ++kk) kf[kk] = *(const bf16x8*)(p + 16 * kk);
}
__device__ __forceinline__ void load_v(bf16x8 (&vf)[4], const bf16* VTb, int key0, int lane) {
    const bf16* p = VTb + (size_t)(lane & 31) * SEQ + key0 + 8 * (lane >> 5);
    vf[0] = *(const bf16x8*)p; vf[1] = *(const bf16x8*)(p + 16); vf[2] = *(const bf16x8*)(p + 32 * SEQ); vf[3] = *(const bf16x8*)(p + 32 * SEQ + 16);
}
__device__ __forceinline__ void load_q(bf16x8 (&qf)[4], const bf16* Qrow0, int lane) {
    const bf16* p = Qrow0 + (size_t)(lane & 31) * INW + 8 * (lane >> 5);
#pragma unroll
    for (int kk = 0; kk < 4; ++kk) qf[kk] = *(const bf16x8*)(p + 16 * kk);
}
__device__ __forceinline__ void pv_acc(f32x16 (&o)[2], const bf16x8 (&vf)[4], const float (&a)[16]) {
    u32x4 w0, w1;
    w0.x = pk2(a[0], a[1]); w0.y = pk2(a[2], a[3]); w0.z = pk2(a[4], a[5]); w0.w = pk2(a[6], a[7]);
    w1.x = pk2(a[8], a[9]); w1.y = pk2(a[10], a[11]); w1.z = pk2(a[12], a[13]); w1.w = pk2(a[14], a[15]);
    const bf16x8 p0 = __builtin_bit_cast(bf16x8, w0), p1 = __builtin_bit_cast(bf16x8, w1);
    o[0] = MFMA32(vf[0], p0, o[0]); o[0] = MFMA32(vf[1], p1, o[0]);
    o[1] = MFMA32(vf[2], p0, o[1]); o[1] = MFMA32(vf[3], p1, o[1]);
}
__device__ __forceinline__ void store_o_p(bf16* p, const f32x16 (&o)[2], float sc) {
#pragma unroll
    for (int dh = 0; dh < 2; ++dh)
#pragma unroll
        for (int g4 = 0; g4 < 4; ++g4) { u32x2 w; w.x = pk2(o[dh][4 * g4] * sc, o[dh][4 * g4 + 1] * sc); w.y = pk2(o[dh][4 * g4 + 2] * sc, o[dh][4 * g4 + 3] * sc); *(u32x2*)(p + dh * 32 + 8 * g4) = w; }
}
__device__ __forceinline__ void store_o(bf16* Yb, const f32x16 (&o)[2], float sc, int lane) { store_o_p(Yb + (size_t)(lane & 31) * DM + 4 * (lane >> 5), o, sc); }

constexpr float SBSC = 0.125f * 1.4426950408889634f, SBTH = -160.f;
template <bool DIAG> __device__ __forceinline__ void sb_qt(const bf16x8 (&kf)[4], const bf16x8 (&vf)[4], const bf16x8 (&qf)[4], f32x16 (&o)[2], float& carry, int ql, int hi) {
    f32x16 s = {};
#pragma unroll
    for (int kk = 0; kk < 4; ++kk) s = MFMA32(kf[kk], qf[kk], s);
    float L[16], zl[16];
    float lo = 0.f, up = 0.f;
#pragma unroll
    for (int r = 0; r < 16; ++r) { const float z = s[r] * SBSC; const float e = ex2(-fabsf(z)); const float sp = fmaxf(z, 0.f) + lg2(1.f + e);
        const bool valid = !DIAG || (kidx(r, hi) < ql);
        L[r] = valid ? -sp : 0.f; zl[r] = valid ? (z - sp) : -INFINITY;
        if (r < 8) lo += L[r]; else up += L[r]; }
    const float plo = __shfl_xor(lo, 32), pup = __shfl_xor(up, 32);
    const float offU = hi ? carry : carry + pup;
    const float offL = hi ? (carry + up + pup) : (carry + pup + up + plo);
    carry += (lo + plo) + (up + pup);
    float a[16];
    float run = offU;
#pragma unroll
    for (int r = 15; r >= 8; --r) { a[r] = ex2(zl[r] + run); run += L[r]; }
    run = offL;
#pragma unroll
    for (int r = 7; r >= 0; --r) { a[r] = ex2(zl[r] + run); run += L[r]; }
    pv_acc(o, vf, a);
}
__device__ __forceinline__ void sb_item(const bf16* proj, const bf16* vt, bf16* Y, int bh, int qt, int lane) {
    const int b = bh >> 2, h = bh & 3, hi = lane >> 5, ql = lane & 31, q0r = qt * 32;
    const bf16* Qb = proj + (size_t)b * SEQ * INW + 768 + h * 64;
    const bf16* Kb = proj + (size_t)b * SEQ * INW + 1024 + h * 64;
    const bf16* VTb = vt + (size_t)bh * 64 * SEQ;
    bf16x8 q[4]; load_q(q, Qb + (size_t)q0r * INW, lane);
    f32x16 o[2] = {}; float c = 0.f;
    bf16x8 kf[4], vf[4];
    load_k(kf, Kb, q0r, lane); load_v(vf, VTb, q0r, lane);
    sb_qt<true>(kf, vf, q, o, c, ql, hi);
    for (int key0 = q0r - 32; key0 >= 0; key0 -= 32) {
        if (__all(c < SBTH)) break;
        load_k(kf, Kb, key0, lane); load_v(vf, VTb, key0, lane);
        sb_qt<false>(kf, vf, q, o, c, ql, hi);
    }
    store_o(Y + (size_t)(b * SEQ + q0r) * DM + 256 + h * 64, o, 1.f, lane);
}

template <int MODE  > __device__ __forceinline__ void mb_qt(const bf16x8 (&kf)[4], const bf16x8 (&vf)[4], const bf16x8 (&qf)[4], f32x16 (&o)[2], float& mref, float& lsum, bool sel, int ql, int hi) {
    f32x16 s = {};
#pragma unroll
    for (int kk = 0; kk < 4; ++kk) s = MFMA32(kf[kk], qf[kk], s);
    if (MODE == 2) {
#pragma unroll
        for (int r = 0; r < 16; ++r) if (kidx(r, hi) > ql) s[r] = NEG;
    }
    float tm = s[0];
#pragma unroll
    for (int r = 1; r < 16; ++r) tm = fmaxf(tm, s[r]);
    tm = fmaxf(tm, __shfl_xor(tm, 32));
    tm = sel ? tm : NEG;
    if (__any(tm > mref + 16.f)) { const float mn = fmaxf(mref, tm), al = ex2(mref - mn); lsum *= al; o[0] *= al; o[1] *= al; mref = mn; }
    const float me = sel ? mref : INFINITY;
    float p[16];
#pragma unroll
    for (int r = 0; r < 16; ++r) { p[r] = ex2(s[r] - me); lsum += p[r]; }
    pv_acc(o, vf, p);
}
__device__ __forceinline__ unsigned topk_mask(const float* km, const bf16x8 (&qf)[4], int own, int lane) {
    const int hi = lane >> 5;
    f32x16 g = {};
#pragma unroll
    for (int kk = 0; kk < 4; ++kk) { const float* kp = km + (lane & 31) * 64 + 16 * kk + 8 * hi; const f32x4 x0 = *(const f32x4*)kp, x1 = *(const f32x4*)(kp + 4);
        u32x4 wh; wh.x = pk2(x0.x, x0.y); wh.y = pk2(x0.z, x0.w); wh.z = pk2(x1.x, x1.y); wh.w = pk2(x1.z, x1.w);
        u32x4 wl; wl.x = pk2(x0.x - bflo(wh.x), x0.y - bfhi(wh.x)); wl.y = pk2(x0.z - bflo(wh.y), x0.w - bfhi(wh.y)); wl.z = pk2(x1.x - bflo(wh.z), x1.y - bfhi(wh.z)); wl.w = pk2(x1.z - bflo(wh.w), x1.w - bfhi(wh.w));
        g = MFMA32(__builtin_bit_cast(bf16x8, wh), qf[kk], g); g = MFMA32(__builtin_bit_cast(bf16x8, wl), qf[kk], g); }
    float gv[16];
#pragma unroll
    for (int r = 0; r < 16; ++r) gv[r] = (crow(r, hi) < own) ? g[r] : NEG;
    unsigned mask = 0u;
#pragma unroll
    for (int round = 0; round < 3; ++round) {
        float bm = gv[0]; int bi = crow(0, hi);
#pragma unroll
        for (int r = 1; r < 16; ++r) if (gv[r] > bm) { bm = gv[r]; bi = crow(r, hi); }
        const float pm = __shfl_xor(bm, 32); const int pi = __shfl_xor(bi, 32);
        const bool takep = (pm > bm) || (pm == bm && pi < bi);
        const float cm = takep ? pm : bm; const int ci = takep ? pi : bi;
        if (cm > -1e29f) mask |= 1u << ci;
#pragma unroll
        for (int r = 0; r < 16; ++r) if (crow(r, hi) == ci) gv[r] = NEG;
    }
    return mask;
}
__device__ __forceinline__ void moba_select(const bf16* proj, const float* kmean, unsigned* QM, unsigned long long* SQ, int bh, int chunk, int lane) {
    const int b = bh >> 2, h = bh & 3, qstart = chunk * 64, own = chunk >> 2;
    const bf16* Qb = proj + (size_t)b * SEQ * INW + 1536 + h * 64;
    unsigned m0 = 0u, m1 = 0u;
    if (own > 0) { bf16x8 q0[4], q1[4]; load_q(q0, Qb + (size_t)qstart * INW, lane); load_q(q1, Qb + (size_t)(qstart + 32) * INW, lane);
        m0 = topk_mask(kmean + (size_t)bh * 32 * 64, q0, own, lane); m1 = topk_mask(kmean + (size_t)bh * 32 * 64, q1, own, lane); }
    if (lane < 32) { QM[(size_t)bh * SEQ + qstart + lane] = m0; QM[(size_t)bh * SEQ + qstart + 32 + lane] = m1; }
    unsigned long long mine = 0ull;
#pragma unroll
    for (int n = 0; n < 32; ++n) { const unsigned long long b0 = __ballot((m0 >> n) & 1u) & 0xffffffffull, b1 = __ballot((m1 >> n) & 1u) & 0xffffffffull; const unsigned long long v = b0 | (b1 << 32); if (lane == n) mine = v; }
    if (lane < 32) SQ[((size_t)bh * 128 + chunk) * 32 + lane] = mine;
}
__device__ __forceinline__ int select_nth(unsigned long long m, int r) {
    int pos = 0; unsigned w = (unsigned)m; int c = __popc(w);
    if (r >= c) { r -= c; w = (unsigned)(m >> 32); pos = 32; }
    c = __popc(w & 0xffffu); if (r >= c) { r -= c; w >>= 16; pos += 16; }
    c = __popc(w & 0xffu); if (r >= c) { r -= c; w >>= 8; pos += 8; }
    c = __popc(w & 0xfu); if (r >= c) { r -= c; w >>= 4; pos += 4; }
    c = __popc(w & 3u); if (r >= c) { r -= c; w >>= 2; pos += 2; }
    if (r >= (int)(w & 1u)) pos += 1;
    return pos;
}
__device__ __forceinline__ void moba_past(const bf16* proj, const bf16* vt, const unsigned* QM, const unsigned long long* SQ, bf16* POUT, f32x2* PML, int bh, int w, int lane) {
    const int b = bh >> 2, h = bh & 3, hi = lane >> 5, ql = lane & 31;
    const bf16* Qb = proj + (size_t)b * SEQ * INW + 1536 + h * 64;
    const bf16* Kb = proj + (size_t)b * SEQ * INW + 1792 + h * 64;
    const bf16* VTb = vt + (size_t)bh * 64 * SEQ;
    const unsigned long long* sq = SQ + (size_t)bh * 128 * 32;
    int gbase = 0;
    for (int n = 0; n < 31; ++n) {
        const int c0 = 2 * lane;
        const unsigned long long m0 = (c0 >= 4 * (n + 1)) ? sq[c0 * 32 + n] : 0ull;
        const unsigned long long m1 = (c0 + 1 >= 4 * (n + 1)) ? sq[(c0 + 1) * 32 + n] : 0ull;
        const int cA = __popcll(m0), tot = cA + __popcll(m1);
        int incl = tot;
#pragma unroll
        for (int o = 1; o < 64; o <<= 1) { const int t = __shfl_up(incl, o); if (lane >= o) incl += t; }
        const int ex = incl - tot, T = __builtin_amdgcn_readlane(incl, 63);
        const int ntile = (T + 31) >> 5;
        for (int k = (w - gbase) & 63; k < ntile; k += 64) {
            bf16x8 kf[4], vf[4], kg[4], vg[4];
            load_k(kf, Kb, n * 256, lane); load_v(vf, VTb, n * 256, lane);
            const int p = 32 * k + ql;
            unsigned long long cand = __ballot(tot > 0 && ex < 32 * k + 32 && ex + tot > 32 * k);
            int qidx = (n + 1) * 256;
            while (cand) {
                const int j = __ffsll((long long)cand) - 1; cand &= cand - 1ull;
                const int exj = __builtin_amdgcn_readlane(ex, j), totj = __builtin_amdgcn_readlane(tot, j), cAj = __builtin_amdgcn_readlane(cA, j);
                const unsigned m0lo = __builtin_amdgcn_readlane((unsigned)m0, j), m0hi = __builtin_amdgcn_readlane((unsigned)(m0 >> 32), j);
                const unsigned m1lo = __builtin_amdgcn_readlane((unsigned)m1, j), m1hi = __builtin_amdgcn_readlane((unsigned)(m1 >> 32), j);
                if (p >= exj && p < exj + totj) { int r = p - exj; unsigned long long mm = ((unsigned long long)m0hi << 32) | m0lo; int ch = 2 * j;
                    if (r >= cAj) { r -= cAj; mm = ((unsigned long long)m1hi << 32) | m1lo; ch += 1; }
                    qidx = ch * 64 + select_nth(mm, r); }
            }
            const bool valid = p < T;
            bf16x8 q[4];
            { const bf16* qp = Qb + (size_t)qidx * INW + 8 * hi;
#pragma unroll
              for (int kk = 0; kk < 4; ++kk) q[kk] = *(const bf16x8*)(qp + 16 * kk); }
            f32x16 o[2] = {}; float mref = NEG, lsum = 0.f;
            for (int t = 0; t < 8; t += 2) {
                load_k(kg, Kb, n * 256 + 32 * (t + 1), lane); load_v(vg, VTb, n * 256 + 32 * (t + 1), lane);
                mb_qt<1>(kf, vf, q, o, mref, lsum, true, ql, hi);
                if (t + 2 < 8) { load_k(kf, Kb, n * 256 + 32 * (t + 2), lane); load_v(vf, VTb, n * 256 + 32 * (t + 2), lane); }
                mb_qt<1>(kg, vg, q, o, mref, lsum, true, ql, hi);
            }
            lsum += __shfl_xor(lsum, 32);
            if (valid) { const unsigned qm = QM[(size_t)bh * SEQ + qidx]; const int slot = __popc(qm & ((1u << n) - 1u));
                const size_t pi = ((size_t)bh * SEQ + qidx) * 3 + slot;
                store_o_p(POUT + pi * 64 + 4 * hi, o, 1.f / lsum);
                if (hi == 0) PML[pi] = (f32x2){mref, lsum}; }
        }
        gbase += ntile;
    }
}
__device__ __forceinline__ void moba_own(const bf16* proj, const bf16* vt, const bf16* POUT, const f32x2* PML, bf16* Y, int bh, int qt, int lane) {
    const int b = bh >> 2, h = bh & 3, hi = lane >> 5, ql = lane & 31, q0r = qt * 32, own = qt >> 3;
    const bf16* Qb = proj + (size_t)b * SEQ * INW + 1536 + h * 64;
    const bf16* Kb = proj + (size_t)b * SEQ * INW + 1792 + h * 64;
    const bf16* VTb = vt + (size_t)bh * 64 * SEQ;
    bf16x8 q[4]; load_q(q, Qb + (size_t)q0r * INW, lane);
    f32x16 o[2] = {}; float mref = NEG, lsum = 0.f;
    bf16x8 kf[4], vf[4];
    load_k(kf, Kb, q0r, lane); load_v(vf, VTb, q0r, lane);
    mb_qt<2>(kf, vf, q, o, mref, lsum, true, ql, hi);
    for (int key0 = own * 256; key0 < q0r; key0 += 32) { load_k(kf, Kb, key0, lane); load_v(vf, VTb, key0, lane); mb_qt<1>(kf, vf, q, o, mref, lsum, true, ql, hi); }
    lsum += __shfl_xor(lsum, 32);
    const int ns = own < 3 ? own : 3;
    const size_t pi = ((size_t)bh * SEQ + q0r + ql) * 3;
    f32x2 ml[3]; float M = mref;
#pragma unroll
    for (int s = 0; s < 3; ++s) { ml[s] = (f32x2){NEG, 0.f}; if (s < ns) { ml[s] = PML[pi + s]; M = fmaxf(M, ml[s].x); } }
    const float wown = ex2(mref - M); float den = lsum * wown;
    o[0] *= wown; o[1] *= wown;
#pragma unroll
    for (int s = 0; s < 3; ++s) if (s < ns) { const float wsl = ml[s].y * ex2(ml[s].x - M); den += wsl; const bf16* ps = POUT + (pi + s) * 64 + 4 * hi;
#pragma unroll
        for (int dh = 0; dh < 2; ++dh)
#pragma unroll
            for (int g4 = 0; g4 < 4; ++g4) { const u32x2 v = *(const u32x2*)(ps + dh * 32 + 8 * g4);
                o[dh][4 * g4] += wsl * bflo(v.x); o[dh][4 * g4 + 1] += wsl * bfhi(v.x); o[dh][4 * g4 + 2] += wsl * bflo(v.y); o[dh][4 * g4 + 3] += wsl * bfhi(v.y); } }
    store_o(Y + (size_t)(b * SEQ + q0r) * DM + 512 + h * 64, o, 1.f / den, lane);
}

#define XB_TMO      128
#define XB_XCNT(j)  (256  + 64 * (j))
#define XB_XSUB(j)  (1280 + 64 * (j))
#define XB_XGEN(j)  (2304 + 64 * (j))
#define XB_TOP      3328
#define XB_TOPGEN   3392
#define XCD_BAR_WORDS 3456
#define XB_SPIN_CAP (1u << 18)

__device__ __forceinline__ unsigned xb_ld(unsigned* p)              { return __hip_atomic_load(p, __ATOMIC_RELAXED, __HIP_MEMORY_SCOPE_AGENT); }
__device__ __forceinline__ unsigned xb_add(unsigned* p, unsigned v) { return __hip_atomic_fetch_add(p, v, __ATOMIC_RELAXED, __HIP_MEMORY_SCOPE_AGENT); }
__device__ __forceinline__ unsigned xb_xcc_id() { return (unsigned)__builtin_amdgcn_s_getreg((3 << 11) | 20) & 0xFu; }
#define XB_SPIN(cond, bar) do { unsigned _sp = 0; while (cond) { __builtin_amdgcn_s_sleep(1); \
    if ((++_sp & 255u) == 0u) { if (xb_ld(&(bar)[XB_TMO])) break; if (_sp > XB_SPIN_CAP) { atomicAdd(&(bar)[XB_TMO], 1u); break; } } } } while (0)

struct XcdBarrier {
    unsigned* bar; unsigned x;
    volatile LAS unsigned* st;
};

__device__ __forceinline__ XcdBarrier xcd_barrier_post(unsigned* bar, volatile LAS unsigned* st, bool t0) {
    XcdBarrier b; b.bar = bar; b.x = xb_xcc_id(); b.st = st;
    if (t0) (void)xb_add(&bar[XB_XCNT(b.x)], 1u);
    return b;
}
__device__ __forceinline__ void xcd_barrier_complete(unsigned* bar, unsigned x, unsigned& nloc, unsigned& nx) {
    const unsigned G = gridDim.x * gridDim.y * gridDim.z;
    unsigned sum, cnt, mine, sp = 0u;
    for (;;) {
        sum = 0u; cnt = 0u; mine = 0u;
#pragma unroll
        for (unsigned j = 0; j < 16; ++j) { const unsigned c = xb_ld(&bar[XB_XCNT(j)]); sum += c; cnt += (c > 0u) ? 1u : 0u; mine = (j == x) ? c : mine; }
        if (sum == G) break;
        __builtin_amdgcn_s_sleep(1);
        if ((++sp & 255u) == 0u) { if (xb_ld(&bar[XB_TMO])) break; if (sp > XB_SPIN_CAP) { atomicAdd(&bar[XB_TMO], 1u); break; } }
    }
    nloc = mine > 0u ? mine : 1u; nx = cnt > 0u ? cnt : 1u;
}

__device__ __forceinline__ void xcd_barrier(const XcdBarrier& b, bool t0) {
    asm volatile("s_waitcnt vmcnt(0)" ::: "memory");
    __syncthreads();
    if (t0) {
        unsigned* bar = b.bar;
        __builtin_amdgcn_s_waitcnt(0);
        unsigned nloc = b.st[0], nx = b.st[1];
        if (nloc == 0u) { xcd_barrier_complete(bar, b.x, nloc, nx); b.st[0] = nloc; b.st[1] = nx; }
        const unsigned old = xb_add(&bar[XB_XSUB(b.x)], 1u);
        const unsigned gen = old / nloc;
        if (old + 1u == (gen + 1u) * nloc) {
            __builtin_amdgcn_fence(__ATOMIC_RELEASE, "agent");
            asm volatile("s_waitcnt vmcnt(0)" ::: "memory");
            const unsigned og = xb_add(&bar[XB_TOP], 1u);
            const unsigned tg = og / nx;
            if (og + 1u == (tg + 1u) * nx) xb_add(&bar[XB_TOPGEN], 1u);
            else XB_SPIN(xb_ld(&bar[XB_TOPGEN]) == tg, bar);
            __builtin_amdgcn_fence(__ATOMIC_ACQUIRE, "agent");
            xb_add(&bar[XB_XGEN(b.x)], 1u);
            asm volatile("s_waitcnt vmcnt(0)" ::: "memory");
        } else {
            XB_SPIN(xb_ld(&bar[XB_XGEN(b.x)]) == gen, bar);
            __builtin_amdgcn_fence(__ATOMIC_ACQUIRE, "agent");
            asm volatile("s_waitcnt vmcnt(0)" ::: "memory");
        }
    }
    __syncthreads();
}
#ifndef MK_PER_PHASE
#define MK_PER_PHASE 0
#endif
__global__ void __launch_bounds__(NWAVES * 64, 2) hybrid_fwd(Args a) {
    extern __shared__ __attribute__((aligned(16))) unsigned char lds[];
    cg::grid_group grid = cg::this_grid();
    const int G0 = gridDim.x, bx0 = blockIdx.x;
    volatile LAS unsigned* MISC = (volatile LAS unsigned*)((LAS unsigned char*)lds + 131072);
    if (threadIdx.x < 32) MISC[threadIdx.x] = 0u;
    __syncthreads();
    const int wave0 = __builtin_amdgcn_readfirstlane((int)threadIdx.x >> 6);
#define PHASE_IDS int lane = (int)__builtin_amdgcn_mbcnt_hi(~0u, __builtin_amdgcn_mbcnt_lo(~0u, 0u)); asm volatile("" : "+v"(lane)); int bx = bx0, G = G0; asm volatile("" : "+s"(bx), "+s"(G));   \
    const int wave = wave0; const int tid = wave * 64 + lane; const int gw = bx * NWAVES + wave, NGW = G * NWAVES; const int vcu = (G % 8 == 0) ? (bx % 8) * (G / 8) + bx / 8 : bx; (void)tid; (void)gw; (void)NGW; (void)vcu;
    XcdBarrier bar = xcd_barrier_post((unsigned*)(a.ws + WS_CTL), MISC + 8, threadIdx.x == 0);
    unsigned char* ws = a.ws;
    float* mod = (float*)(ws + WS_MOD);
    float* kmean = (float*)(ws + WS_KMEAN);
    bf16* XN = (bf16*)(ws + WS_XN); bf16* Yb = (bf16*)(ws + WS_Y); bf16* PROJ = (bf16*)(ws + WS_PROJ); bf16* HB = (bf16*)(ws + WS_PROJ);
    bf16* VTSB = (bf16*)(ws + WS_VTSB); bf16* VTMB = (bf16*)(ws + WS_VTMB);
    float* ROWSS = (float*)(ws + WS_ROWSS); float* BIAS2 = (float*)(ws + WS_BIAS2);
    bf16* POUT = (bf16*)(ws + WS_POUT); f32x2* PML = (f32x2*)(ws + WS_PML); unsigned* QM = (unsigned*)(ws + WS_QM); unsigned long long* SQ = (unsigned long long*)(ws + WS_SQ);
    const int lo = a.ph_lo, hi_ = a.ph_hi; (void)lo; (void)hi_;
#if MK_PER_PHASE
#define IN(k) (lo <= (k) && (k) < hi_)
#define SEAM(k) do { if (IN(k) && IN((k) + 1)) grid.sync(); } while (0)
#else
#define IN(k) true
#define SEAM(k) do { unsigned ln_ = __builtin_amdgcn_mbcnt_hi(~0u, __builtin_amdgcn_mbcnt_lo(~0u, 0u)); asm volatile("" : "+v"(ln_)); const bool t0_ = (wave0 == 0) && (ln_ == 0u); xcd_barrier(bar, t0_); } while (0)
#endif

#ifndef NO_P0
    if (IN(0)) { PHASE_IDS for (int i = bx * 512 + tid; i < 3 * MTOK; i += G * 512) ROWSS[MTOK + i] = 0.f;
        p0_prologue(a, lds, tid, lane, wave, bx, G); }
#endif
    grid.sync();
    for (int l = 0; l < 2; ++l) {
        const int pb = 1 + 9 * l - (l ? 1 : 0);
        const float* mod_l = mod + (size_t)l * 8 * 6144;
        const float* xin = (l == 0) ? a.in[0] : a.out;
        float* bias_in = BIAS2 + (size_t)l * BIAS2_L; float* bias_m1 = bias_in + 8 * INW;
        if (l == 0) {
            if (IN(pb + 0)) { PHASE_IDS
                for (int it = gw; it < 2 * (INW + FF); it += NGW) { const int ll = it / (INW + FF), r = it % (INW + FF); const float* md = mod + (size_t)ll * 8 * 6144; float* bi = BIAS2 + (size_t)ll * BIAS2_L;
                    if (r < INW) bias2_item((const bf16*)(ws + WS_WIN) + (size_t)ll * INW * DM, md, bi, INW, r, lane);
                    else bias2_item((const bf16*)(ws + WS_W1) + (size_t)ll * FF * DM, md + 3 * 1024, bi + 8 * INW, FF, r - INW, lane); }
                norm_phase0(xin, XN, ROWSS, a.in[5], mod_l, 0, gw, NGW, lane); }
            SEAM(pb + 0);
        }
        if (IN(pb + 1)) { PHASE_IDS
            pg8::Gemm g{XN, (const bf16*)(ws + WS_WIN) + (size_t)l * INW * DM, MTOK, INW, DM}; pg8::StaticOrder S; S.init(MTOK, INW, G, bx);
            pg8::EpiProj E{PROJ, INW, VTSB, VTMB, ROWSS + (size_t)(2 * l) * MTOK, bias_in};
            pg8::gemm_phase<pg8::EpiProj, pg8::StaticOrder, true, true>((PG8_LAS unsigned char*)lds, g, S, E, tid);
        }
        SEAM(pb + 1);
        if (IN(pb + 2)) { PHASE_IDS
#ifndef NO_PREP
            for (int it = bx; it < 256; it += G) prep_item(PROJ, (const int*)a.in[2], a.in[12] + l * 64, a.in[13] + l * 64, kmean, lds, it, tid);
#endif
#ifndef NO_CF
            for (int it = bx; it < MTOK / 32; it += G) cf_item(PROJ, Yb, a.in[8] + l * 31 * 256, a.in[9] + l * 256, a.in[10] + l * 256, a.in[11] + l * 256, lds, it, tid, lane, wave);
#endif
#ifndef NO_SC
            for (int it = bx; it < MTOK / 64; it += G) sc_item(PROJ, Yb, a.in[7] + l * 3 * 256, it, tid);
#endif
#ifndef NO_SB
            for (int it = vcu * NWAVES + wave; it < 32 * 256; it += NGW) sb_item(PROJ, VTSB, Yb, it >> 8, it & 255, lane);
#endif
        }
        SEAM(pb + 2);
        if (IN(pb + 3)) { PHASE_IDS
#ifndef NO_MOBA
            for (int it = vcu * NWAVES + wave; it < 32 * 128; it += NGW) moba_select(PROJ, kmean, QM, SQ, it >> 7, it & 127, lane);
#endif
        }
        SEAM(pb + 3);
        if (IN(pb + 4)) { PHASE_IDS
#ifndef NO_MOBA
            for (int wi = vcu * NWAVES + wave; wi < 32 * 64; wi += NGW) moba_past(PROJ, VTMB, QM, SQ, POUT, PML, wi >> 6, wi & 63, lane);
#endif
        }
        SEAM(pb + 4);
        if (IN(pb + 5)) { PHASE_IDS
#ifndef NO_MOBA
            for (int it = vcu * NWAVES + wave; it < 32 * 256; it += NGW) moba_own(PROJ, VTMB, POUT, PML, Yb, it >> 8, it & 255, lane);
#endif
        }
        SEAM(pb + 5);
        if (IN(pb + 6)) { PHASE_IDS
            pg8::Gemm g{Yb, (const bf16*)(ws + WS_WOUT) + (size_t)l * DM * DM, MTOK, DM, DM}; pg8::StaticOrder S; S.init(MTOK, DM, G, bx);
            pg8::EpiRes E{xin, a.out, mod_l + 2 * 1024, XN, ROWSS + (size_t)(2 * l + 1) * MTOK, a.in[15] + l * DM, mod_l + 4 * 1024};
            pg8::gemm_phase<pg8::EpiRes, pg8::StaticOrder, true, true>((PG8_LAS unsigned char*)lds, g, S, E, tid);
        }
        SEAM(pb + 6);
        if (IN(pb + 7)) { PHASE_IDS
            pg8::Gemm g{XN, (const bf16*)(ws + WS_W1) + (size_t)l * FF * DM, MTOK, FF, DM}; pg8::StaticOrder S; S.init(MTOK, FF, G, bx);
            pg8::EpiRelu2 E{HB, FF, ROWSS + (size_t)(2 * l + 1) * MTOK, bias_m1};
            pg8::gemm_phase<pg8::EpiRelu2, pg8::StaticOrder, true, true>((PG8_LAS unsigned char*)lds, g, S, E, tid);
        }
        SEAM(pb + 7);
        if (IN(pb + 8)) { PHASE_IDS
            pg8::Gemm g{HB, (const bf16*)(ws + WS_W2) + (size_t)l * DM * FF, MTOK, DM, FF}; pg8::StaticOrder S; S.init(MTOK, DM, G, bx);
            pg8::EpiRes E{a.out, a.out, mod_l + 5 * 1024, (l == 0) ? XN : (bf16*)nullptr, ROWSS + (size_t)2 * MTOK, a.in[5] + DM, mod + (size_t)8 * 6144 + 1 * 1024};
            pg8::gemm_phase<pg8::EpiRes, pg8::StaticOrder, true, true>((PG8_LAS unsigned char*)lds, g, S, E, tid);
        }
        if (l == 0) SEAM(pb + 8);
    }
#undef IN
#undef SEAM
}

extern "C" void kernel_launch(void* const* d_in, const int* in_sizes, int n_in, void* d_out, int out_size, void* d_ws, size_t ws_size, hipStream_t stream) {
    static int grid = 0;
    if (grid == 0) {
        if (n_in != 18 || out_size != MTOK * DM || ws_size < WS_END) { fprintf(stderr, "kernel_launch: unexpected shapes (n_in %d out %d ws %zu)\n", n_in, out_size, ws_size); grid = -1; return; }
        int dev = 0, cus = 0, per_cu = 0;
        hipGetDevice(&dev); hipDeviceGetAttribute(&cus, hipDeviceAttributeMultiprocessorCount, dev);
        if (hipFuncSetAttribute((const void*)hybrid_fwd, hipFuncAttributeMaxDynamicSharedMemorySize, LDS_BYTES) != hipSuccess) { fprintf(stderr, "kernel_launch: hipFuncSetAttribute failed\n"); grid = -1; return; }
        if (hipOccupancyMaxActiveBlocksPerMultiprocessor(&per_cu, (const void*)hybrid_fwd, NWAVES * 64, LDS_BYTES) != hipSuccess || per_cu < 1) { fprintf(stderr, "kernel_launch: occupancy query says %d\n", per_cu); per_cu = 1; }
        (void)hipGetLastError();
        grid = cus * per_cu;
    }
    if (grid < 0) return;
    if (hipMemsetAsync((char*)d_ws + WS_CTL, 0, CTL_ZERO_BYTES, stream) != hipSuccess) { fprintf(stderr, "kernel_launch: memset failed\n"); return; }
    Args a{};
    for (int i = 0; i < 18; ++i) a.in[i] = (const float*)d_in[i];
    a.out = (float*)d_out; a.ws = (unsigned char*)d_ws;
#if MK_PER_PHASE
    for (int p = 0; p < N_PHASES; ++p) { a.ph_lo = p; a.ph_hi = p + 1; void* args[] = {&a};
        hipError_t e = hipLaunchCooperativeKernel((const void*)hybrid_fwd, dim3(grid), dim3(NWAVES * 64), args, LDS_BYTES, stream);
        if (e != hipSuccess) { fprintf(stderr, "cooperative launch failed (phase %d): %s (grid %d)\n", p, hipGetErrorString(e), grid); break; } }
#else
    a.ph_lo = 0; a.ph_hi = N_PHASES; void* args[] = {&a};
    hipError_t e = hipLaunchCooperativeKernel((const void*)hybrid_fwd, dim3(grid), dim3(NWAVES * 64), args, LDS_BYTES, stream);
    if (e != hipSuccess) fprintf(stderr, "cooperative launch failed: %s (grid %d)\n", hipGetErrorString(e), grid);
#endif
}
```

```cpp
#include <hip/hip_runtime.h>
#include <hip/hip_cooperative_groups.h>
#include <cstdio>
#include <cstdint>
namespace cg = cooperative_groups;
namespace pg8 {
#define PG8_LAS __attribute__((address_space(3)))
typedef unsigned short bf16_t;
typedef short bf16x8 __attribute__((ext_vector_type(8)));
typedef float f32x4 __attribute__((ext_vector_type(4)));
typedef unsigned u32x4 __attribute__((ext_vector_type(4)));
constexpr int BM = 256, BK = 64, HALF = 128, HTB = HALF * BK * 2  , STAGE_BYTES = 8 * HTB, NXCD = 8, WGM = 8;

__host__ __device__ __forceinline__ int lds_byte(int r, int c) { const int st = (r >> 4) * 2 + (c >> 5), rr = r & 15, cc = c & 31, ob = rr * 64 + cc * 2; return st * 1024 + (ob ^ (((ob >> 9) & 1) << 5)); }
__host__ __device__ __forceinline__ void stage_rc(int b, int& R, int& C) { const int st = b / 1024, sb = b % 1024, swz = sb ^ (((sb >> 9) & 1) << 5); R = (st >> 1) * 16 + swz / 64; C = (st & 1) * 32 + (swz % 64) / 2; }
__host__ __device__ __forceinline__ int perm32(int rho) { const int n = rho >> 4, i = rho & 15; return 8 * (i >> 2) + 4 * n + (i & 3); }

struct Unit { int pm, pn; };
struct Gemm { const bf16_t* A; const bf16_t* Bt; int M, N, K; };

struct StaticOrder {
    int nM, nN, nwg, G, c;
    __host__ __device__ void init(int M, int N, int G_, int c_) { nM = M / BM; nN = N / BM; nwg = nM * nN; G = G_; c = c_; }
    __host__ __device__ bool next(int i, Unit& u) const {
        const long L = (long)i * G + c; if (L >= nwg) return false;
        int wgid = (int)L; { const int q = nwg / NXCD, r = nwg % NXCD, xcd = wgid % NXCD, off = wgid / NXCD; wgid = (xcd < r ? xcd * (q + 1) : r * (q + 1) + (xcd - r) * q) + off; }
        const int nig = WGM * nN, gid = wgid / nig, fm = gid * WGM, gsz = (nM - fm) < WGM ? (nM - fm) : WGM;
        u.pm = fm + ((wgid % nig) % gsz); u.pn = (wgid % nig) / gsz; return true;
    }
    __device__ __forceinline__ void a_ready(const Unit&) const {}
    __device__ __forceinline__ void done(const Unit&) const {}
};
__device__ __forceinline__ unsigned cvt_pk_bf16(float lo, float hi) { unsigned r; asm volatile("v_cvt_pk_bf16_f32 %0, %1, %2" : "=v"(r) : "v"(lo), "v"(hi)); return r; }
typedef float f32x2 __attribute__((ext_vector_type(2)));
__device__ __forceinline__ unsigned short bf16_1(float v) { return (unsigned short)(cvt_pk_bf16(v, v) & 0xffffu); }
struct EpiProj {
    static constexpr bool PERM = true, AFTER_DRAIN = false;
    bf16_t* O; int ldc; bf16_t* vt_sb; bf16_t* vt_mb; const float* rowss; const float* bias2;
    __device__ __forceinline__ void operator()(const f32x4 (&acc)[2][2][4][2], const Unit& u, int wr, int wc, int fr, int fq) const {
        const float* bb = bias2 + (size_t)(u.pm >> 5) * ldc + u.pn * BM + wc * 32 + 8 * fq;
        f32x4 bv[2][2]; float rs[2][4];
#pragma unroll
        for (int bj = 0; bj < 2; ++bj)
#pragma unroll
            for (int n = 0; n < 2; ++n) bv[bj][n] = *(const f32x4*)(bb + bj * HALF + 4 * n);
#pragma unroll
        for (int ai = 0; ai < 2; ++ai)
#pragma unroll
            for (int m = 0; m < 4; ++m) rs[ai][m] = rsqrtf(rowss[u.pm * BM + ai * HALF + wr * 64 + m * 16 + fr] * (1.f / 1024.f) + 1e-6f);
        if (u.pn == 5 || u.pn == 8) {
            bf16_t* vt = (u.pn == 5) ? vt_sb : vt_mb;
            const int b = u.pm >> 5, s0 = (u.pm & 31) * 256 + wr * 64 + fr;
#pragma unroll
            for (int bj = 0; bj < 2; ++bj)
#pragma unroll
                for (int n = 0; n < 2; ++n)
#pragma unroll
                    for (int e = 0; e < 4; ++e) {
                        const int c = 128 * bj + 32 * wc + 8 * fq + 4 * n + e;
                        bf16_t* col = vt + ((size_t)((b * 4 + (c >> 6)) * 64 + (c & 63))) * 8192 + s0;
#pragma unroll
                        for (int ai = 0; ai < 2; ++ai)
#pragma unroll
                            for (int m = 0; m < 4; ++m) col[ai * 128 + m * 16] = bf16_1(acc[ai][bj][m][n][e] * rs[ai][m] + bv[bj][n][e]);
                    }
        } else {
            const int row0 = u.pm * BM + wr * 64 + fr, col0 = u.pn * BM + wc * 32 + 8 * fq;
#pragma unroll
            for (int ai = 0; ai < 2; ++ai)
#pragma unroll
                for (int m = 0; m < 4; ++m) { bf16_t* rowp = O + (size_t)(row0 + ai * HALF + m * 16) * ldc + col0;
#pragma unroll
                    for (int bj = 0; bj < 2; ++bj) { const f32x4 v0 = acc[ai][bj][m][0] * rs[ai][m] + bv[bj][0], v1 = acc[ai][bj][m][1] * rs[ai][m] + bv[bj][1];
                        u32x4 w; w.x = cvt_pk_bf16(v0[0], v0[1]); w.y = cvt_pk_bf16(v0[2], v0[3]); w.z = cvt_pk_bf16(v1[0], v1[1]); w.w = cvt_pk_bf16(v1[2], v1[3]);
                        *(u32x4*)(rowp + bj * HALF) = w; } }
        }
    }
};
struct EpiRelu2 {
    static constexpr bool PERM = true, AFTER_DRAIN = false;
    bf16_t* O; int ldc; const float* rowss; const float* bias2;
    __device__ __forceinline__ void operator()(const f32x4 (&acc)[2][2][4][2], const Unit& u, int wr, int wc, int fr, int fq) const {
        const int row0 = u.pm * BM + wr * 64 + fr, col0 = u.pn * BM + wc * 32 + 8 * fq;
        const float* bb = bias2 + (size_t)(u.pm >> 5) * ldc + col0;
        f32x4 bv[2][2];
#pragma unroll
        for (int bj = 0; bj < 2; ++bj)
#pragma unroll
            for (int n = 0; n < 2; ++n) bv[bj][n] = *(const f32x4*)(bb + bj * HALF + 4 * n);
#pragma unroll
        for (int ai = 0; ai < 2; ++ai)
#pragma unroll
            for (int m = 0; m < 4; ++m) { bf16_t* rowp = O + (size_t)(row0 + ai * HALF + m * 16) * ldc + col0; const float rs = rsqrtf(rowss[row0 + ai * HALF + m * 16] * (1.f / 1024.f) + 1e-6f);
#pragma unroll
                for (int bj = 0; bj < 2; ++bj) { f32x4 v0 = acc[ai][bj][m][0] * rs + bv[bj][0], v1 = acc[ai][bj][m][1] * rs + bv[bj][1];
#pragma unroll
                    for (int e = 0; e < 4; ++e) { const float a0 = fmaxf(v0[e], 0.f), a1 = fmaxf(v1[e], 0.f); v0[e] = a0 * a0; v1[e] = a1 * a1; }
                    u32x4 w; w.x = cvt_pk_bf16(v0[0], v0[1]); w.y = cvt_pk_bf16(v0[2], v0[3]); w.z = cvt_pk_bf16(v1[0], v1[1]); w.w = cvt_pk_bf16(v1[2], v1[3]);
                    *(u32x4*)(rowp + bj * HALF) = w; } }
    }
};
struct EpiRes {
    static constexpr bool PERM = true, AFTER_DRAIN = false;
    const float* base; float* out; const float* gate; bf16_t* xn; float* rowss; const float* gnext; const float* scnext;
    __device__ __forceinline__ void operator()(const f32x4 (&acc)[2][2][4][2], const Unit& u, int wr, int wc, int fr, int fq) const {
        const float* g = gate + (size_t)(u.pm >> 5) * 6144;
        const int col0 = u.pn * BM + wc * 32 + 8 * fq;
        f32x4 gv[2][2], gs[2][2];
#pragma unroll
        for (int bj = 0; bj < 2; ++bj)
#pragma unroll
            for (int n = 0; n < 2; ++n) { gv[bj][n] = *(const f32x4*)(g + col0 + bj * HALF + n * 4);
                if (xn) gs[bj][n] = *(const f32x4*)(gnext + col0 + bj * HALF + n * 4) * (1.f + *(const f32x4*)(scnext + (size_t)(u.pm >> 5) * 6144 + col0 + bj * HALF + n * 4));
                else gs[bj][n] = (f32x4){0.f, 0.f, 0.f, 0.f}; }
#pragma unroll
        for (int ai = 0; ai < 2; ++ai)
#pragma unroll
            for (int mp = 0; mp < 4; mp += 2) {
                f32x4 pre[2][2][2];
#pragma unroll
                for (int mm = 0; mm < 2; ++mm) { const size_t off = (size_t)(u.pm * BM + ai * HALF + wr * 64 + (mp + mm) * 16 + fr) * 1024 + col0;
#pragma unroll
                    for (int bj = 0; bj < 2; ++bj) { pre[mm][bj][0] = *(const f32x4*)(base + off + bj * HALF); pre[mm][bj][1] = *(const f32x4*)(base + off + bj * HALF + 4); } }
                asm volatile("" ::: "memory");
#pragma unroll
                for (int mm = 0; mm < 2; ++mm) { const int m = mp + mm; const int row = u.pm * BM + ai * HALF + wr * 64 + m * 16 + fr; const size_t off = (size_t)row * 1024 + col0; float ss = 0.f;
#pragma unroll
                    for (int bj = 0; bj < 2; ++bj) {
                        const f32x4 o0 = pre[mm][bj][0] + gv[bj][0] * acc[ai][bj][m][0], o1 = pre[mm][bj][1] + gv[bj][1] * acc[ai][bj][m][1];
                        *(f32x4*)(out + off + bj * HALF) = o0; *(f32x4*)(out + off + bj * HALF + 4) = o1;
                        if (xn) { const f32x4 y0 = o0 * gs[bj][0], y1 = o1 * gs[bj][1];
                            u32x4 w; w.x = cvt_pk_bf16(y0[0], y0[1]); w.y = cvt_pk_bf16(y0[2], y0[3]); w.z = cvt_pk_bf16(y1[0], y1[1]); w.w = cvt_pk_bf16(y1[2], y1[3]);
                            *(u32x4*)(xn + off + bj * HALF) = w;
                            ss += ((o0[0] * o0[0] + o0[1] * o0[1]) + (o0[2] * o0[2] + o0[3] * o0[3])) + ((o1[0] * o1[0] + o1[1] * o1[1]) + (o1[2] * o1[2] + o1[3] * o1[3])); } }
                    if (xn) { ss += __shfl_xor(ss, 16); ss += __shfl_xor(ss, 32); if (fq == 0) atomicAdd(rowss + row, ss); } }
            }
    }
};
template <class Epi, class Sched, bool ALIGN_EPI = false, bool SP2 = false>
__device__ __forceinline__ void gemm_phase(PG8_LAS unsigned char* lds, const Gemm g, const Sched& S, const Epi& E, int tid_in) {
    int tid_l = tid_in; asm volatile("" : "+v"(tid_l));
    const int tid = tid_l, wid = __builtin_amdgcn_readfirstlane(tid >> 6), lane = tid & 63, wr = wid >> 2, wc = wid & 3, fr = lane & 15, fq = lane >> 4;
    const int K = g.K, nt = K / BK;
    unsigned voffA[2], voffB[2];
#pragma unroll
    for (int i = 0; i < 2; ++i) { int R, C; stage_rc(tid * 16 + i * 8192, R, C); const int Rb = Epi::PERM ? ((R & ~31) + perm32(R & 31)) : R;
        voffA[i] = (unsigned)(R * K + C) * 2u; voffB[i] = (unsigned)(Rb * K + C) * 2u; }
    const size_t kstep = (size_t)(BK * 2);
    const size_t hstep = (size_t)HALF * K * 2;
    const size_t tstep = 2 * hstep;
    const unsigned ldsw = (unsigned)wid * 1024u;
    const int aoff = lds_byte(wr * 64 + fr, fq * 8), boff = lds_byte(wc * 32 + fr, fq * 8);
#define PG8_SA(b, h) (((b) * 2 + (h)) * HTB)
#define PG8_SB(b, h) ((4 + (b) * 2 + (h)) * HTB)
#define PG8_STAGE(bufoff, gbase, voff) do { _Pragma("unroll") for (int _i = 0; _i < 2; ++_i) \
        __builtin_amdgcn_global_load_lds((const unsigned*)((const char*)(gbase) + (voff)[_i]), (PG8_LAS unsigned*)(lds + (bufoff) + ldsw + _i * 8192), 16, 0, 0); } while (0)
#define PG8_LDA(dst, b, h) do { _Pragma("unroll") for (int m = 0; m < 4; ++m) _Pragma("unroll") for (int k = 0; k < 2; ++k) dst[m][k] = *(const PG8_LAS bf16x8*)(lds + PG8_SA(b, h) + aoff + m * 2048 + k * 1024); } while (0)
#define PG8_LDB(dst, b, h) do { _Pragma("unroll") for (int n = 0; n < 2; ++n) _Pragma("unroll") for (int k = 0; k < 2; ++k) dst[n][k] = *(const PG8_LAS bf16x8*)(lds + PG8_SB(b, h) + boff + n * 2048 + k * 1024); } while (0)
#define PG8_MMA(ai, bj, At, Bt) do { __builtin_amdgcn_s_setprio(1); _Pragma("unroll") for (int m = 0; m < 4; ++m) _Pragma("unroll") for (int n = 0; n < 2; ++n) _Pragma("unroll") for (int k = 0; k < 2; ++k) \
        acc[ai][bj][m][n] = __builtin_amdgcn_mfma_f32_16x16x32_bf16(Bt[n][k], At[m][k], acc[ai][bj][m][n], 0, 0, 0); __builtin_amdgcn_s_setprio(0); } while (0)
#define PG8_WAIT_V(n) asm volatile("s_waitcnt vmcnt(" #n ")" ::: "memory")
#define PG8_WAIT_L(n) asm volatile("s_waitcnt lgkmcnt(" #n ")" ::: "memory")
#define PG8_BAR __builtin_amdgcn_s_barrier()
#define PG8_SCHED __builtin_amdgcn_sched_barrier(0)
    Unit cur, nxt; int ui = 0;
    if (!S.next(0, cur)) return;
    f32x4 acc[2][2][4][2];
#pragma unroll
    for (int a = 0; a < 2; ++a)
#pragma unroll
        for (int b = 0; b < 2; ++b)
#pragma unroll
            for (int m = 0; m < 4; ++m)
#pragma unroll
                for (int n = 0; n < 2; ++n) acc[a][b][m][n] = (f32x4){0.f, 0.f, 0.f, 0.f};
    bf16x8 At[4][2], B0[2][2], B1[2][2];
    const char* cA = (const char*)g.A + (size_t)cur.pm * tstep; const char* cB = (const char*)g.Bt + (size_t)cur.pn * tstep;
    S.a_ready(cur);
    if constexpr (SP2) {
        PG8_STAGE(PG8_SB(0, 0), cB, voffB); PG8_STAGE(PG8_SB(0, 1), cB + hstep, voffB); PG8_STAGE(PG8_SA(0, 0), cA, voffA); PG8_STAGE(PG8_SA(0, 1), cA + hstep, voffA);
        if (wr == 1) PG8_BAR;
        PG8_WAIT_V(2); PG8_BAR;
        PG8_STAGE(PG8_SB(1, 0), cB + kstep, voffB); PG8_STAGE(PG8_SA(1, 0), cA + kstep, voffA); PG8_STAGE(PG8_SB(1, 1), cB + hstep + kstep, voffB);
        PG8_WAIT_V(6); PG8_BAR;
    } else {
        PG8_STAGE(PG8_SB(0, 0), cB, voffB); PG8_STAGE(PG8_SA(0, 0), cA, voffA); PG8_STAGE(PG8_SB(0, 1), cB + hstep, voffB); PG8_STAGE(PG8_SA(0, 1), cA + hstep, voffA);
        if (wr == 1) PG8_BAR;
        PG8_WAIT_V(4); PG8_BAR;
        PG8_STAGE(PG8_SB(1, 0), cB + kstep, voffB); PG8_STAGE(PG8_SA(1, 0), cA + kstep, voffA); PG8_STAGE(PG8_SB(1, 1), cB + hstep + kstep, voffB);
        PG8_WAIT_V(6); PG8_BAR;
    }
    for (;;) {
        const bool has_next = S.next(ui + 1, nxt);
        const char* nA = has_next ? (const char*)g.A + (size_t)nxt.pm * tstep : cA; const char* nB = has_next ? (const char*)g.Bt + (size_t)nxt.pn * tstep : cB;
        for (int t = 0; t < nt; t += 2) {
            const bool last = (t == nt - 2);
            const char* a1 = cA + (size_t)(t + 1) * kstep;
            const char* a2 = last ? nA : cA + (size_t)(t + 2) * kstep; const char* b2 = last ? nB : cB + (size_t)(t + 2) * kstep;
            const char* a3 = a2 + kstep; const char* b3 = b2 + kstep;
            if (last && has_next) S.a_ready(nxt);
            if constexpr (SP2) {
            PG8_LDB(B0, 0, 0); PG8_LDB(B1, 0, 1); PG8_SCHED; PG8_LDA(At, 0, 0); PG8_STAGE(PG8_SA(1, 1), a1 + hstep, voffA);
            PG8_WAIT_V(8); PG8_WAIT_L(0); PG8_BAR; PG8_MMA(0, 0, At, B0); PG8_MMA(0, 1, At, B1); PG8_BAR; PG8_SCHED;
            PG8_LDA(At, 0, 1); PG8_STAGE(PG8_SB(0, 0), b2, voffB); PG8_STAGE(PG8_SB(0, 1), b2 + hstep, voffB); PG8_STAGE(PG8_SA(0, 0), a2, voffA);
            PG8_WAIT_V(8); PG8_WAIT_L(0); PG8_BAR; PG8_MMA(1, 0, At, B0); PG8_MMA(1, 1, At, B1); PG8_BAR; PG8_SCHED;
            PG8_LDB(B0, 1, 0); PG8_LDB(B1, 1, 1); PG8_SCHED; PG8_LDA(At, 1, 0); PG8_STAGE(PG8_SA(0, 1), a2 + hstep, voffA);
            PG8_WAIT_V(8); PG8_WAIT_L(0); PG8_BAR; PG8_MMA(0, 0, At, B0); PG8_MMA(0, 1, At, B1); PG8_BAR; PG8_SCHED;
            PG8_LDA(At, 1, 1); PG8_STAGE(PG8_SB(1, 0), b3, voffB); PG8_STAGE(PG8_SB(1, 1), b3 + hstep, voffB); PG8_STAGE(PG8_SA(1, 0), a3, voffA);
            PG8_WAIT_V(8); PG8_WAIT_L(0); PG8_BAR; PG8_MMA(1, 0, At, B0); PG8_MMA(1, 1, At, B1); PG8_BAR; PG8_SCHED;
            } else {
            PG8_LDB(B0, 0, 0); PG8_SCHED; PG8_LDA(At, 0, 0); PG8_STAGE(PG8_SA(1, 1), a1 + hstep, voffA);
            PG8_WAIT_L(8); PG8_BAR; PG8_WAIT_L(0); PG8_MMA(0, 0, At, B0); PG8_BAR; PG8_SCHED;
            PG8_LDB(B1, 0, 1); PG8_STAGE(PG8_SB(0, 0), b2, voffB);
            PG8_BAR; PG8_WAIT_L(0); PG8_MMA(0, 1, At, B1); PG8_BAR;
            PG8_LDA(At, 0, 1); PG8_STAGE(PG8_SA(0, 0), a2, voffA);
            PG8_BAR; PG8_WAIT_L(0); PG8_MMA(1, 0, At, B0); PG8_BAR; PG8_SCHED;
            PG8_STAGE(PG8_SB(0, 1), b2 + hstep, voffB);
            PG8_WAIT_V(6); PG8_BAR; PG8_MMA(1, 1, At, B1); PG8_BAR;
            PG8_LDB(B0, 1, 0); PG8_SCHED; PG8_LDA(At, 1, 0); PG8_STAGE(PG8_SA(0, 1), a2 + hstep, voffA);
            PG8_WAIT_L(8); PG8_BAR; PG8_WAIT_L(0); PG8_MMA(0, 0, At, B0); PG8_BAR; PG8_SCHED;
            PG8_LDB(B1, 1, 1); PG8_STAGE(PG8_SB(1, 0), b3, voffB);
            PG8_BAR; PG8_WAIT_L(0); PG8_MMA(0, 1, At, B1); PG8_BAR;
            PG8_LDA(At, 1, 1); PG8_STAGE(PG8_SA(1, 0), a3, voffA);
            PG8_BAR; PG8_WAIT_L(0); PG8_MMA(1, 0, At, B0); PG8_BAR; PG8_SCHED;
            PG8_STAGE(PG8_SB(1, 1), b3 + hstep, voffB);
            PG8_WAIT_V(6); PG8_BAR; PG8_MMA(1, 1, At, B1); PG8_BAR;
            }
        }
        if constexpr (ALIGN_EPI) { if (wr == 0) PG8_BAR; }
        if constexpr (!Epi::AFTER_DRAIN) { E(acc, cur, wr, wc, fr, fq); S.done(cur); }
        if (!has_next) break;
#pragma unroll
        for (int a = 0; a < 2; ++a)
#pragma unroll
            for (int b = 0; b < 2; ++b)
#pragma unroll
                for (int m = 0; m < 4; ++m)
#pragma unroll
                    for (int n = 0; n < 2; ++n) acc[a][b][m][n] = (f32x4){0.f, 0.f, 0.f, 0.f};
        cur = nxt; cA = nA; cB = nB; ++ui;
        if constexpr (ALIGN_EPI) { if (wr == 1) PG8_BAR; }
    }
    PG8_WAIT_V(0);
    if constexpr (!ALIGN_EPI) { if (wr == 0) PG8_BAR; }
    PG8_BAR;
    if constexpr (Epi::AFTER_DRAIN) { E.fused(acc, cur, wr, wc, fr, fq, lds, wid, lane); S.done(cur); }
#undef PG8_SA
#undef PG8_SB
#undef PG8_STAGE
#undef PG8_LDA
#undef PG8_LDB
#undef PG8_MMA
#undef PG8_WAIT_V
#undef PG8_WAIT_L
#undef PG8_BAR
#undef PG8_SCHED
}
}

constexpr int NB = 8, SEQ = 8192, DM = 1024, MTOK = NB * SEQ, INW = 2816, FF = 4096, NWAVES = 8;
constexpr size_t MiB = 1u << 20;
constexpr size_t WS_CTL = 1 * MiB, CTL_ZERO_BYTES = 16384;
constexpr size_t WS_MOD = 0, WS_KMEAN = 512 * 1024;
constexpr size_t WS_WIN = 2 * MiB, WS_WOUT = 14 * MiB, WS_W1 = 18 * MiB, WS_W2 = 34 * MiB;
constexpr size_t WS_VTSB = 50 * MiB, WS_VTMB = 82 * MiB;
constexpr size_t WS_XN = 128 * MiB, WS_Y = 256 * MiB, WS_PROJ = 384 * MiB;
constexpr size_t WS_POUT = WS_XN;
constexpr size_t WS_PML = 896 * MiB, WS_QM = 904 * MiB, WS_SQ = 906 * MiB, WS_ROWSS = 908 * MiB, WS_BIAS2 = 909 * MiB, WS_QK2 = 910 * MiB, WS_END = 974 * MiB;
constexpr int LDS_BYTES = 135168;
constexpr int N_PHASES = 18;
constexpr int QKP = 512;
constexpr int BIAS2_L = 8 * INW + 8 * FF;

typedef unsigned short bf16;
typedef short bf16x8 __attribute__((ext_vector_type(8)));
typedef float f32x4 __attribute__((ext_vector_type(4)));
typedef float f32x2 __attribute__((ext_vector_type(2)));
typedef float f32x16 __attribute__((ext_vector_type(16)));
typedef unsigned u32x4 __attribute__((ext_vector_type(4)));
typedef unsigned u32x2 __attribute__((ext_vector_type(2)));
typedef __bf16 bf16x2_t __attribute__((ext_vector_type(2)));
#define LAS __attribute__((address_space(3)))
__device__ __forceinline__ unsigned pk2(float lo, float hi) { f32x2 v = {lo, hi}; bf16x2_t b = __builtin_convertvector(v, bf16x2_t); return __builtin_bit_cast(unsigned, b); }
__device__ __forceinline__ float bflo(unsigned w) { return __uint_as_float(w << 16); }
__device__ __forceinline__ float bfhi(unsigned w) { return __uint_as_float(w & 0xffff0000u); }
__device__ __forceinline__ void unpack8(const u32x4 w, float (&f)[8]) {
    f[0] = bflo(w.x); f[1] = bfhi(w.x); f[2] = bflo(w.y); f[3] = bfhi(w.y); f[4] = bflo(w.z); f[5] = bfhi(w.z); f[6] = bflo(w.w); f[7] = bfhi(w.w); }
__device__ __forceinline__ u32x4 pack8(const float (&f)[8]) { u32x4 w; w.x = pk2(f[0], f[1]); w.y = pk2(f[2], f[3]); w.z = pk2(f[4], f[5]); w.w = pk2(f[6], f[7]); return w; }
__device__ __forceinline__ float wave_sum(float v) {
#pragma unroll
    for (int o = 1; o < 64; o <<= 1) v += __shfl_xor(v, o);
    return v;
}
__device__ __forceinline__ float ex2(float x) { return __builtin_amdgcn_exp2f(x); }
__device__ __forceinline__ float lg2(float x) { return __builtin_amdgcn_logf(x); }

struct Args { const float* in[18]; float* out; unsigned char* ws; int ph_lo, ph_hi; };

__device__ __forceinline__ void p0_transpose_item(const float* W, int K, int N, bf16* WT, LAS float* scr, int item, int lane) {
    const int nblk = N / 32, kb = item / nblk, nb = item % nblk, k0 = 64 * kb, n0 = 32 * nb;
#pragma unroll 8
    for (int i = 0; i < 32; ++i) { const int kk = 2 * i + (lane >> 5); scr[kk * 33 + (lane & 31)] = W[(size_t)(k0 + kk) * N + n0 + (lane & 31)]; }
    asm volatile("s_waitcnt lgkmcnt(0)" ::: "memory");
    const int c = lane & 7;
#pragma unroll
    for (int j = 0; j < 4; ++j) { const int n = (lane >> 3) + 8 * j; const LAS float* s = scr + (8 * c) * 33 + n;
        u32x4 o; o.x = pk2(s[0 * 33], s[1 * 33]); o.y = pk2(s[2 * 33], s[3 * 33]); o.z = pk2(s[4 * 33], s[5 * 33]); o.w = pk2(s[6 * 33], s[7 * 33]);
        *(u32x4*)(WT + (size_t)(n0 + n) * K + k0 + 8 * c) = o; }
    asm volatile("s_waitcnt lgkmcnt(0)" ::: "memory");
}

__device__ __forceinline__ void p0_prologue(const Args& a, unsigned char* lds, int tid, int lane, int wave, int bx, int G) {
    {
        float* cact = (float*)lds;
        float* red = (float*)(lds + 32768);
        const float* c = a.in[1]; const float* w_ada = a.in[3]; const float* b_ada = a.in[4];
        float* mod = (float*)(a.ws + WS_MOD);
        if (bx < 192) { for (int i = tid; i < 8192; i += 512) { const float v = c[i]; cact[i] = v / (1.f + __expf(-v)); } }
        __syncthreads();
        for (int it = bx; it < 192; it += G) {
            const int l = it / 96, cgp = it % 96;
            const float* W = w_ada + (size_t)l * 1024 * 6144 + cgp * 64 + lane;
            float acc[8];
#pragma unroll
            for (int b = 0; b < 8; ++b) acc[b] = 0.f;
            for (int k0 = wave * 128; k0 < wave * 128 + 128; k0 += 32) {
                float wv[32];
#pragma unroll
                for (int i = 0; i < 32; ++i) wv[i] = W[(size_t)(k0 + i) * 6144];
#pragma unroll
                for (int i = 0; i < 32; i += 4)
#pragma unroll
                    for (int b = 0; b < 8; ++b) { const f32x4 cv = *(const f32x4*)(cact + b * 1024 + k0 + i); acc[b] += cv.x * wv[i] + cv.y * wv[i + 1] + cv.z * wv[i + 2] + cv.w * wv[i + 3]; }
            }
#pragma unroll
            for (int b = 0; b < 8; ++b) red[(wave * 8 + b) * 64 + lane] = acc[b];
            __syncthreads();
            { const int b = tid >> 6, j = tid & 63; float s = 0.f;
#pragma unroll
              for (int w = 0; w < 8; ++w) s += red[(w * 8 + b) * 64 + j];
              mod[(size_t)(l * 8 + b) * 6144 + cgp * 64 + j] = s + b_ada[l * 6144 + cgp * 64 + j]; }
            __syncthreads();
        }
        __syncthreads();
    }
    {
        LAS float* scr = (LAS float*)((LAS unsigned char*)lds + wave * 16384);
        const int gw = bx * NWAVES + wave, NGW = G * NWAVES;
        constexpr int I_IN = (DM / 64) * (INW / 32), I_OUT = (DM / 64) * (DM / 32), I_1 = (DM / 64) * (FF / 32), I_2 = (FF / 64) * (DM / 32);
        constexpr int PER_L = I_IN + I_OUT + I_1 + I_2;
        for (int it = gw; it < 2 * PER_L; it += NGW) {
            const int l = it / PER_L; int r = it % PER_L;
            if (r < I_IN) { p0_transpose_item(a.in[6] + (size_t)l * DM * INW, DM, INW, (bf16*)(a.ws + WS_WIN) + (size_t)l * INW * DM, scr, r, lane); continue; } r -= I_IN;
            if (r < I_OUT) { p0_transpose_item(a.in[14] + (size_t)l * DM * DM, DM, DM, (bf16*)(a.ws + WS_WOUT) + (size_t)l * DM * DM, scr, r, lane); continue; } r -= I_OUT;
            if (r < I_1) { p0_transpose_item(a.in[16] + (size_t)l * DM * FF, DM, FF, (bf16*)(a.ws + WS_W1) + (size_t)l * FF * DM, scr, r, lane); continue; } r -= I_1;
            p0_transpose_item(a.in[17] + (size_t)l * FF * DM, FF, DM, (bf16*)(a.ws + WS_W2) + (size_t)l * DM * FF, scr, r, lane);
        }
    }
}

__device__ __forceinline__ void norm_phase0(const float* x, bf16* xn, float* rowss, const float* g, const float* mod_l, int shift_chunk, int gw, int NGW, int lane) {
    for (int r0 = gw * 32; r0 < MTOK; r0 += NGW * 32) {
        const float* mb = mod_l + (size_t)(r0 >> 13) * 6144 + shift_chunk * 1024;
        f32x4 gs[4];
#pragma unroll
        for (int j = 0; j < 4; ++j) { const int c = 4 * lane + 256 * j; const f32x4 g4 = *(const f32x4*)(g + c), sc = *(const f32x4*)(mb + 1024 + c); gs[j] = g4 * (1.f + sc); }
#pragma unroll 2
        for (int i = 0; i < 32; ++i) {
            const float* xr = x + (size_t)(r0 + i) * DM + 4 * lane;
            f32x4 v[4]; float ss = 0.f;
#pragma unroll
            for (int j = 0; j < 4; ++j) { v[j] = *(const f32x4*)(xr + 256 * j); ss += (v[j].x * v[j].x + v[j].y * v[j].y) + (v[j].z * v[j].z + v[j].w * v[j].w); }
            const float tot = wave_sum(ss); if (lane == 0) rowss[r0 + i] = tot;
            bf16* orow = xn + (size_t)(r0 + i) * DM + 4 * lane;
#pragma unroll
            for (int j = 0; j < 4; ++j) { const f32x4 o = v[j] * gs[j]; u32x2 w; w.x = pk2(o.x, o.y); w.y = pk2(o.z, o.w); *(u32x2*)(orow + 256 * j) = w; }
        }
    }
}

__device__ __forceinline__ void bias2_item(const bf16* WT, const float* shift  , float* outp  , int N, int n, int lane) {
    const bf16* wr = WT + (size_t)n * DM + 8 * lane;
    float w[16]; { float t[8]; unpack8(*(const u32x4*)wr, t);
#pragma unroll
        for (int e = 0; e < 8; ++e) w[e] = t[e];
        unpack8(*(const u32x4*)(wr + 512), t);
#pragma unroll
        for (int e = 0; e < 8; ++e) w[8 + e] = t[e]; }
#pragma unroll
    for (int b = 0; b < 8; ++b) { const float* sp = shift + (size_t)b * 6144 + 8 * lane;
        const f32x4 s0 = *(const f32x4*)sp, s1 = *(const f32x4*)(sp + 4), s2 = *(const f32x4*)(sp + 512), s3 = *(const f32x4*)(sp + 516);
        float acc = (s0.x * w[0] + s0.y * w[1]) + (s0.z * w[2] + s0.w * w[3]) + (s1.x * w[4] + s1.y * w[5]) + (s1.z * w[6] + s1.w * w[7])
                  + (s2.x * w[8] + s2.y * w[9]) + (s2.z * w[10] + s2.w * w[11]) + (s3.x * w[12] + s3.y * w[13]) + (s3.z * w[14] + s3.w * w[15]);
        acc = wave_sum(acc);
        if (lane == 0) outp[(size_t)b * N + n] = acc; }
}

__device__ __forceinline__ void sc_item(const bf16* __restrict__ proj, bf16* __restrict__ Y, const float* __restrict__ wsc, int item, int tid) {
    const int cgp = tid & 31, ts = tid >> 5;
    float w[3][8];
#pragma unroll
    for (int k = 0; k < 3; ++k)
#pragma unroll
        for (int e = 0; e < 8; ++e) w[k][e] = wsc[k * 256 + cgp * 8 + e];
    const int r0 = item * 64;
#pragma unroll
    for (int p = 0; p < 4; ++p) {
        const int row = r0 + p * 16 + ts, t = row & (SEQ - 1);
        const bf16* pr = proj + (size_t)row * INW + cgp * 8;
        const u32x4 Bv = *(const u32x4*)pr;
        float acc[8];
#pragma unroll
        for (int e = 0; e < 8; ++e) acc[e] = 0.f;
#pragma unroll
        for (int k = 0; k < 3; ++k) { const int dt = 2 - k;
            if (t - dt >= 0) { const bf16* q = pr - (size_t)dt * INW; const u32x4 Cv = *(const u32x4*)(q + 256), Hv = *(const u32x4*)(q + 512); float c[8], h[8]; unpack8(Cv, c); unpack8(Hv, h);
#pragma unroll
                for (int e = 0; e < 8; ++e) acc[e] += w[k][e] * (c[e] * h[e]); } }
        float bb[8]; unpack8(Bv, bb);
#pragma unroll
        for (int e = 0; e < 8; ++e) bb[e] *= acc[e];
        *(u32x4*)(Y + (size_t)row * DM + cgp * 8) = pack8(bb);
    }
}

__device__ __forceinline__ void cf_item(const bf16* __restrict__ proj, bf16* __restrict__ Y, const float* __restrict__ wcc, const float* __restrict__ bcc, const float* __restrict__ gcl, const float* __restrict__ bcl, unsigned char* lds, int item, int tid, int lane, int wave) {
    float* U = (float*)lds;
    float* CO = (float*)(lds + 62 * 256 * 4);
    const int r0 = item * 32, t0 = r0 & (SEQ - 1);
    for (int idx = tid; idx < 62 * 32; idx += 512) {
        const int rr = idx >> 5, cgp = idx & 31, t = t0 - 30 + rr;
        float u[8];
#pragma unroll
        for (int e = 0; e < 8; ++e) u[e] = 0.f;
        if (t >= 0) { const bf16* p = proj + (size_t)(r0 - 30 + rr) * INW + 2304 + cgp * 8; const u32x4 av = *(const u32x4*)p, gv = *(const u32x4*)(p + 256); float aa[8], gg[8]; unpack8(av, aa); unpack8(gv, gg);
#pragma unroll
            for (int e = 0; e < 8; ++e) u[e] = aa[e] / (1.f + __expf(-gg[e])); }
        *(f32x4*)(U + rr * 256 + cgp * 8) = (f32x4){u[0], u[1], u[2], u[3]}; *(f32x4*)(U + rr * 256 + cgp * 8 + 4) = (f32x4){u[4], u[5], u[6], u[7]};
    }
    __syncthreads();
    {
        const int ch = tid & 255, half = tid >> 8;
        float w[31];
#pragma unroll
        for (int k = 0; k < 31; ++k) w[k] = wcc[k * 256 + ch];
        float uu[46];
#pragma unroll
        for (int i = 0; i < 46; ++i) uu[i] = U[(half * 16 + i) * 256 + ch];
        const float bias = bcc[ch];
#pragma unroll
        for (int tt = 0; tt < 16; ++tt) { float acc = bias;
#pragma unroll
            for (int k = 0; k < 31; ++k) acc += w[k] * uu[tt + k];
            CO[(half * 16 + tt) * 256 + ch] = acc; }
    }
    __syncthreads();
    {
        const f32x4 g4 = *(const f32x4*)(gcl + lane * 4), b4 = *(const f32x4*)(bcl + lane * 4);
#pragma unroll
        for (int i = 0; i < 4; ++i) { const int tl = wave * 4 + i;
            const f32x4 v = *(const f32x4*)(CO + tl * 256 + lane * 4);
            const float mean = wave_sum((v.x + v.y) + (v.z + v.w)) * (1.f / 256.f);
            const f32x4 d = v - mean;
            const float var = wave_sum((d.x * d.x + d.y * d.y) + (d.z * d.z + d.w * d.w)) * (1.f / 256.f);
            const float rstd = rsqrtf(var + 1e-6f);
            f32x4 y = d * rstd * g4 + b4;
            y.x = y.x / (1.f + __expf(-y.x)); y.y = y.y / (1.f + __expf(-y.y)); y.z = y.z / (1.f + __expf(-y.z)); y.w = y.w / (1.f + __expf(-y.w));
            u32x2 w2; w2.x = pk2(y.x, y.y); w2.y = pk2(y.z, y.w);
            *(u32x2*)(Y + (size_t)(r0 + tl) * DM + 768 + lane * 4) = w2; }
    }
    __syncthreads();
}

constexpr float C2 = 0.125f * 1.4426950408889634f;
__device__ __forceinline__ void prep_item(const bf16* __restrict__ proj, bf16* __restrict__ qk2, const int* __restrict__ positions, const float* gq, const float* gk, float* kmean, unsigned char* lds, int item, int tid) {
    f32x2* cs = (f32x2*)lds;
    float* kacc = (float*)(lds + 4096);
    const int b = item >> 5, n = item & 31;
    const int g = tid >> 3, j = tid & 7, tk = g >> 2, h = g & 3;
    if (tid < 256) kacc[tid] = 0.f;
    float gqv[8], gkv[8], ksum[8];
#pragma unroll
    for (int e = 0; e < 8; ++e) { gqv[e] = gq[8 * j + e]; gkv[e] = gk[8 * j + e]; ksum[e] = 0.f; }
    const int f_t = tid & 31, tk_t = tid >> 5;
    const float inv_freq = expf((-9.210340371976184f * (float)f_t) / 32.0f);
    for (int p = 0; p < 16; ++p) {
        const int rowb = b * SEQ + n * 256 + p * 16;
        { const int pos = positions[rowb + tk_t]; const float ang = (float)pos * inv_freq;
          double rev = (double)ang * 0.15915494309189535; rev -= floor(rev); const float rf = (float)rev;
          cs[tk_t * 32 + f_t] = (f32x2){__builtin_amdgcn_cosf(rf), __builtin_amdgcn_sinf(rf)}; }
        __syncthreads();
#pragma unroll
        for (int which = 0; which < 2; ++which) {
            const bf16* ptr = proj + (size_t)(rowb + tk) * INW + (which ? 1792 : 1536) + h * 64 + j * 8;
            bf16* optr = qk2 + (size_t)(rowb + tk) * QKP + which * 256 + h * 64 + j * 8;
            float v[8]; unpack8(*(const u32x4*)ptr, v);
            float ss = 0.f;
#pragma unroll
            for (int e = 0; e < 8; ++e) ss += v[e] * v[e];
            ss += __shfl_xor(ss, 1); ss += __shfl_xor(ss, 2); ss += __shfl_xor(ss, 4);
            const float rstd = rsqrtf(ss * (1.f / 64.f) + 1e-6f);
            float o[8];
#pragma unroll
            for (int e = 0; e < 8; ++e) { const float y = v[e] * rstd * (which ? gkv[e] : gqv[e]); const float pt = __shfl_xor(y, 4); const f32x2 c = cs[tk * 32 + ((8 * j + e) & 31)];
                o[e] = (j < 4) ? (y * c.x - pt * c.y) : (y * c.x + pt * c.y); }
            if (which == 0) {
#pragma unroll
                for (int e = 0; e < 8; ++e) o[e] *= C2;
            } else {
#pragma unroll
                for (int e = 0; e < 8; ++e) ksum[e] += o[e];
            }
            *(u32x4*)optr = pack8(o);
        }
        __syncthreads();
    }
#pragma unroll
    for (int e = 0; e < 8; ++e) atomicAdd(&kacc[h * 64 + 8 * j + e], ksum[e]);
    __syncthreads();
    if (tid < 256) kmean[((size_t)(b * 4 + (tid >> 6)) * 32 + n) * 64 + (tid & 63)] = kacc[tid] * (1.f / 256.f);
    __syncthreads();
}

#define MFMA32(a, b, c) __builtin_amdgcn_mfma_f32_32x32x16_bf16((a), (b), (c), 0, 0, 0)
__device__ __forceinline__ int kperm(int rho) { return (rho & 19) | ((rho & 4) << 1) | ((rho & 8) >> 1); }
__device__ __forceinline__ constexpr int kidx(int r, int hi) { return (r & 7) + 8 * hi + 16 * (r >> 3); }
__device__ __forceinline__ constexpr int crow(int r, int hi) { return (r & 3) + 8 * (r >> 2) + 4 * hi; }
constexpr float NEG = -1e30f;

template <int PITCH = INW> __device__ __forceinline__ void load_k(bf16x8 (&kf)[4], const bf16* Kb, int key0, int lane) {
    const bf16* p = Kb + (size_t)(key0 + kperm(lane & 31)) * PITCH + (lane >> 5) * 8;
#pragma unroll
    for (int kk = 0; kk < 4; ++kk) kf[kk] = *(const bf16x8*)(p + 16 * kk);
}
__device__ __forceinline__ void load_v(bf16x8 (&vf)[4], const bf16* VTb, int key0, int lane) {
    const bf16* p = VTb + (size_t)(lane & 31) * SEQ + key0 + 8 * (lane >> 5);
    vf[0] = *(const bf16x8*)p; vf[1] = *(const bf16x8*)(p + 16); vf[2] = *(const bf16x8*)(p + 32 * SEQ); vf[3] = *(const bf16x8*)(p + 32 * SEQ + 16);
}
template <int PITCH = INW> __device__ __forceinline__ void load_q(bf16x8 (&qf)[4], const bf16* Qrow0, int lane) {
    const bf16* p = Qrow0 + (size_t)(lane & 31) * PITCH + 8 * (lane >> 5);
#pragma unroll
    for (int kk = 0; kk < 4; ++kk) qf[kk] = *(const bf16x8*)(p + 16 * kk);
}
__device__ __forceinline__ void pv_acc(f32x16 (&o)[2], const bf16x8 (&vf)[4], const float (&a)[16]) {
    u32x4 w0, w1;
    w0.x = pk2(a[0], a[1]); w0.y = pk2(a[2], a[3]); w0.z = pk2(a[4], a[5]); w0.w = pk2(a[6], a[7]);
    w1.x = pk2(a[8], a[9]); w1.y = pk2(a[10], a[11]); w1.z = pk2(a[12], a[13]); w1.w = pk2(a[14], a[15]);
    const bf16x8 p0 = __builtin_bit_cast(bf16x8, w0), p1 = __builtin_bit_cast(bf16x8, w1);
    o[0] = MFMA32(vf[0], p0, o[0]); o[0] = MFMA32(vf[1], p1, o[0]);
    o[1] = MFMA32(vf[2], p0, o[1]); o[1] = MFMA32(vf[3], p1, o[1]);
}
__device__ __forceinline__ void store_o_p(bf16* p, const f32x16 (&o)[2], float sc) {
#pragma unroll
    for (int dh = 0; dh < 2; ++dh)
#pragma unroll
        for (int g4 = 0; g4 < 4; ++g4) { u32x2 w; w.x = pk2(o[dh][4 * g4] * sc, o[dh][4 * g4 + 1] * sc); w.y = pk2(o[dh][4 * g4 + 2] * sc, o[dh][4 * g4 + 3] * sc); *(u32x2*)(p + dh * 32 + 8 * g4) = w; }
}
__device__ __forceinline__ void store_o(bf16* Yb, const f32x16 (&o)[2], float sc, int lane) { store_o_p(Yb + (size_t)(lane & 31) * DM + 4 * (lane >> 5), o, sc); }

constexpr float SBSC = 0.125f * 1.4426950408889634f, SBTH = -160.f;
template <bool DIAG> __device__ __forceinline__ void sb_qt(const bf16x8 (&kf)[4], const bf16x8 (&vf)[4], const bf16x8 (&qf)[4], f32x16 (&o)[2], float& carry, int ql, int hi) {
    f32x16 s = {};
#pragma unroll
    for (int kk = 0; kk < 4; ++kk) s = MFMA32(kf[kk], qf[kk], s);
    float L[16], zl[16];
    float lo = 0.f, up = 0.f;
#pragma unroll
    for (int r = 0; r < 16; ++r) { const float z = s[r] * SBSC; const float e = ex2(-fabsf(z)); const float sp = fmaxf(z, 0.f) + lg2(1.f + e);
        const bool valid = !DIAG || (kidx(r, hi) < ql);
        L[r] = valid ? -sp : 0.f; zl[r] = valid ? (z - sp) : -INFINITY;
        if (r < 8) lo += L[r]; else up += L[r]; }
    const float plo = __shfl_xor(lo, 32), pup = __shfl_xor(up, 32);
    const float offU = hi ? carry : carry + pup;
    const float offL = hi ? (carry + up + pup) : (carry + pup + up + plo);
    carry += (lo + plo) + (up + pup);
    float a[16];
    float run = offU;
#pragma unroll
    for (int r = 15; r >= 8; --r) { a[r] = ex2(zl[r] + run); run += L[r]; }
    run = offL;
#pragma unroll
    for (int r = 7; r >= 0; --r) { a[r] = ex2(zl[r] + run); run += L[r]; }
    pv_acc(o, vf, a);
}
__device__ __forceinline__ void sb_item(const bf16* proj, const bf16* vt, bf16* Y, int bh, int qt, int lane) {
    const int b = bh >> 2, h = bh & 3, hi = lane >> 5, ql = lane & 31, q0r = qt * 32;
    const bf16* Qb = proj + (size_t)b * SEQ * INW + 768 + h * 64;
    const bf16* Kb = proj + (size_t)b * SEQ * INW + 1024 + h * 64;
    const bf16* VTb = vt + (size_t)bh * 64 * SEQ;
    bf16x8 q[4]; load_q(q, Qb + (size_t)q0r * INW, lane);
    f32x16 o[2] = {}; float c = 0.f;
    bf16x8 kf[4], vf[4], kg[4], vg[4];
    load_k(kf, Kb, q0r, lane); load_v(vf, VTb, q0r, lane);
    if (q0r >= 32) { load_k(kg, Kb, q0r - 32, lane); load_v(vg, VTb, q0r - 32, lane); }
    sb_qt<true>(kf, vf, q, o, c, ql, hi);
    for (int key0 = q0r - 32; key0 >= 0; key0 -= 64) {
        if (__all(c < SBTH)) break;
        if (key0 >= 32) { load_k(kf, Kb, key0 - 32, lane); load_v(vf, VTb, key0 - 32, lane); }
        sb_qt<false>(kg, vg, q, o, c, ql, hi);
        if (key0 < 32 || __all(c < SBTH)) break;
        if (key0 >= 64) { load_k(kg, Kb, key0 - 64, lane); load_v(vg, VTb, key0 - 64, lane); }
        sb_qt<false>(kf, vf, q, o, c, ql, hi);
    }
    store_o(Y + (size_t)(b * SEQ + q0r) * DM + 256 + h * 64, o, 1.f, lane);
}

template <int MODE  > __device__ __forceinline__ void mb_qt(const bf16x8 (&kf)[4], const bf16x8 (&vf)[4], const bf16x8 (&qf)[4], f32x16 (&o)[2], float& mref, float& lsum, bool sel, int ql, int hi) {
    f32x16 s = {};
#pragma unroll
    for (int kk = 0; kk < 4; ++kk) s = MFMA32(kf[kk], qf[kk], s);
    if (MODE == 2) {
#pragma unroll
        for (int r = 0; r < 16; ++r) if (kidx(r, hi) > ql) s[r] = NEG;
    }
    float tm = s[0];
#pragma unroll
    for (int r = 1; r < 16; ++r) tm = fmaxf(tm, s[r]);
    tm = fmaxf(tm, __shfl_xor(tm, 32));
    tm = sel ? tm : NEG;
    if (__any(tm > mref + 16.f)) { const float mn = fmaxf(mref, tm), al = ex2(mref - mn); lsum *= al; o[0] *= al; o[1] *= al; mref = mn; }
    const float me = sel ? mref : INFINITY;
    float p[16];
#pragma unroll
    for (int r = 0; r < 16; ++r) { p[r] = ex2(s[r] - me); lsum += p[r]; }
    pv_acc(o, vf, p);
}
__device__ __forceinline__ unsigned topk_mask(const float* km, const bf16x8 (&qf)[4], int own, int lane) {
    const int hi = lane >> 5;
    f32x16 g = {};
#pragma unroll
    for (int kk = 0; kk < 4; ++kk) { const float* kp = km + (lane & 31) * 64 + 16 * kk + 8 * hi; const f32x4 x0 = *(const f32x4*)kp, x1 = *(const f32x4*)(kp + 4);
        u32x4 wh; wh.x = pk2(x0.x, x0.y); wh.y = pk2(x0.z, x0.w); wh.z = pk2(x1.x, x1.y); wh.w = pk2(x1.z, x1.w);
        u32x4 wl; wl.x = pk2(x0.x - bflo(wh.x), x0.y - bfhi(wh.x)); wl.y = pk2(x0.z - bflo(wh.y), x0.w - bfhi(wh.y)); wl.z = pk2(x1.x - bflo(wh.z), x1.y - bfhi(wh.z)); wl.w = pk2(x1.z - bflo(wh.w), x1.w - bfhi(wh.w));
        g = MFMA32(__builtin_bit_cast(bf16x8, wh), qf[kk], g); g = MFMA32(__builtin_bit_cast(bf16x8, wl), qf[kk], g); }
    float gv[16];
#pragma unroll
    for (int r = 0; r < 16; ++r) gv[r] = (crow(r, hi) < own) ? g[r] : NEG;
    unsigned mask = 0u;
#pragma unroll
    for (int round = 0; round < 3; ++round) {
        float bm = gv[0]; int bi = crow(0, hi);
#pragma unroll
        for (int r = 1; r < 16; ++r) if (gv[r] > bm) { bm = gv[r]; bi = crow(r, hi); }
        const float pm = __shfl_xor(bm, 32); const int pi = __shfl_xor(bi, 32);
        const bool takep = (pm > bm) || (pm == bm && pi < bi);
        const float cm = takep ? pm : bm; const int ci = takep ? pi : bi;
        if (cm > -1e29f) mask |= 1u << ci;
#pragma unroll
        for (int r = 0; r < 16; ++r) if (crow(r, hi) == ci) gv[r] = NEG;
    }
    return mask;
}
__device__ __forceinline__ void moba_select(const bf16* proj, const float* kmean, unsigned* QM, unsigned long long* SQ, int bh, int chunk, int lane) {
    const int b = bh >> 2, h = bh & 3, qstart = chunk * 64, own = chunk >> 2;
    const bf16* Qb = proj + (size_t)b * SEQ * QKP + h * 64;
    unsigned m0 = 0u, m1 = 0u;
    if (own > 0) { bf16x8 q0[4], q1[4]; load_q<QKP>(q0, Qb + (size_t)qstart * QKP, lane); load_q<QKP>(q1, Qb + (size_t)(qstart + 32) * QKP, lane);
        m0 = topk_mask(kmean + (size_t)bh * 32 * 64, q0, own, lane); m1 = topk_mask(kmean + (size_t)bh * 32 * 64, q1, own, lane); }
    if (lane < 32) { QM[(size_t)bh * SEQ + qstart + lane] = m0; QM[(size_t)bh * SEQ + qstart + 32 + lane] = m1; }
    unsigned long long mine = 0ull;
#pragma unroll
    for (int n = 0; n < 32; ++n) { const unsigned long long b0 = __ballot((m0 >> n) & 1u) & 0xffffffffull, b1 = __ballot((m1 >> n) & 1u) & 0xffffffffull; const unsigned long long v = b0 | (b1 << 32); if (lane == n) mine = v; }
    if (lane < 32) SQ[((size_t)bh * 128 + chunk) * 32 + lane] = mine;
}
__device__ __forceinline__ int select_nth(unsigned long long m, int r) {
    int pos = 0; unsigned w = (unsigned)m; int c = __popc(w);
    if (r >= c) { r -= c; w = (unsigned)(m >> 32); pos = 32; }
    c = __popc(w & 0xffffu); if (r >= c) { r -= c; w >>= 16; pos += 16; }
    c = __popc(w & 0xffu); if (r >= c) { r -= c; w >>= 8; pos += 8; }
    c = __popc(w & 0xfu); if (r >= c) { r -= c; w >>= 4; pos += 4; }
    c = __popc(w & 3u); if (r >= c) { r -= c; w >>= 2; pos += 2; }
    if (r >= (int)(w & 1u)) pos += 1;
    return pos;
}
__device__ __forceinline__ void moba_past(const bf16* proj, const bf16* vt, const unsigned* QM, const unsigned long long* SQ, bf16* POUT, f32x2* PML, int bh, int w, int lane) {
    const int b = bh >> 2, h = bh & 3, hi = lane >> 5, ql = lane & 31;
    const bf16* Qb = proj + (size_t)b * SEQ * QKP + h * 64;
    const bf16* Kb = proj + (size_t)b * SEQ * QKP + 256 + h * 64;
    const bf16* VTb = vt + (size_t)bh * 64 * SEQ;
    const unsigned long long* sq = SQ + (size_t)bh * 128 * 32;
    int gbase = 0;
    const int c0 = 2 * lane;
    unsigned long long nm0 = (c0 >= 4) ? sq[c0 * 32] : 0ull, nm1 = (c0 + 1 >= 4) ? sq[(c0 + 1) * 32] : 0ull;
    for (int n = 0; n < 31; ++n) {
        const unsigned long long m0 = nm0, m1 = nm1;
        if (n + 1 < 31) { nm0 = (c0 >= 4 * (n + 2)) ? sq[c0 * 32 + n + 1] : 0ull; nm1 = (c0 + 1 >= 4 * (n + 2)) ? sq[(c0 + 1) * 32 + n + 1] : 0ull; }
        const int cA = __popcll(m0), tot = cA + __popcll(m1);
        int incl = tot;
#pragma unroll
        for (int o = 1; o < 64; o <<= 1) { const int t = __shfl_up(incl, o); if (lane >= o) incl += t; }
        const int ex = incl - tot, T = __builtin_amdgcn_readlane(incl, 63);
        const int ntile = (T + 31) >> 5;
        for (int k = (w - gbase) & 63; k < ntile; k += 64) {
            bf16x8 kf[4], vf[4], kg[4], vg[4];
            load_k<QKP>(kf, Kb, n * 256, lane); load_v(vf, VTb, n * 256, lane);
            const int p = 32 * k + ql;
            unsigned long long cand = __ballot(tot > 0 && ex < 32 * k + 32 && ex + tot > 32 * k);
            int qidx = (n + 1) * 256;
            while (cand) {
                const int j = __ffsll((long long)cand) - 1; cand &= cand - 1ull;
                const int exj = __builtin_amdgcn_readlane(ex, j), totj = __builtin_amdgcn_readlane(tot, j), cAj = __builtin_amdgcn_readlane(cA, j);
                const unsigned m0lo = __builtin_amdgcn_readlane((unsigned)m0, j), m0hi = __builtin_amdgcn_readlane((unsigned)(m0 >> 32), j);
                const unsigned m1lo = __builtin_amdgcn_readlane((unsigned)m1, j), m1hi = __builtin_amdgcn_readlane((unsigned)(m1 >> 32), j);
                if (p >= exj && p < exj + totj) { int r = p - exj; unsigned long long mm = ((unsigned long long)m0hi << 32) | m0lo; int ch = 2 * j;
                    if (r >= cAj) { r -= cAj; mm = ((unsigned long long)m1hi << 32) | m1lo; ch += 1; }
                    qidx = ch * 64 + select_nth(mm, r); }
            }
            const bool valid = p < T;
            const unsigned qm = QM[(size_t)bh * SEQ + qidx];
            bf16x8 q[4];
            { const bf16* qp = Qb + (size_t)qidx * QKP + 8 * hi;
#pragma unroll
              for (int kk = 0; kk < 4; ++kk) q[kk] = *(const bf16x8*)(qp + 16 * kk); }
            f32x16 o[2] = {}; float mref = NEG, lsum = 0.f;
            for (int t = 0; t < 8; t += 2) {
                load_k<QKP>(kg, Kb, n * 256 + 32 * (t + 1), lane); load_v(vg, VTb, n * 256 + 32 * (t + 1), lane);
                mb_qt<1>(kf, vf, q, o, mref, lsum, true, ql, hi);
                if (t + 2 < 8) { load_k<QKP>(kf, Kb, n * 256 + 32 * (t + 2), lane); load_v(vf, VTb, n * 256 + 32 * (t + 2), lane); }
                mb_qt<1>(kg, vg, q, o, mref, lsum, true, ql, hi);
            }
            lsum += __shfl_xor(lsum, 32);
            if (valid) { const int slot = __popc(qm & ((1u << n) - 1u));
                const size_t pi = ((size_t)bh * SEQ + qidx) * 3 + slot;
                store_o_p(POUT + pi * 64 + 4 * hi, o, 1.f / lsum);
                if (hi == 0) PML[pi] = (f32x2){mref, lsum}; }
        }
        gbase += ntile;
    }
}
__device__ __forceinline__ void moba_own(const bf16* proj, const bf16* vt, const bf16* POUT, const f32x2* PML, bf16* Y, int bh, int qt, int lane) {
    const int b = bh >> 2, h = bh & 3, hi = lane >> 5, ql = lane & 31, q0r = qt * 32, own = qt >> 3;
    const bf16* Qb = proj + (size_t)b * SEQ * QKP + h * 64;
    const bf16* Kb = proj + (size_t)b * SEQ * QKP + 256 + h * 64;
    const bf16* VTb = vt + (size_t)bh * 64 * SEQ;
    bf16x8 q[4]; load_q<QKP>(q, Qb + (size_t)q0r * QKP, lane);
    f32x16 o[2] = {}; float mref = NEG, lsum = 0.f;
    bf16x8 kf[4], vf[4], kg[4], vg[4];
    load_k<QKP>(kf, Kb, q0r, lane); load_v(vf, VTb, q0r, lane);
    const int kb0 = own * 256;
    if (kb0 < q0r) { load_k<QKP>(kg, Kb, kb0, lane); load_v(vg, VTb, kb0, lane); }
    mb_qt<2>(kf, vf, q, o, mref, lsum, true, ql, hi);
    for (int key0 = kb0; key0 < q0r; key0 += 64) {
        if (key0 + 32 < q0r) { load_k<QKP>(kf, Kb, key0 + 32, lane); load_v(vf, VTb, key0 + 32, lane); }
        mb_qt<1>(kg, vg, q, o, mref, lsum, true, ql, hi);
        if (key0 + 32 >= q0r) break;
        if (key0 + 64 < q0r) { load_k<QKP>(kg, Kb, key0 + 64, lane); load_v(vg, VTb, key0 + 64, lane); }
        mb_qt<1>(kf, vf, q, o, mref, lsum, true, ql, hi);
    }
    lsum += __shfl_xor(lsum, 32);
    const int ns = own < 3 ? own : 3;
    const size_t pi = ((size_t)bh * SEQ + q0r + ql) * 3;
    f32x2 ml[3]; float M = mref;
#pragma unroll
    for (int s = 0; s < 3; ++s) { ml[s] = (f32x2){NEG, 0.f}; if (s < ns) { ml[s] = PML[pi + s]; M = fmaxf(M, ml[s].x); } }
    const float wown = ex2(mref - M); float den = lsum * wown;
    o[0] *= wown; o[1] *= wown;
#pragma unroll
    for (int s = 0; s < 3; ++s) if (s < ns) { const float wsl = ml[s].y * ex2(ml[s].x - M); den += wsl; const bf16* ps = POUT + (pi + s) * 64 + 4 * hi;
#pragma unroll
        for (int dh = 0; dh < 2; ++dh)
#pragma unroll
            for (int g4 = 0; g4 < 4; ++g4) { const u32x2 v = *(const u32x2*)(ps + dh * 32 + 8 * g4);
                o[dh][4 * g4] += wsl * bflo(v.x); o[dh][4 * g4 + 1] += wsl * bfhi(v.x); o[dh][4 * g4 + 2] += wsl * bflo(v.y); o[dh][4 * g4 + 3] += wsl * bfhi(v.y); } }
    store_o(Y + (size_t)(b * SEQ + q0r) * DM + 512 + h * 64, o, 1.f / den, lane);
}

#define XB_TMO      128
#define XB_XCNT(j)  (256  + 64 * (j))
#define XB_XSUB(j)  (1280 + 64 * (j))
#define XB_XGEN(j)  (2304 + 64 * (j))
#define XB_TOP      3328
#define XB_TOPGEN   3392
#define XCD_BAR_WORDS 3456
#define XB_SPIN_CAP (1u << 18)

__device__ __forceinline__ unsigned xb_ld(unsigned* p)              { return __hip_atomic_load(p, __ATOMIC_RELAXED, __HIP_MEMORY_SCOPE_AGENT); }
__device__ __forceinline__ unsigned xb_add(unsigned* p, unsigned v) { return __hip_atomic_fetch_add(p, v, __ATOMIC_RELAXED, __HIP_MEMORY_SCOPE_AGENT); }
__device__ __forceinline__ unsigned xb_xcc_id() { return (unsigned)__builtin_amdgcn_s_getreg((3 << 11) | 20) & 0xFu; }
#define XB_SPIN(cond, bar) do { unsigned _sp = 0; while (cond) { __builtin_amdgcn_s_sleep(1); \
    if ((++_sp & 255u) == 0u) { if (xb_ld(&(bar)[XB_TMO])) break; if (_sp > XB_SPIN_CAP) { atomicAdd(&(bar)[XB_TMO], 1u); break; } } } } while (0)

struct XcdBarrier {
    unsigned* bar; unsigned x;
    volatile LAS unsigned* st;
};

__device__ __forceinline__ XcdBarrier xcd_barrier_post(unsigned* bar, volatile LAS unsigned* st, bool t0) {
    XcdBarrier b; b.bar = bar; b.x = xb_xcc_id(); b.st = st;
    if (t0) (void)xb_add(&bar[XB_XCNT(b.x)], 1u);
    return b;
}
__device__ __forceinline__ void xcd_barrier_complete(unsigned* bar, unsigned x, unsigned& nloc, unsigned& nx) {
    const unsigned G = gridDim.x * gridDim.y * gridDim.z;
    unsigned sum, cnt, mine, sp = 0u;
    for (;;) {
        sum = 0u; cnt = 0u; mine = 0u;
#pragma unroll
        for (unsigned j = 0; j < 16; ++j) { const unsigned c = xb_ld(&bar[XB_XCNT(j)]); sum += c; cnt += (c > 0u) ? 1u : 0u; mine = (j == x) ? c : mine; }
        if (sum == G) break;
        __builtin_amdgcn_s_sleep(1);
        if ((++sp & 255u) == 0u) { if (xb_ld(&bar[XB_TMO])) break; if (sp > XB_SPIN_CAP) { atomicAdd(&bar[XB_TMO], 1u); break; } }
    }
    nloc = mine > 0u ? mine : 1u; nx = cnt > 0u ? cnt : 1u;
}

__device__ __forceinline__ void xcd_barrier(const XcdBarrier& b, bool t0) {
    asm volatile("s_waitcnt vmcnt(0)" ::: "memory");
    __syncthreads();
    if (t0) {
        unsigned* bar = b.bar;
        __builtin_amdgcn_s_waitcnt(0);
        unsigned nloc = b.st[0], nx = b.st[1];
        if (nloc == 0u) { xcd_barrier_complete(bar, b.x, nloc, nx); b.st[0] = nloc; b.st[1] = nx; }
        const unsigned old = xb_add(&bar[XB_XSUB(b.x)], 1u);
        const unsigned gen = old / nloc;
        if (old + 1u == (gen + 1u) * nloc) {
            __builtin_amdgcn_fence(__ATOMIC_RELEASE, "agent");
            asm volatile("s_waitcnt vmcnt(0)" ::: "memory");
            const unsigned og = xb_add(&bar[XB_TOP], 1u);
            const unsigned tg = og / nx;
            if (og + 1u == (tg + 1u) * nx) xb_add(&bar[XB_TOPGEN], 1u);
            else XB_SPIN(xb_ld(&bar[XB_TOPGEN]) == tg, bar);
            __builtin_amdgcn_fence(__ATOMIC_ACQUIRE, "agent");
            xb_add(&bar[XB_XGEN(b.x)], 1u);
            asm volatile("s_waitcnt vmcnt(0)" ::: "memory");
        } else {
            XB_SPIN(xb_ld(&bar[XB_XGEN(b.x)]) == gen, bar);
            __builtin_amdgcn_fence(__ATOMIC_ACQUIRE, "agent");
            asm volatile("s_waitcnt vmcnt(0)" ::: "memory");
        }
    }
    __syncthreads();
}
#ifndef MK_PER_PHASE
#define MK_PER_PHASE 0
#endif
__global__ void __launch_bounds__(NWAVES * 64, 2) hybrid_fwd(Args a) {
    extern __shared__ __attribute__((aligned(16))) unsigned char lds[];
    cg::grid_group grid = cg::this_grid();
    const int G0 = gridDim.x, bx0 = blockIdx.x;
    volatile LAS unsigned* MISC = (volatile LAS unsigned*)((LAS unsigned char*)lds + 131072);
    if (threadIdx.x < 32) MISC[threadIdx.x] = 0u;
    __syncthreads();
    const int wave0 = __builtin_amdgcn_readfirstlane((int)threadIdx.x >> 6);
#define PHASE_IDS int lane = (int)__builtin_amdgcn_mbcnt_hi(~0u, __builtin_amdgcn_mbcnt_lo(~0u, 0u)); asm volatile("" : "+v"(lane)); int bx = bx0, G = G0; asm volatile("" : "+s"(bx), "+s"(G));   \
    const int wave = wave0; const int tid = wave * 64 + lane; const int gw = bx * NWAVES + wave, NGW = G * NWAVES; const int vcu = (G % 8 == 0) ? (bx % 8) * (G / 8) + bx / 8 : bx; (void)tid; (void)gw; (void)NGW; (void)vcu;
    XcdBarrier bar = xcd_barrier_post((unsigned*)(a.ws + WS_CTL), MISC + 8, threadIdx.x == 0);
    unsigned char* ws = a.ws;
    float* mod = (float*)(ws + WS_MOD);
    float* kmean = (float*)(ws + WS_KMEAN);
    bf16* XN = (bf16*)(ws + WS_XN); bf16* Yb = (bf16*)(ws + WS_Y); bf16* PROJ = (bf16*)(ws + WS_PROJ); bf16* HB = (bf16*)(ws + WS_PROJ);
    bf16* VTSB = (bf16*)(ws + WS_VTSB); bf16* VTMB = (bf16*)(ws + WS_VTMB);
    bf16* QK2 = (bf16*)(ws + WS_QK2);
    float* ROWSS = (float*)(ws + WS_ROWSS); float* BIAS2 = (float*)(ws + WS_BIAS2);
    bf16* POUT = (bf16*)(ws + WS_POUT); f32x2* PML = (f32x2*)(ws + WS_PML); unsigned* QM = (unsigned*)(ws + WS_QM); unsigned long long* SQ = (unsigned long long*)(ws + WS_SQ);
    const int lo = a.ph_lo, hi_ = a.ph_hi; (void)lo; (void)hi_;
#if MK_PER_PHASE
#define IN(k) (lo <= (k) && (k) < hi_)
#define SEAM(k) do { if (IN(k) && IN((k) + 1)) grid.sync(); } while (0)
#else
#define IN(k) true
#define SEAM(k) do { unsigned ln_ = __builtin_amdgcn_mbcnt_hi(~0u, __builtin_amdgcn_mbcnt_lo(~0u, 0u)); asm volatile("" : "+v"(ln_)); const bool t0_ = (wave0 == 0) && (ln_ == 0u); xcd_barrier(bar, t0_); } while (0)
#endif

#ifndef NO_P0
    if (IN(0)) { PHASE_IDS for (int i = bx * 512 + tid; i < 3 * MTOK; i += G * 512) ROWSS[MTOK + i] = 0.f;
        p0_prologue(a, lds, tid, lane, wave, bx, G); }
#endif
    grid.sync();
    for (int l = 0; l < 2; ++l) {
        const int pb = 1 + 9 * l - (l ? 1 : 0);
        const float* mod_l = mod + (size_t)l * 8 * 6144;
        const float* xin = (l == 0) ? a.in[0] : a.out;
        float* bias_in = BIAS2 + (size_t)l * BIAS2_L; float* bias_m1 = bias_in + 8 * INW;
        if (l == 0) {
            if (IN(pb + 0)) { PHASE_IDS
                for (int it = gw; it < 2 * (INW + FF); it += NGW) { const int ll = it / (INW + FF), r = it % (INW + FF); const float* md = mod + (size_t)ll * 8 * 6144; float* bi = BIAS2 + (size_t)ll * BIAS2_L;
                    if (r < INW) bias2_item((const bf16*)(ws + WS_WIN) + (size_t)ll * INW * DM, md, bi, INW, r, lane);
                    else bias2_item((const bf16*)(ws + WS_W1) + (size_t)ll * FF * DM, md + 3 * 1024, bi + 8 * INW, FF, r - INW, lane); }
                norm_phase0(xin, XN, ROWSS, a.in[5], mod_l, 0, gw, NGW, lane); }
            SEAM(pb + 0);
        }
        if (IN(pb + 1)) { PHASE_IDS
            pg8::Gemm g{XN, (const bf16*)(ws + WS_WIN) + (size_t)l * INW * DM, MTOK, INW, DM}; pg8::StaticOrder S; S.init(MTOK, INW, G, bx);
            pg8::EpiProj E{PROJ, INW, VTSB, VTMB, ROWSS + (size_t)(2 * l) * MTOK, bias_in};
            pg8::gemm_phase<pg8::EpiProj, pg8::StaticOrder, true, true>((PG8_LAS unsigned char*)lds, g, S, E, tid);
        }
        SEAM(pb + 1);
        if (IN(pb + 2)) { PHASE_IDS
#ifndef NO_PREP
            for (int it = bx; it < 256; it += G) prep_item(PROJ, QK2, (const int*)a.in[2], a.in[12] + l * 64, a.in[13] + l * 64, kmean, lds, it, tid);
#endif
#ifndef NO_CF
            for (int it = bx; it < MTOK / 32; it += G) cf_item(PROJ, Yb, a.in[8] + l * 31 * 256, a.in[9] + l * 256, a.in[10] + l * 256, a.in[11] + l * 256, lds, it, tid, lane, wave);
#endif
#ifndef NO_SC
            for (int it = bx; it < MTOK / 64; it += G) sc_item(PROJ, Yb, a.in[7] + l * 3 * 256, it, tid);
#endif
#ifndef NO_SB
            for (int it = vcu * NWAVES + wave; it < 32 * 256; it += NGW) sb_item(PROJ, VTSB, Yb, it >> 8, it & 255, lane);
#endif
        }
        SEAM(pb + 2);
        if (IN(pb + 3)) { PHASE_IDS
#ifndef NO_MOBA
            for (int it = vcu * NWAVES + wave; it < 32 * 128; it += NGW) moba_select(QK2, kmean, QM, SQ, it >> 7, it & 127, lane);
#endif
        }
        SEAM(pb + 3);
        if (IN(pb + 4)) { PHASE_IDS
#ifndef NO_MOBA
            for (int wi = vcu * NWAVES + wave; wi < 32 * 64; wi += NGW) moba_past(QK2, VTMB, QM, SQ, POUT, PML, wi >> 6, wi & 63, lane);
#endif
        }
        SEAM(pb + 4);
        if (IN(pb + 5)) { PHASE_IDS
#ifndef NO_MOBA
            for (int it = vcu * NWAVES + wave, kq = 0; it < 32 * 256; it += NGW, ++kq) { const int qt = (kq & 1) ? 255 - (it & 255) : (it & 255);
                moba_own(QK2, VTMB, POUT, PML, Yb, it >> 8, qt, lane); }
#endif
        }
        SEAM(pb + 5);
        if (IN(pb + 6)) { PHASE_IDS
            pg8::Gemm g{Yb, (const bf16*)(ws + WS_WOUT) + (size_t)l * DM * DM, MTOK, DM, DM}; pg8::StaticOrder S; S.init(MTOK, DM, G, bx);
            pg8::EpiRes E{xin, a.out, mod_l + 2 * 1024, XN, ROWSS + (size_t)(2 * l + 1) * MTOK, a.in[15] + l * DM, mod_l + 4 * 1024};
            pg8::gemm_phase<pg8::EpiRes, pg8::StaticOrder, true, true>((PG8_LAS unsigned char*)lds, g, S, E, tid);
        }
        SEAM(pb + 6);
        if (IN(pb + 7)) { PHASE_IDS
            pg8::Gemm g{XN, (const bf16*)(ws + WS_W1) + (size_t)l * FF * DM, MTOK, FF, DM}; pg8::StaticOrder S; S.init(MTOK, FF, G, bx);
            pg8::EpiRelu2 E{HB, FF, ROWSS + (size_t)(2 * l + 1) * MTOK, bias_m1};
            pg8::gemm_phase<pg8::EpiRelu2, pg8::StaticOrder, true, true>((PG8_LAS unsigned char*)lds, g, S, E, tid);
        }
        SEAM(pb + 7);
        if (IN(pb + 8)) { PHASE_IDS
            pg8::Gemm g{HB, (const bf16*)(ws + WS_W2) + (size_t)l * DM * FF, MTOK, DM, FF}; pg8::StaticOrder S; S.init(MTOK, DM, G, bx);
            pg8::EpiRes E{a.out, a.out, mod_l + 5 * 1024, (l == 0) ? XN : (bf16*)nullptr, ROWSS + (size_t)2 * MTOK, a.in[5] + DM, mod + (size_t)8 * 6144 + 1 * 1024};
            pg8::gemm_phase<pg8::EpiRes, pg8::StaticOrder, true, true>((PG8_LAS unsigned char*)lds, g, S, E, tid);
        }
        if (l == 0) SEAM(pb + 8);
    }
#undef IN
#undef SEAM
}

extern "C" void kernel_launch(void* const* d_in, const int* in_sizes, int n_in, void* d_out, int out_size, void* d_ws, size_t ws_size, hipStream_t stream) {
    static int grid = 0;
    if (grid == 0) {
        if (n_in != 18 || out_size != MTOK * DM || ws_size < WS_END) { fprintf(stderr, "kernel_launch: unexpected shapes (n_in %d out %d ws %zu)\n", n_in, out_size, ws_size); grid = -1; return; }
        int dev = 0, cus = 0, per_cu = 0;
        hipGetDevice(&dev); hipDeviceGetAttribute(&cus, hipDeviceAttributeMultiprocessorCount, dev);
        if (hipFuncSetAttribute((const void*)hybrid_fwd, hipFuncAttributeMaxDynamicSharedMemorySize, LDS_BYTES) != hipSuccess) { fprintf(stderr, "kernel_launch: hipFuncSetAttribute failed\n"); grid = -1; return; }
        if (hipOccupancyMaxActiveBlocksPerMultiprocessor(&per_cu, (const void*)hybrid_fwd, NWAVES * 64, LDS_BYTES) != hipSuccess || per_cu < 1) { fprintf(stderr, "kernel_launch: occupancy query says %d\n", per_cu); per_cu = 1; }
        (void)hipGetLastError();
        grid = cus * per_cu;
    }
    if (grid < 0) return;
    if (hipMemsetAsync((char*)d_ws + WS_CTL, 0, CTL_ZERO_BYTES, stream) != hipSuccess) { fprintf(stderr, "kernel_launch: memset failed\n"); return; }
    Args a{};
    for (int i = 0; i < 18; ++i) a.in[i] = (const float*)d_in[i];
    a.out = (float*)d_out; a.ws = (unsigned char*)d_ws;
#if MK_PER_PHASE
    for (int p = 0; p < N_PHASES; ++p) { a.ph_lo = p; a.ph_hi = p + 1; void* args[] = {&a};
        hipError_t e = hipLaunchCooperativeKernel((const void*)hybrid_fwd, dim3(grid), dim3(NWAVES * 64), args, LDS_BYTES, stream);
        if (e != hipSuccess) { fprintf(stderr, "cooperative launch failed (phase %d): %s (grid %d)\n", p, hipGetErrorString(e), grid); break; } }
#else
    a.ph_lo = 0; a.ph_hi = N_PHASES; void* args[] = {&a};
    hipError_t e = hipLaunchCooperativeKernel((const void*)hybrid_fwd, dim3(grid), dim3(NWAVES * 64), args, LDS_BYTES, stream);
    if (e != hipSuccess) fprintf(stderr, "cooperative launch failed: %s (grid %d)\n", hipGetErrorString(e), grid);
#endif
}
```

```cpp
#include <hip/hip_runtime.h>
#include <hip/hip_cooperative_groups.h>
#include <cstdio>
#include <cstdint>
namespace cg = cooperative_groups;
namespace pg8 {
#define PG8_LAS __attribute__((address_space(3)))
typedef unsigned short bf16_t;
typedef short bf16x8 __attribute__((ext_vector_type(8)));
typedef float f32x4 __attribute__((ext_vector_type(4)));
typedef unsigned u32x4 __attribute__((ext_vector_type(4)));
constexpr int BM = 256, BK = 64, HALF = 128, HTB = HALF * BK * 2  , STAGE_BYTES = 8 * HTB, NXCD = 8, WGM = 8;

__host__ __device__ __forceinline__ int lds_byte(int r, int c) { const int st = (r >> 4) * 2 + (c >> 5), rr = r & 15, cc = c & 31, ob = rr * 64 + cc * 2; return st * 1024 + (ob ^ (((ob >> 9) & 1) << 5)); }
__host__ __device__ __forceinline__ void stage_rc(int b, int& R, int& C) { const int st = b / 1024, sb = b % 1024, swz = sb ^ (((sb >> 9) & 1) << 5); R = (st >> 1) * 16 + swz / 64; C = (st & 1) * 32 + (swz % 64) / 2; }
__host__ __device__ __forceinline__ int perm32(int rho) { const int n = rho >> 4, i = rho & 15; return 8 * (i >> 2) + 4 * n + (i & 3); }

struct Unit { int pm, pn; };
struct Gemm { const bf16_t* A; const bf16_t* Bt; int M, N, K; };

struct StaticOrder {
    int nM, nN, nwg, G, c;
    __host__ __device__ void init(int M, int N, int G_, int c_) { nM = M / BM; nN = N / BM; nwg = nM * nN; G = G_; c = c_; }
    __host__ __device__ bool next(int i, Unit& u) const {
        const long L = (long)i * G + c; if (L >= nwg) return false;
        int wgid = (int)L; { const int q = nwg / NXCD, r = nwg % NXCD, xcd = wgid % NXCD, off = wgid / NXCD; wgid = (xcd < r ? xcd * (q + 1) : r * (q + 1) + (xcd - r) * q) + off; }
        const int nig = WGM * nN, gid = wgid / nig, fm = gid * WGM, gsz = (nM - fm) < WGM ? (nM - fm) : WGM;
        u.pm = fm + ((wgid % nig) % gsz); u.pn = (wgid % nig) / gsz; return true;
    }
    __device__ __forceinline__ void a_ready(const Unit&) const {}
    __device__ __forceinline__ void done(const Unit&) const {}
};
__device__ __forceinline__ unsigned cvt_pk_bf16(float lo, float hi) { unsigned r; asm volatile("v_cvt_pk_bf16_f32 %0, %1, %2" : "=v"(r) : "v"(lo), "v"(hi)); return r; }
typedef float f32x2 __attribute__((ext_vector_type(2)));
__device__ __forceinline__ unsigned short bf16_1(float v) { return (unsigned short)(cvt_pk_bf16(v, v) & 0xffffu); }
struct EpiProj {
    static constexpr bool PERM = true, AFTER_DRAIN = false;
    bf16_t* O; int ldc; bf16_t* vt_sb; bf16_t* vt_mb; const float* rowss; const float* bias2; bf16_t* qk2; const int* pos; const float* gq; const float* gk; float* kmean; PG8_LAS float* gl;
    __device__ __forceinline__ void operator()(const f32x4 (&acc)[2][2][4][2], const Unit& u, int wr, int wc, int fr, int fq) const {
        const float* bb = bias2 + (size_t)(u.pm >> 5) * ldc + u.pn * BM + wc * 32 + 8 * fq;
        f32x4 bv[2][2]; float rs[2][4];
#pragma unroll
        for (int bj = 0; bj < 2; ++bj)
#pragma unroll
            for (int n = 0; n < 2; ++n) bv[bj][n] = *(const f32x4*)(bb + bj * HALF + 4 * n);
#pragma unroll
        for (int ai = 0; ai < 2; ++ai)
#pragma unroll
            for (int m = 0; m < 4; ++m) rs[ai][m] = rsqrtf(rowss[u.pm * BM + ai * HALF + wr * 64 + m * 16 + fr] * (1.f / 1024.f) + 1e-6f);
        if (u.pn == 1 || u.pn == 2 || u.pn == 9 || u.pn == 10) {
            const bool glu = u.pn >= 9;
            const int row0 = u.pm * BM + wr * 64 + fr, col0 = (glu ? 2304 : 256) + ((u.pn & 1) ? 0 : 128) + wc * 32 + 8 * fq;
#pragma unroll
            for (int ai = 0; ai < 2; ++ai)
#pragma unroll
                for (int m = 0; m < 4; ++m) { bf16_t* rowp = O + (size_t)(row0 + ai * HALF + m * 16) * ldc + col0;
                    f32x4 p0 = acc[ai][0][m][0] * rs[ai][m] + bv[0][0], p1 = acc[ai][0][m][1] * rs[ai][m] + bv[0][1];
                    f32x4 q0 = acc[ai][1][m][0] * rs[ai][m] + bv[1][0], q1 = acc[ai][1][m][1] * rs[ai][m] + bv[1][1];
                    if (glu) {
#pragma unroll
                        for (int e = 0; e < 4; ++e) { q0[e] = 1.f / (1.f + __expf(-q0[e])); q1[e] = 1.f / (1.f + __expf(-q1[e])); } }
                    p0 = p0 * q0; p1 = p1 * q1;
                    u32x4 w; w.x = cvt_pk_bf16(p0[0], p0[1]); w.y = cvt_pk_bf16(p0[2], p0[3]); w.z = cvt_pk_bf16(p1[0], p1[1]); w.w = cvt_pk_bf16(p1[2], p1[3]);
                    *(u32x4*)rowp = w; }
        } else if (u.pn == 6 || u.pn == 7) {
            const bool isk = (u.pn == 7);
            float invf[8]; int fql = fq; asm volatile("" : "+v"(fql));
#pragma unroll
            for (int e = 0; e < 8; ++e) invf[e] = expf((-9.210340371976184f * (float)(8 * fql + e)) / 32.0f);
            const float* gg = (isk ? gk : gq) + 8 * fql;
            const int rowb = u.pm * BM + wr * 64 + fr;
#pragma unroll
            for (int ai = 0; ai < 2; ++ai)
#pragma unroll
                for (int m = 0; m < 4; ++m) {
                    const int row = rowb + ai * HALF + m * 16; const float r_ = rsqrtf(rowss[row] * (1.f / 1024.f) + 1e-6f);
                    const f32x4 a0 = acc[ai][0][m][0] * r_ + *(const f32x4*)bb, a1 = acc[ai][0][m][1] * r_ + *(const f32x4*)(bb + 4), b0 = acc[ai][1][m][0] * r_ + *(const f32x4*)(bb + HALF), b1 = acc[ai][1][m][1] * r_ + *(const f32x4*)(bb + HALF + 4);
                    float ss = ((a0[0] * a0[0] + a0[1] * a0[1]) + (a0[2] * a0[2] + a0[3] * a0[3])) + ((a1[0] * a1[0] + a1[1] * a1[1]) + (a1[2] * a1[2] + a1[3] * a1[3]))
                             + ((b0[0] * b0[0] + b0[1] * b0[1]) + (b0[2] * b0[2] + b0[3] * b0[3])) + ((b1[0] * b1[0] + b1[1] * b1[1]) + (b1[2] * b1[2] + b1[3] * b1[3]));
                    ss += __shfl_xor(ss, 16); ss += __shfl_xor(ss, 32);
                    const float rstd = rsqrtf(ss * (1.f / 64.f) + 1e-6f);
                    const f32x4 ya0 = a0 * rstd * *(const f32x4*)gg, ya1 = a1 * rstd * *(const f32x4*)(gg + 4), yb0 = b0 * rstd * *(const f32x4*)(gg + 32), yb1 = b1 * rstd * *(const f32x4*)(gg + 36);
                    const float lo[8] = {ya0[0], ya0[1], ya0[2], ya0[3], ya1[0], ya1[1], ya1[2], ya1[3]}, hi[8] = {yb0[0], yb0[1], yb0[2], yb0[3], yb1[0], yb1[1], yb1[2], yb1[3]};
                    const float posf = (float)pos[row];
                    float ol[8], oh[8];
#pragma unroll
                    for (int e = 0; e < 8; ++e) { const float ang = posf * invf[e]; const float rv = ang * 0.15915494309189535f; const float rf = rv - floorf(rv);
                        const float c = __builtin_amdgcn_cosf(rf), sn = __builtin_amdgcn_sinf(rf);
                        ol[e] = lo[e] * c - hi[e] * sn; oh[e] = hi[e] * c + lo[e] * sn; }
                    if (!isk) {
#pragma unroll
                        for (int e = 0; e < 8; ++e) { ol[e] *= 0.125f * 1.4426950408889634f; oh[e] *= 0.125f * 1.4426950408889634f; }
                    }
                    bf16_t* qp = qk2 + (size_t)row * 512 + (isk ? 256 : 0) + wc * 64 + 8 * fql;
                    u32x4 w0, w1;
                    w0.x = cvt_pk_bf16(ol[0], ol[1]); w0.y = cvt_pk_bf16(ol[2], ol[3]); w0.z = cvt_pk_bf16(ol[4], ol[5]); w0.w = cvt_pk_bf16(ol[6], ol[7]);
                    w1.x = cvt_pk_bf16(oh[0], oh[1]); w1.y = cvt_pk_bf16(oh[2], oh[3]); w1.z = cvt_pk_bf16(oh[4], oh[5]); w1.w = cvt_pk_bf16(oh[6], oh[7]);
                    *(u32x4*)qp = w0; *(u32x4*)(qp + 32) = w1;
                }
        } else if (u.pn == 5 || u.pn == 8) {
            bf16_t* vt = (u.pn == 5) ? vt_sb : vt_mb;
            const int b = u.pm >> 5, s0 = (u.pm & 31) * 256 + wr * 64 + fr;
#pragma unroll
            for (int bj = 0; bj < 2; ++bj)
#pragma unroll
                for (int n = 0; n < 2; ++n)
#pragma unroll
                    for (int e = 0; e < 4; ++e) {
                        const int c = 128 * bj + 32 * wc + 8 * fq + 4 * n + e;
                        bf16_t* col = vt + ((size_t)((b * 4 + (c >> 6)) * 64 + (c & 63))) * 8192 + s0;
#pragma unroll
                        for (int ai = 0; ai < 2; ++ai)
#pragma unroll
                            for (int m = 0; m < 4; ++m) col[ai * 128 + m * 16] = bf16_1(acc[ai][bj][m][n][e] * rs[ai][m] + bv[bj][n][e]);
                    }
        } else {
            const int row0 = u.pm * BM + wr * 64 + fr, col0 = u.pn * BM + wc * 32 + 8 * fq;
#pragma unroll
            for (int ai = 0; ai < 2; ++ai)
#pragma unroll
                for (int m = 0; m < 4; ++m) { bf16_t* rowp = O + (size_t)(row0 + ai * HALF + m * 16) * ldc + col0;
#pragma unroll
                    for (int bj = 0; bj < 2; ++bj) { const f32x4 v0 = acc[ai][bj][m][0] * rs[ai][m] + bv[bj][0], v1 = acc[ai][bj][m][1] * rs[ai][m] + bv[bj][1];
                        u32x4 w; w.x = cvt_pk_bf16(v0[0], v0[1]); w.y = cvt_pk_bf16(v0[2], v0[3]); w.z = cvt_pk_bf16(v1[0], v1[1]); w.w = cvt_pk_bf16(v1[2], v1[3]);
                        *(u32x4*)(rowp + bj * HALF) = w; } }
        }
    }
};
struct EpiRelu2 {
    static constexpr bool PERM = true, AFTER_DRAIN = false;
    bf16_t* O; int ldc; const float* rowss; const float* bias2;
    __device__ __forceinline__ void operator()(const f32x4 (&acc)[2][2][4][2], const Unit& u, int wr, int wc, int fr, int fq) const {
        const int row0 = u.pm * BM + wr * 64 + fr, col0 = u.pn * BM + wc * 32 + 8 * fq;
        const float* bb = bias2 + (size_t)(u.pm >> 5) * ldc + col0;
        f32x4 bv[2][2];
#pragma unroll
        for (int bj = 0; bj < 2; ++bj)
#pragma unroll
            for (int n = 0; n < 2; ++n) bv[bj][n] = *(const f32x4*)(bb + bj * HALF + 4 * n);
#pragma unroll
        for (int ai = 0; ai < 2; ++ai)
#pragma unroll
            for (int m = 0; m < 4; ++m) { bf16_t* rowp = O + (size_t)(row0 + ai * HALF + m * 16) * ldc + col0; const float rs = rsqrtf(rowss[row0 + ai * HALF + m * 16] * (1.f / 1024.f) + 1e-6f);
#pragma unroll
                for (int bj = 0; bj < 2; ++bj) { f32x4 v0 = acc[ai][bj][m][0] * rs + bv[bj][0], v1 = acc[ai][bj][m][1] * rs + bv[bj][1];
#pragma unroll
                    for (int e = 0; e < 4; ++e) { const float a0 = fmaxf(v0[e], 0.f), a1 = fmaxf(v1[e], 0.f); v0[e] = a0 * a0; v1[e] = a1 * a1; }
                    u32x4 w; w.x = cvt_pk_bf16(v0[0], v0[1]); w.y = cvt_pk_bf16(v0[2], v0[3]); w.z = cvt_pk_bf16(v1[0], v1[1]); w.w = cvt_pk_bf16(v1[2], v1[3]);
                    *(u32x4*)(rowp + bj * HALF) = w; } }
    }
};
typedef _Float16 h16x8 __attribute__((ext_vector_type(8)));
typedef float f32x8 __attribute__((ext_vector_type(8)));
struct EpiRes {
    static constexpr bool PERM = true, AFTER_DRAIN = false;
    const unsigned short* base; void* out; const float* gate; bf16_t* xn; float* rowss; const float* gnext; const float* scnext; int o16;
    __device__ __forceinline__ void operator()(const f32x4 (&acc)[2][2][4][2], const Unit& u, int wr, int wc, int fr, int fq) const {
        const float* g = gate + (size_t)(u.pm >> 5) * 6144;
        const int col0 = u.pn * BM + wc * 32 + 8 * fq;
        f32x4 gv[2][2], gs[2][2];
#pragma unroll
        for (int bj = 0; bj < 2; ++bj)
#pragma unroll
            for (int n = 0; n < 2; ++n) { gv[bj][n] = *(const f32x4*)(g + col0 + bj * HALF + n * 4);
                if (xn) gs[bj][n] = *(const f32x4*)(gnext + col0 + bj * HALF + n * 4) * (1.f + *(const f32x4*)(scnext + (size_t)(u.pm >> 5) * 6144 + col0 + bj * HALF + n * 4));
                else gs[bj][n] = (f32x4){0.f, 0.f, 0.f, 0.f}; }
#pragma unroll
        for (int ai = 0; ai < 2; ++ai)
#pragma unroll
            for (int mp = 0; mp < 4; mp += 4) {
                u32x4 pre[4][2];
#pragma unroll
                for (int mm = 0; mm < 4; ++mm) { const size_t off = (size_t)(u.pm * BM + ai * HALF + wr * 64 + (mp + mm) * 16 + fr) * 1024 + col0;
#pragma unroll
                    for (int bj = 0; bj < 2; ++bj) {
                        pre[mm][bj] = *(const u32x4*)(base + off + bj * HALF); } }
                asm volatile("" ::: "memory");
#pragma unroll
                for (int mm = 0; mm < 4; ++mm) { const int m = mp + mm; const int row = u.pm * BM + ai * HALF + wr * 64 + m * 16 + fr; const size_t off = (size_t)row * 1024 + col0; float ss = 0.f;
#pragma unroll
                    for (int bj = 0; bj < 2; ++bj) {
                        const f32x8 bf = __builtin_convertvector(__builtin_bit_cast(h16x8, pre[mm][bj]), f32x8);
                        const f32x4 o0 = (f32x4){bf[0], bf[1], bf[2], bf[3]} + gv[bj][0] * acc[ai][bj][m][0], o1 = (f32x4){bf[4], bf[5], bf[6], bf[7]} + gv[bj][1] * acc[ai][bj][m][1];
                        if (o16) { const f32x8 f = {o0[0], o0[1], o0[2], o0[3], o1[0], o1[1], o1[2], o1[3]}; *(u32x4*)((unsigned short*)out + off + bj * HALF) = __builtin_bit_cast(u32x4, __builtin_convertvector(f, h16x8)); }
                        else { *(f32x4*)((float*)out + off + bj * HALF) = o0; *(f32x4*)((float*)out + off + bj * HALF + 4) = o1; }
                        if (xn) { const f32x4 y0 = o0 * gs[bj][0], y1 = o1 * gs[bj][1];
                            u32x4 w; w.x = cvt_pk_bf16(y0[0], y0[1]); w.y = cvt_pk_bf16(y0[2], y0[3]); w.z = cvt_pk_bf16(y1[0], y1[1]); w.w = cvt_pk_bf16(y1[2], y1[3]);
                            *(u32x4*)(xn + off + bj * HALF) = w;
                            ss += ((o0[0] * o0[0] + o0[1] * o0[1]) + (o0[2] * o0[2] + o0[3] * o0[3])) + ((o1[0] * o1[0] + o1[1] * o1[1]) + (o1[2] * o1[2] + o1[3] * o1[3])); } }
                    if (xn) { ss += __shfl_xor(ss, 16); ss += __shfl_xor(ss, 32); if (fq == 0) atomicAdd(rowss + row, ss); } }
            }
    }
};
template <class Epi, class Sched, bool ALIGN_EPI = false, bool SP2 = false>
__device__ __forceinline__ void gemm_phase(PG8_LAS unsigned char* lds, const Gemm g, const Sched& S, const Epi& E, int tid_in) {
    int tid_l = tid_in; asm volatile("" : "+v"(tid_l));
    const int tid = tid_l, wid = __builtin_amdgcn_readfirstlane(tid >> 6), lane = tid & 63, wr = wid >> 2, wc = wid & 3, fr = lane & 15, fq = lane >> 4;
    const int K = g.K, nt = K / BK;
    unsigned voffA[2], voffB[2];
#pragma unroll
    for (int i = 0; i < 2; ++i) { int R, C; stage_rc(tid * 16 + i * 8192, R, C); const int Rb = Epi::PERM ? ((R & ~31) + perm32(R & 31)) : R;
        voffA[i] = (unsigned)(R * K + C) * 2u; voffB[i] = (unsigned)(Rb * K + C) * 2u; }
    const size_t kstep = (size_t)(BK * 2);
    const size_t hstep = (size_t)HALF * K * 2;
    const size_t tstep = 2 * hstep;
    const unsigned ldsw = (unsigned)wid * 1024u;
    const int aoff = lds_byte(wr * 64 + fr, fq * 8), boff = lds_byte(wc * 32 + fr, fq * 8);
#define PG8_SA(b, h) (((b) * 2 + (h)) * HTB)
#define PG8_SB(b, h) ((4 + (b) * 2 + (h)) * HTB)
#define PG8_STAGE(bufoff, gbase, voff) do { _Pragma("unroll") for (int _i = 0; _i < 2; ++_i) \
        __builtin_amdgcn_global_load_lds((const unsigned*)((const char*)(gbase) + (voff)[_i]), (PG8_LAS unsigned*)(lds + (bufoff) + ldsw + _i * 8192), 16, 0, 0); } while (0)
#define PG8_LDA(dst, b, h) do { _Pragma("unroll") for (int m = 0; m < 4; ++m) _Pragma("unroll") for (int k = 0; k < 2; ++k) dst[m][k] = *(const PG8_LAS bf16x8*)(lds + PG8_SA(b, h) + aoff + m * 2048 + k * 1024); } while (0)
#define PG8_LDB(dst, b, h) do { _Pragma("unroll") for (int n = 0; n < 2; ++n) _Pragma("unroll") for (int k = 0; k < 2; ++k) dst[n][k] = *(const PG8_LAS bf16x8*)(lds + PG8_SB(b, h) + boff + n * 2048 + k * 1024); } while (0)
#define PG8_MMA(ai, bj, At, Bt) do { __builtin_amdgcn_s_setprio(1); _Pragma("unroll") for (int m = 0; m < 4; ++m) _Pragma("unroll") for (int n = 0; n < 2; ++n) _Pragma("unroll") for (int k = 0; k < 2; ++k) \
        acc[ai][bj][m][n] = __builtin_amdgcn_mfma_f32_16x16x32_bf16(Bt[n][k], At[m][k], acc[ai][bj][m][n], 0, 0, 0); __builtin_amdgcn_s_setprio(0); } while (0)
#define PG8_WAIT_V(n) asm volatile("s_waitcnt vmcnt(" #n ")" ::: "memory")
#define PG8_WAIT_L(n) asm volatile("s_waitcnt lgkmcnt(" #n ")" ::: "memory")
#define PG8_BAR __builtin_amdgcn_s_barrier()
#define PG8_SCHED __builtin_amdgcn_sched_barrier(0)
    Unit cur, nxt; int ui = 0;
    if (!S.next(0, cur)) return;
    f32x4 acc[2][2][4][2];
#pragma unroll
    for (int a = 0; a < 2; ++a)
#pragma unroll
        for (int b = 0; b < 2; ++b)
#pragma unroll
            for (int m = 0; m < 4; ++m)
#pragma unroll
                for (int n = 0; n < 2; ++n) acc[a][b][m][n] = (f32x4){0.f, 0.f, 0.f, 0.f};
    bf16x8 At[4][2], B0[2][2], B1[2][2];
    const char* cA = (const char*)g.A + (size_t)cur.pm * tstep; const char* cB = (const char*)g.Bt + (size_t)cur.pn * tstep;
    S.a_ready(cur);
    if constexpr (SP2) {
        PG8_STAGE(PG8_SB(0, 0), cB, voffB); PG8_STAGE(PG8_SB(0, 1), cB + hstep, voffB); PG8_STAGE(PG8_SA(0, 0), cA, voffA); PG8_STAGE(PG8_SA(0, 1), cA + hstep, voffA);
        if (wr == 1) PG8_BAR;
        PG8_WAIT_V(2); PG8_BAR;
        PG8_STAGE(PG8_SB(1, 0), cB + kstep, voffB); PG8_STAGE(PG8_SA(1, 0), cA + kstep, voffA); PG8_STAGE(PG8_SB(1, 1), cB + hstep + kstep, voffB);
        PG8_WAIT_V(6); PG8_BAR;
    } else {
        PG8_STAGE(PG8_SB(0, 0), cB, voffB); PG8_STAGE(PG8_SA(0, 0), cA, voffA); PG8_STAGE(PG8_SB(0, 1), cB + hstep, voffB); PG8_STAGE(PG8_SA(0, 1), cA + hstep, voffA);
        if (wr == 1) PG8_BAR;
        PG8_WAIT_V(4); PG8_BAR;
        PG8_STAGE(PG8_SB(1, 0), cB + kstep, voffB); PG8_STAGE(PG8_SA(1, 0), cA + kstep, voffA); PG8_STAGE(PG8_SB(1, 1), cB + hstep + kstep, voffB);
        PG8_WAIT_V(6); PG8_BAR;
    }
    for (;;) {
        const bool has_next = S.next(ui + 1, nxt);
        const char* nA = has_next ? (const char*)g.A + (size_t)nxt.pm * tstep : cA; const char* nB = has_next ? (const char*)g.Bt + (size_t)nxt.pn * tstep : cB;
        for (int t = 0; t < nt; t += 2) {
            const bool last = (t == nt - 2);
            const char* a1 = cA + (size_t)(t + 1) * kstep;
            const char* a2 = last ? nA : cA + (size_t)(t + 2) * kstep; const char* b2 = last ? nB : cB + (size_t)(t + 2) * kstep;
            const char* a3 = a2 + kstep; const char* b3 = b2 + kstep;
            if (last && has_next) S.a_ready(nxt);
            if constexpr (SP2) {
            PG8_LDB(B0, 0, 0); PG8_LDB(B1, 0, 1); PG8_SCHED; PG8_LDA(At, 0, 0); PG8_STAGE(PG8_SA(1, 1), a1 + hstep, voffA);
            PG8_WAIT_V(8); PG8_WAIT_L(0); PG8_BAR; PG8_MMA(0, 0, At, B0); PG8_MMA(0, 1, At, B1); PG8_BAR; PG8_SCHED;
            PG8_LDA(At, 0, 1); PG8_STAGE(PG8_SB(0, 0), b2, voffB); PG8_STAGE(PG8_SB(0, 1), b2 + hstep, voffB); PG8_STAGE(PG8_SA(0, 0), a2, voffA);
            PG8_WAIT_V(8); PG8_WAIT_L(0); PG8_BAR; PG8_MMA(1, 0, At, B0); PG8_MMA(1, 1, At, B1); PG8_BAR; PG8_SCHED;
            PG8_LDB(B0, 1, 0); PG8_LDB(B1, 1, 1); PG8_SCHED; PG8_LDA(At, 1, 0); PG8_STAGE(PG8_SA(0, 1), a2 + hstep, voffA);
            PG8_WAIT_V(8); PG8_WAIT_L(0); PG8_BAR; PG8_MMA(0, 0, At, B0); PG8_MMA(0, 1, At, B1); PG8_BAR; PG8_SCHED;
            PG8_LDA(At, 1, 1); PG8_STAGE(PG8_SB(1, 0), b3, voffB); PG8_STAGE(PG8_SB(1, 1), b3 + hstep, voffB); PG8_STAGE(PG8_SA(1, 0), a3, voffA);
            PG8_WAIT_V(8); PG8_WAIT_L(0); PG8_BAR; PG8_MMA(1, 0, At, B0); PG8_MMA(1, 1, At, B1); PG8_BAR; PG8_SCHED;
            } else {
            PG8_LDB(B0, 0, 0); PG8_SCHED; PG8_LDA(At, 0, 0); PG8_STAGE(PG8_SA(1, 1), a1 + hstep, voffA);
            PG8_WAIT_L(8); PG8_BAR; PG8_WAIT_L(0); PG8_MMA(0, 0, At, B0); PG8_BAR; PG8_SCHED;
            PG8_LDB(B1, 0, 1); PG8_STAGE(PG8_SB(0, 0), b2, voffB);
            PG8_BAR; PG8_WAIT_L(0); PG8_MMA(0, 1, At, B1); PG8_BAR;
            PG8_LDA(At, 0, 1); PG8_STAGE(PG8_SA(0, 0), a2, voffA);
            PG8_BAR; PG8_WAIT_L(0); PG8_MMA(1, 0, At, B0); PG8_BAR; PG8_SCHED;
            PG8_STAGE(PG8_SB(0, 1), b2 + hstep, voffB);
            PG8_WAIT_V(6); PG8_BAR; PG8_MMA(1, 1, At, B1); PG8_BAR;
            PG8_LDB(B0, 1, 0); PG8_SCHED; PG8_LDA(At, 1, 0); PG8_STAGE(PG8_SA(0, 1), a2 + hstep, voffA);
            PG8_WAIT_L(8); PG8_BAR; PG8_WAIT_L(0); PG8_MMA(0, 0, At, B0); PG8_BAR; PG8_SCHED;
            PG8_LDB(B1, 1, 1); PG8_STAGE(PG8_SB(1, 0), b3, voffB);
            PG8_BAR; PG8_WAIT_L(0); PG8_MMA(0, 1, At, B1); PG8_BAR;
            PG8_LDA(At, 1, 1); PG8_STAGE(PG8_SA(1, 0), a3, voffA);
            PG8_BAR; PG8_WAIT_L(0); PG8_MMA(1, 0, At, B0); PG8_BAR; PG8_SCHED;
            PG8_STAGE(PG8_SB(1, 1), b3 + hstep, voffB);
            PG8_WAIT_V(6); PG8_BAR; PG8_MMA(1, 1, At, B1); PG8_BAR;
            }
        }
        if constexpr (ALIGN_EPI) { if (wr == 0) PG8_BAR; }
        if constexpr (!Epi::AFTER_DRAIN) { E(acc, cur, wr, wc, fr, fq); S.done(cur); }
        if (!has_next) break;
#pragma unroll
        for (int a = 0; a < 2; ++a)
#pragma unroll
            for (int b = 0; b < 2; ++b)
#pragma unroll
                for (int m = 0; m < 4; ++m)
#pragma unroll
                    for (int n = 0; n < 2; ++n) acc[a][b][m][n] = (f32x4){0.f, 0.f, 0.f, 0.f};
        cur = nxt; cA = nA; cB = nB; ++ui;
        if constexpr (ALIGN_EPI) { if (wr == 1) PG8_BAR; }
    }
    PG8_WAIT_V(0);
    if constexpr (!ALIGN_EPI) { if (wr == 0) PG8_BAR; }
    PG8_BAR;
    if constexpr (Epi::AFTER_DRAIN) { E.fused(acc, cur, wr, wc, fr, fq, lds, wid, lane); S.done(cur); }
#undef PG8_SA
#undef PG8_SB
#undef PG8_STAGE
#undef PG8_LDA
#undef PG8_LDB
#undef PG8_MMA
#undef PG8_WAIT_V
#undef PG8_WAIT_L
#undef PG8_BAR
#undef PG8_SCHED
}
}

constexpr int NB = 8, SEQ = 8192, DM = 1024, MTOK = NB * SEQ, INW = 2816, FF = 4096, NWAVES = 8;
constexpr size_t MiB = 1u << 20;
constexpr size_t WS_CTL = 1 * MiB, CTL_ZERO_BYTES = 16384;
constexpr size_t WS_MOD = 0, WS_KMEAN = 512 * 1024;
constexpr size_t WS_WIN = 2 * MiB, WS_WOUT = 14 * MiB, WS_W1 = 18 * MiB, WS_W2 = 34 * MiB;
constexpr size_t WS_VTSB = 50 * MiB, WS_VTMB = 82 * MiB;
constexpr size_t WS_XN = 128 * MiB, WS_Y = 256 * MiB, WS_PROJ = 384 * MiB;
constexpr size_t WS_POUT = WS_XN;
constexpr size_t WS_PML = 114 * MiB, WS_QM = 122 * MiB, WS_SQ = 124 * MiB, WS_ROWSS = 126 * MiB, WS_BIAS2 = 127 * MiB;
constexpr size_t WS_QK2 = 736 * MiB;
constexpr size_t WS_R16 = 896 * MiB, WS_END = 1024 * MiB;
constexpr int LDS_BYTES = 135168;
constexpr int N_PHASES = 18;
constexpr int QKP = 512;
constexpr int BIAS2_L = 8 * INW + 8 * FF;

typedef unsigned short bf16;
typedef short bf16x8 __attribute__((ext_vector_type(8)));
typedef float f32x4 __attribute__((ext_vector_type(4)));
typedef float f32x2 __attribute__((ext_vector_type(2)));
typedef float f32x16 __attribute__((ext_vector_type(16)));
typedef unsigned u32x4 __attribute__((ext_vector_type(4)));
typedef unsigned u32x2 __attribute__((ext_vector_type(2)));
typedef __bf16 bf16x2_t __attribute__((ext_vector_type(2)));
#define LAS __attribute__((address_space(3)))
__device__ __forceinline__ unsigned pk2(float lo, float hi) { f32x2 v = {lo, hi}; bf16x2_t b = __builtin_convertvector(v, bf16x2_t); return __builtin_bit_cast(unsigned, b); }
__device__ __forceinline__ float bflo(unsigned w) { return __uint_as_float(w << 16); }
__device__ __forceinline__ float bfhi(unsigned w) { return __uint_as_float(w & 0xffff0000u); }
__device__ __forceinline__ void unpack8(const u32x4 w, float (&f)[8]) {
    f[0] = bflo(w.x); f[1] = bfhi(w.x); f[2] = bflo(w.y); f[3] = bfhi(w.y); f[4] = bflo(w.z); f[5] = bfhi(w.z); f[6] = bflo(w.w); f[7] = bfhi(w.w); }
__device__ __forceinline__ u32x4 pack8(const float (&f)[8]) { u32x4 w; w.x = pk2(f[0], f[1]); w.y = pk2(f[2], f[3]); w.z = pk2(f[4], f[5]); w.w = pk2(f[6], f[7]); return w; }
__device__ __forceinline__ float wave_sum(float v) {
#pragma unroll
    for (int o = 1; o < 64; o <<= 1) v += __shfl_xor(v, o);
    return v;
}
__device__ __forceinline__ float ex2(float x) { return __builtin_amdgcn_exp2f(x); }
__device__ __forceinline__ float lg2(float x) { return __builtin_amdgcn_logf(x); }

struct Args { const float* in[18]; float* out; unsigned char* ws; int ph_lo, ph_hi; };

__device__ __forceinline__ int win_src_block(int nb) {
    const int t = nb >> 3, j = nb & 7;
    if (t == 1 || t == 9) return (j < 4) ? nb : nb + 4;
    if (t == 2 || t == 10) return (j < 4) ? nb - 4 : nb;
    if (t == 6 || t == 7) return t * 8 + ((j < 4) ? 2 * j : 2 * (j - 4) + 1);
    return nb;
}
template <bool PERMUTE = false> __device__ __forceinline__ void p0_transpose_item(const float* W, int K, int N, bf16* WT, LAS float* scr, int item, int lane) {
    const int nblk = N / 32, kb = item / nblk, nb = item % nblk, k0 = 64 * kb, n0 = 32 * nb, ns0 = 32 * (PERMUTE ? win_src_block(nb) : nb);
#pragma unroll 8
    for (int i = 0; i < 32; ++i) { const int kk = 2 * i + (lane >> 5); scr[kk * 33 + (lane & 31)] = W[(size_t)(k0 + kk) * N + ns0 + (lane & 31)]; }
    asm volatile("s_waitcnt lgkmcnt(0)" ::: "memory");
    const int c = lane & 7;
#pragma unroll
    for (int j = 0; j < 4; ++j) { const int n = (lane >> 3) + 8 * j; const LAS float* s = scr + (8 * c) * 33 + n;
        u32x4 o; o.x = pk2(s[0 * 33], s[1 * 33]); o.y = pk2(s[2 * 33], s[3 * 33]); o.z = pk2(s[4 * 33], s[5 * 33]); o.w = pk2(s[6 * 33], s[7 * 33]);
        *(u32x4*)(WT + (size_t)(n0 + n) * K + k0 + 8 * c) = o; }
    asm volatile("s_waitcnt lgkmcnt(0)" ::: "memory");
}

__device__ __forceinline__ void p0_prologue(const Args& a, unsigned char* lds, int tid, int lane, int wave, int bx, int G) {
    {
        float* cact = (float*)lds;
        float* red = (float*)(lds + 32768);
        const float* c = a.in[1]; const float* w_ada = a.in[3]; const float* b_ada = a.in[4];
        float* mod = (float*)(a.ws + WS_MOD);
        if (bx < 192) { for (int i = tid; i < 8192; i += 512) { const float v = c[i]; cact[i] = v / (1.f + __expf(-v)); } }
        __syncthreads();
        for (int it = bx; it < 192; it += G) {
            const int l = it / 96, cgp = it % 96;
            const float* W = w_ada + (size_t)l * 1024 * 6144 + cgp * 64 + lane;
            float acc[8];
#pragma unroll
            for (int b = 0; b < 8; ++b) acc[b] = 0.f;
            for (int k0 = wave * 128; k0 < wave * 128 + 128; k0 += 32) {
                float wv[32];
#pragma unroll
                for (int i = 0; i < 32; ++i) wv[i] = W[(size_t)(k0 + i) * 6144];
#pragma unroll
                for (int i = 0; i < 32; i += 4)
#pragma unroll
                    for (int b = 0; b < 8; ++b) { const f32x4 cv = *(const f32x4*)(cact + b * 1024 + k0 + i); acc[b] += cv.x * wv[i] + cv.y * wv[i + 1] + cv.z * wv[i + 2] + cv.w * wv[i + 3]; }
            }
#pragma unroll
            for (int b = 0; b < 8; ++b) red[(wave * 8 + b) * 64 + lane] = acc[b];
            __syncthreads();
            { const int b = tid >> 6, j = tid & 63; float s = 0.f;
#pragma unroll
              for (int w = 0; w < 8; ++w) s += red[(w * 8 + b) * 64 + j];
              mod[(size_t)(l * 8 + b) * 6144 + cgp * 64 + j] = s + b_ada[l * 6144 + cgp * 64 + j]; }
            __syncthreads();
        }
        __syncthreads();
    }
    {
        LAS float* scr = (LAS float*)((LAS unsigned char*)lds + wave * 16384);
        const int gw = bx * NWAVES + wave, NGW = G * NWAVES;
        constexpr int I_IN = (DM / 64) * (INW / 32), I_OUT = (DM / 64) * (DM / 32), I_1 = (DM / 64) * (FF / 32), I_2 = (FF / 64) * (DM / 32);
        constexpr int PER_L = I_IN + I_OUT + I_1 + I_2;
        for (int it = gw; it < 2 * PER_L; it += NGW) {
            const int l = it / PER_L; int r = it % PER_L;
            if (r < I_IN) { p0_transpose_item<true>(a.in[6] + (size_t)l * DM * INW, DM, INW, (bf16*)(a.ws + WS_WIN) + (size_t)l * INW * DM, scr, r, lane); continue; } r -= I_IN;
            if (r < I_OUT) { p0_transpose_item(a.in[14] + (size_t)l * DM * DM, DM, DM, (bf16*)(a.ws + WS_WOUT) + (size_t)l * DM * DM, scr, r, lane); continue; } r -= I_OUT;
            if (r < I_1) { p0_transpose_item(a.in[16] + (size_t)l * DM * FF, DM, FF, (bf16*)(a.ws + WS_W1) + (size_t)l * FF * DM, scr, r, lane); continue; } r -= I_1;
            p0_transpose_item(a.in[17] + (size_t)l * FF * DM, FF, DM, (bf16*)(a.ws + WS_W2) + (size_t)l * DM * FF, scr, r, lane);
        }
    }
}

__device__ __forceinline__ void norm_phase0(const float* x, bf16* xn, unsigned short* r16, float* rowss, const float* g, const float* mod_l, int shift_chunk, int gw, int NGW, int lane) {
    for (int r0 = gw * 32; r0 < MTOK; r0 += NGW * 32) {
        const float* mb = mod_l + (size_t)(r0 >> 13) * 6144 + shift_chunk * 1024;
        f32x4 gs[4];
#pragma unroll
        for (int j = 0; j < 4; ++j) { const int c = 4 * lane + 256 * j; const f32x4 g4 = *(const f32x4*)(g + c), sc = *(const f32x4*)(mb + 1024 + c); gs[j] = g4 * (1.f + sc); }
#pragma unroll 2
        for (int i = 0; i < 32; ++i) {
            const float* xr = x + (size_t)(r0 + i) * DM + 4 * lane;
            f32x4 v[4]; float ss = 0.f;
#pragma unroll
            for (int j = 0; j < 4; ++j) { v[j] = *(const f32x4*)(xr + 256 * j); ss += (v[j].x * v[j].x + v[j].y * v[j].y) + (v[j].z * v[j].z + v[j].w * v[j].w); }
            const float tot = wave_sum(ss); if (lane == 0) rowss[r0 + i] = tot;
            bf16* orow = xn + (size_t)(r0 + i) * DM + 4 * lane; unsigned short* rrow = r16 + (size_t)(r0 + i) * DM + 4 * lane;
#pragma unroll
            for (int j = 0; j < 4; ++j) { const f32x4 o = v[j] * gs[j]; u32x2 w; w.x = pk2(o.x, o.y); w.y = pk2(o.z, o.w); *(u32x2*)(orow + 256 * j) = w;
                typedef _Float16 h16x4 __attribute__((ext_vector_type(4))); *(u32x2*)(rrow + 256 * j) = __builtin_bit_cast(u32x2, __builtin_convertvector(v[j], h16x4)); }
        }
    }
}

__device__ __forceinline__ void bias2_item(const bf16* WT, const float* shift  , float* outp  , int N, int n, int lane) {
    const bf16* wr = WT + (size_t)n * DM + 8 * lane;
    float w[16]; { float t[8]; unpack8(*(const u32x4*)wr, t);
#pragma unroll
        for (int e = 0; e < 8; ++e) w[e] = t[e];
        unpack8(*(const u32x4*)(wr + 512), t);
#pragma unroll
        for (int e = 0; e < 8; ++e) w[8 + e] = t[e]; }
#pragma unroll
    for (int b = 0; b < 8; ++b) { const float* sp = shift + (size_t)b * 6144 + 8 * lane;
        const f32x4 s0 = *(const f32x4*)sp, s1 = *(const f32x4*)(sp + 4), s2 = *(const f32x4*)(sp + 512), s3 = *(const f32x4*)(sp + 516);
        float acc = (s0.x * w[0] + s0.y * w[1]) + (s0.z * w[2] + s0.w * w[3]) + (s1.x * w[4] + s1.y * w[5]) + (s1.z * w[6] + s1.w * w[7])
                  + (s2.x * w[8] + s2.y * w[9]) + (s2.z * w[10] + s2.w * w[11]) + (s3.x * w[12] + s3.y * w[13]) + (s3.z * w[14] + s3.w * w[15]);
        acc = wave_sum(acc);
        if (lane == 0) outp[(size_t)b * N + n] = acc; }
}

__device__ __forceinline__ void sc_item(const bf16* __restrict__ proj, bf16* __restrict__ Y, const float* __restrict__ wsc, int item, int tid) {
    const int cgp = tid & 31, ts = tid >> 5;
    float w[3][8];
#pragma unroll
    for (int k = 0; k < 3; ++k)
#pragma unroll
        for (int e = 0; e < 8; ++e) w[k][e] = wsc[k * 256 + cgp * 8 + e];
    const int r0 = item * 64;
#pragma unroll
    for (int p = 0; p < 4; ++p) {
        const int row = r0 + p * 16 + ts, t = row & (SEQ - 1);
        const bf16* pr = proj + (size_t)row * INW + cgp * 8;
        const u32x4 Bv = *(const u32x4*)pr;
        float acc[8];
#pragma unroll
        for (int e = 0; e < 8; ++e) acc[e] = 0.f;
#pragma unroll
        for (int k = 0; k < 3; ++k) { const int dt = 2 - k;
            if (t - dt >= 0) { const bf16* q = pr - (size_t)dt * INW; float ch[8]; unpack8(*(const u32x4*)(q + 256), ch);
#pragma unroll
                for (int e = 0; e < 8; ++e) acc[e] += w[k][e] * ch[e]; } }
        float bb[8]; unpack8(Bv, bb);
#pragma unroll
        for (int e = 0; e < 8; ++e) bb[e] *= acc[e];
        *(u32x4*)(Y + (size_t)row * DM + cgp * 8) = pack8(bb);
    }
}

__device__ __forceinline__ void cf_load(u32x4 (&av)[4], u32x4 (&gv)[4], const bf16* __restrict__ proj, int item, int tid) {
    const int r0 = item * 32, t0 = r0 & (SEQ - 1);
#pragma unroll
    for (int r = 0; r < 4; ++r) { const int idx = tid + 512 * r, rr = idx >> 5, cgp = idx & 31; av[r] = (u32x4){0u, 0u, 0u, 0u}; gv[r] = (u32x4){0u, 0u, 0u, 0u};
        if (idx < 62 * 32 && t0 - 30 + rr >= 0) { const bf16* p = proj + (size_t)(r0 - 30 + rr) * INW + 2304 + cgp * 8; av[r] = *(const u32x4*)p; } }
}
__device__ __forceinline__ void cf_phase(const bf16* __restrict__ proj, bf16* __restrict__ Y, const float* __restrict__ wcc, const float* __restrict__ bcc, const float* __restrict__ gcl, const float* __restrict__ bcl, unsigned char* lds, int bx, int G, int tid, int lane, int wave) {
    float* U = (float*)lds;
    float* CO = (float*)(lds + 62 * 256 * 4);
    const int nitems = MTOK / 32;
    if (bx >= nitems) return;
    u32x4 av[4], gv[4];
    cf_load(av, gv, proj, bx, tid);
    for (int item = bx; item < nitems; item += G) {
        const int r0 = item * 32;
#pragma unroll
        for (int r = 0; r < 4; ++r) { const int idx = tid + 512 * r, rr = idx >> 5, cgp = idx & 31;
            if (idx < 62 * 32) { float u[8]; unpack8(av[r], u);
                *(f32x4*)(U + rr * 256 + cgp * 8) = (f32x4){u[0], u[1], u[2], u[3]}; *(f32x4*)(U + rr * 256 + cgp * 8 + 4) = (f32x4){u[4], u[5], u[6], u[7]}; } }
        __syncthreads();
        if (item + G < nitems) cf_load(av, gv, proj, item + G, tid);
        {
            const int ch = tid & 255, half = tid >> 8;
            float w[31];
#pragma unroll
            for (int k = 0; k < 31; ++k) w[k] = wcc[k * 256 + ch];
            float uu[46];
#pragma unroll
            for (int i = 0; i < 46; ++i) uu[i] = U[(half * 16 + i) * 256 + ch];
            const float bias = bcc[ch];
#pragma unroll
            for (int tt = 0; tt < 16; ++tt) { float acc = bias;
#pragma unroll
                for (int k = 0; k < 31; ++k) acc += w[k] * uu[tt + k];
                CO[(half * 16 + tt) * 256 + ch] = acc; }
        }
        __syncthreads();
        {
            const f32x4 g4 = *(const f32x4*)(gcl + lane * 4), b4 = *(const f32x4*)(bcl + lane * 4);
#pragma unroll
            for (int i = 0; i < 4; ++i) { const int tl = wave * 4 + i;
                const f32x4 v = *(const f32x4*)(CO + tl * 256 + lane * 4);
                const float mean = wave_sum((v.x + v.y) + (v.z + v.w)) * (1.f / 256.f);
                const f32x4 d = v - mean;
                const float var = wave_sum((d.x * d.x + d.y * d.y) + (d.z * d.z + d.w * d.w)) * (1.f / 256.f);
                const float rstd = rsqrtf(var + 1e-6f);
                f32x4 y = d * rstd * g4 + b4;
                y.x = y.x / (1.f + __expf(-y.x)); y.y = y.y / (1.f + __expf(-y.y)); y.z = y.z / (1.f + __expf(-y.z)); y.w = y.w / (1.f + __expf(-y.w));
                u32x2 w2; w2.x = pk2(y.x, y.y); w2.y = pk2(y.z, y.w);
                *(u32x2*)(Y + (size_t)(r0 + tl) * DM + 768 + lane * 4) = w2; }
        }
        __syncthreads();
    }
}

constexpr float C2 = 0.125f * 1.4426950408889634f;
__device__ __forceinline__ void prep_item(const bf16* __restrict__ proj, bf16* __restrict__ qk2, const int* __restrict__ positions, const float* gq, const float* gk, float* kmean, unsigned char* lds, int item, int tid) {
    f32x2* cs = (f32x2*)lds;
    float* kacc = (float*)(lds + 4096);
    const int b = item >> 5, n = item & 31;
    const int g = tid >> 3, j = tid & 7, tk = g >> 2, h = g & 3;
    if (tid < 256) kacc[tid] = 0.f;
    float gqv[8], gkv[8], ksum[8];
#pragma unroll
    for (int e = 0; e < 8; ++e) { gqv[e] = gq[8 * j + e]; gkv[e] = gk[8 * j + e]; ksum[e] = 0.f; }
    const int f_t = tid & 31, tk_t = tid >> 5;
    const float inv_freq = expf((-9.210340371976184f * (float)f_t) / 32.0f);
    for (int p = 0; p < 16; ++p) {
        const int rowb = b * SEQ + n * 256 + p * 16;
        { const int pos = positions[rowb + tk_t]; const float ang = (float)pos * inv_freq;
          double rev = (double)ang * 0.15915494309189535; rev -= floor(rev); const float rf = (float)rev;
          cs[tk_t * 32 + f_t] = (f32x2){__builtin_amdgcn_cosf(rf), __builtin_amdgcn_sinf(rf)}; }
        __syncthreads();
#pragma unroll
        for (int which = 0; which < 2; ++which) {
            const bf16* ptr = proj + (size_t)(rowb + tk) * INW + (which ? 1792 : 1536) + h * 64 + j * 8;
            bf16* optr = qk2 + (size_t)(rowb + tk) * QKP + which * 256 + h * 64 + j * 8;
            float v[8]; unpack8(*(const u32x4*)ptr, v);
            float ss = 0.f;
#pragma unroll
            for (int e = 0; e < 8; ++e) ss += v[e] * v[e];
            ss += __shfl_xor(ss, 1); ss += __shfl_xor(ss, 2); ss += __shfl_xor(ss, 4);
            const float rstd = rsqrtf(ss * (1.f / 64.f) + 1e-6f);
            float o[8];
#pragma unroll
            for (int e = 0; e < 8; ++e) { const float y = v[e] * rstd * (which ? gkv[e] : gqv[e]); const float pt = __shfl_xor(y, 4); const f32x2 c = cs[tk * 32 + ((8 * j + e) & 31)];
                o[e] = (j < 4) ? (y * c.x - pt * c.y) : (y * c.x + pt * c.y); }
            if (which == 0) {
#pragma unroll
                for (int e = 0; e < 8; ++e) o[e] *= C2;
            } else {
#pragma unroll
                for (int e = 0; e < 8; ++e) ksum[e] += o[e];
            }
            *(u32x4*)optr = pack8(o);
        }
        __syncthreads();
    }
#pragma unroll
    for (int e = 0; e < 8; ++e) atomicAdd(&kacc[h * 64 + 8 * j + e], ksum[e]);
    __syncthreads();
    if (tid < 256) kmean[((size_t)(b * 4 + (tid >> 6)) * 32 + n) * 64 + (tid & 63)] = kacc[tid] * (1.f / 256.f);
    __syncthreads();
}

__device__ __forceinline__ void kmean_item(const bf16* __restrict__ qk2, float* __restrict__ kmean, unsigned char* lds, int item, int tid) {
    float* kacc = (float*)lds;
    const int b = item >> 5, n = item & 31, cg = tid & 31, rg = tid >> 5;
    if (tid < 256) kacc[tid] = 0.f;
    __syncthreads();
    float sm[8];
#pragma unroll
    for (int e = 0; e < 8; ++e) sm[e] = 0.f;
    const bf16* p = qk2 + (size_t)(b * SEQ + n * 256 + rg) * QKP + 256 + cg * 8;
#pragma unroll 8
    for (int i = 0; i < 16; ++i) { float v[8]; unpack8(*(const u32x4*)(p + (size_t)i * 16 * QKP), v);
#pragma unroll
        for (int e = 0; e < 8; ++e) sm[e] += v[e]; }
#pragma unroll
    for (int e = 0; e < 8; ++e) atomicAdd(&kacc[cg * 8 + e], sm[e]);
    __syncthreads();
    if (tid < 256) kmean[((size_t)(b * 4 + (tid >> 6)) * 32 + n) * 64 + (tid & 63)] = kacc[tid] * (1.f / 256.f);
    __syncthreads();
}

#define MFMA32(a, b, c) __builtin_amdgcn_mfma_f32_32x32x16_bf16((a), (b), (c), 0, 0, 0)
__device__ __forceinline__ int kperm(int rho) { return (rho & 19) | ((rho & 4) << 1) | ((rho & 8) >> 1); }
__device__ __forceinline__ constexpr int kidx(int r, int hi) { return (r & 7) + 8 * hi + 16 * (r >> 3); }
__device__ __forceinline__ constexpr int crow(int r, int hi) { return (r & 3) + 8 * (r >> 2) + 4 * hi; }
constexpr float NEG = -1e30f;

template <int PITCH = INW> __device__ __forceinline__ void load_k(bf16x8 (&kf)[4], const bf16* Kb, int key0, int lane) {
    const bf16* p = Kb + (size_t)(key0 + kperm(lane & 31)) * PITCH + (lane >> 5) * 8;
#pragma unroll
    for (int kk = 0; kk < 4; ++kk) kf[kk] = *(const bf16x8*)(p + 16 * kk);
}
__device__ __forceinline__ void load_v(bf16x8 (&vf)[4], const bf16* VTb, int key0, int lane) {
    const bf16* p = VTb + (size_t)(lane & 31) * SEQ + key0 + 8 * (lane >> 5);
    vf[0] = *(const bf16x8*)p; vf[1] = *(const bf16x8*)(p + 16); vf[2] = *(const bf16x8*)(p + 32 * SEQ); vf[3] = *(const bf16x8*)(p + 32 * SEQ + 16);
}
template <int PITCH = INW> __device__ __forceinline__ void load_q(bf16x8 (&qf)[4], const bf16* Qrow0, int lane) {
    const bf16* p = Qrow0 + (size_t)(lane & 31) * PITCH + 8 * (lane >> 5);
#pragma unroll
    for (int kk = 0; kk < 4; ++kk) qf[kk] = *(const bf16x8*)(p + 16 * kk);
}
__device__ __forceinline__ void pv_acc(f32x16 (&o)[2], const bf16x8 (&vf)[4], const float (&a)[16]) {
    u32x4 w0, w1;
    w0.x = pk2(a[0], a[1]); w0.y = pk2(a[2], a[3]); w0.z = pk2(a[4], a[5]); w0.w = pk2(a[6], a[7]);
    w1.x = pk2(a[8], a[9]); w1.y = pk2(a[10], a[11]); w1.z = pk2(a[12], a[13]); w1.w = pk2(a[14], a[15]);
    const bf16x8 p0 = __builtin_bit_cast(bf16x8, w0), p1 = __builtin_bit_cast(bf16x8, w1);
    o[0] = MFMA32(vf[0], p0, o[0]); o[0] = MFMA32(vf[1], p1, o[0]);
    o[1] = MFMA32(vf[2], p0, o[1]); o[1] = MFMA32(vf[3], p1, o[1]);
}
__device__ __forceinline__ void store_o_p(bf16* p, const f32x16 (&o)[2], float sc) {
#pragma unroll
    for (int dh = 0; dh < 2; ++dh)
#pragma unroll
        for (int g4 = 0; g4 < 4; ++g4) { u32x2 w; w.x = pk2(o[dh][4 * g4] * sc, o[dh][4 * g4 + 1] * sc); w.y = pk2(o[dh][4 * g4 + 2] * sc, o[dh][4 * g4 + 3] * sc); *(u32x2*)(p + dh * 32 + 8 * g4) = w; }
}
__device__ __forceinline__ void store_o(bf16* Yb, const f32x16 (&o)[2], float sc, int lane) { store_o_p(Yb + (size_t)(lane & 31) * DM + 4 * (lane >> 5), o, sc); }

constexpr float SBSC = 0.125f * 1.4426950408889634f, SBTH = -160.f;
template <bool DIAG> __device__ __forceinline__ void sb_qt(const bf16x8 (&kf)[4], const bf16x8 (&vf)[4], const bf16x8 (&qf)[4], f32x16 (&o)[2], float& carry, int ql, int hi) {
    f32x16 s = {};
#pragma unroll
    for (int kk = 0; kk < 4; ++kk) s = MFMA32(kf[kk], qf[kk], s);
    float L[16], zl[16];
    float lo = 0.f, up = 0.f;
#pragma unroll
    for (int r = 0; r < 16; ++r) { const float z = s[r] * SBSC; const float e = ex2(-fabsf(z)); const float sp = fmaxf(z, 0.f) + lg2(1.f + e);
        const bool valid = !DIAG || (kidx(r, hi) < ql);
        L[r] = valid ? -sp : 0.f; zl[r] = valid ? (z - sp) : -INFINITY;
        if (r < 8) lo += L[r]; else up += L[r]; }
    const float plo = __shfl_xor(lo, 32), pup = __shfl_xor(up, 32);
    const float offU = hi ? carry : carry + pup;
    const float offL = hi ? (carry + up + pup) : (carry + pup + up + plo);
    carry += (lo + plo) + (up + pup);
    float a[16];
    float run = offU;
#pragma unroll
    for (int r = 15; r >= 8; --r) { a[r] = ex2(zl[r] + run); run += L[r]; }
    run = offL;
#pragma unroll
    for (int r = 7; r >= 0; --r) { a[r] = ex2(zl[r] + run); run += L[r]; }
    pv_acc(o, vf, a);
}
__device__ __forceinline__ void sb_item(const bf16* proj, const bf16* vt, bf16* Y, int bh, int qt, int lane) {
    const int b = bh >> 2, h = bh & 3, hi = lane >> 5, ql = lane & 31, q0r = qt * 32;
    const bf16* Qb = proj + (size_t)b * SEQ * INW + 768 + h * 64;
    const bf16* Kb = proj + (size_t)b * SEQ * INW + 1024 + h * 64;
    const bf16* VTb = vt + (size_t)bh * 64 * SEQ;
    bf16x8 q[4]; load_q(q, Qb + (size_t)q0r * INW, lane);
    f32x16 o[2] = {}; float c = 0.f;
    bf16x8 kf[4], vf[4], kg[4], vg[4];
    load_k(kf, Kb, q0r, lane); load_v(vf, VTb, q0r, lane);
    if (q0r >= 32) { load_k(kg, Kb, q0r - 32, lane); load_v(vg, VTb, q0r - 32, lane); }
    sb_qt<true>(kf, vf, q, o, c, ql, hi);
    for (int key0 = q0r - 32; key0 >= 0; key0 -= 64) {
        if (__all(c < SBTH)) break;
        if (key0 >= 32) { load_k(kf, Kb, key0 - 32, lane); load_v(vf, VTb, key0 - 32, lane); }
        sb_qt<false>(kg, vg, q, o, c, ql, hi);
        if (key0 < 32 || __all(c < SBTH)) break;
        if (key0 >= 64) { load_k(kg, Kb, key0 - 64, lane); load_v(vg, VTb, key0 - 64, lane); }
        sb_qt<false>(kf, vf, q, o, c, ql, hi);
    }
    store_o(Y + (size_t)(b * SEQ + q0r) * DM + 256 + h * 64, o, 1.f, lane);
}

template <int MODE  > __device__ __forceinline__ void mb_qt(const bf16x8 (&kf)[4], const bf16x8 (&vf)[4], const bf16x8 (&qf)[4], f32x16 (&o)[2], float& mref, float& lsum, bool sel, int ql, int hi) {
    f32x16 s = {};
#pragma unroll
    for (int kk = 0; kk < 4; ++kk) s = MFMA32(kf[kk], qf[kk], s);
    if (MODE == 2) {
#pragma unroll
        for (int r = 0; r < 16; ++r) if (kidx(r, hi) > ql) s[r] = NEG;
    }
    float tm = s[0];
#pragma unroll
    for (int r = 1; r < 16; ++r) tm = fmaxf(tm, s[r]);
    tm = fmaxf(tm, __shfl_xor(tm, 32));
    tm = sel ? tm : NEG;
    if (__any(tm > mref + 16.f)) { const float mn = fmaxf(mref, tm), al = ex2(mref - mn); lsum *= al; o[0] *= al; o[1] *= al; mref = mn; }
    const float me = sel ? mref : INFINITY;
    float p[16];
#pragma unroll
    for (int r = 0; r < 16; ++r) { p[r] = ex2(s[r] - me); lsum += p[r]; }
    pv_acc(o, vf, p);
}
__device__ __forceinline__ unsigned topk_mask(const float* km, const bf16x8 (&qf)[4], int own, int lane) {
    const int hi = lane >> 5;
    f32x16 g = {};
#pragma unroll
    for (int kk = 0; kk < 4; ++kk) { const float* kp = km + (lane & 31) * 64 + 16 * kk + 8 * hi; const f32x4 x0 = *(const f32x4*)kp, x1 = *(const f32x4*)(kp + 4);
        u32x4 wh; wh.x = pk2(x0.x, x0.y); wh.y = pk2(x0.z, x0.w); wh.z = pk2(x1.x, x1.y); wh.w = pk2(x1.z, x1.w);
        u32x4 wl; wl.x = pk2(x0.x - bflo(wh.x), x0.y - bfhi(wh.x)); wl.y = pk2(x0.z - bflo(wh.y), x0.w - bfhi(wh.y)); wl.z = pk2(x1.x - bflo(wh.z), x1.y - bfhi(wh.z)); wl.w = pk2(x1.z - bflo(wh.w), x1.w - bfhi(wh.w));
        g = MFMA32(__builtin_bit_cast(bf16x8, wh), qf[kk], g); g = MFMA32(__builtin_bit_cast(bf16x8, wl), qf[kk], g); }
    float gv[16];
#pragma unroll
    for (int r = 0; r < 16; ++r) gv[r] = (crow(r, hi) < own) ? g[r] : NEG;
    unsigned mask = 0u;
#pragma unroll
    for (int round = 0; round < 3; ++round) {
        float bm = gv[0]; int bi = crow(0, hi);
#pragma unroll
        for (int r = 1; r < 16; ++r) if (gv[r] > bm) { bm = gv[r]; bi = crow(r, hi); }
        const float pm = __shfl_xor(bm, 32); const int pi = __shfl_xor(bi, 32);
        const bool takep = (pm > bm) || (pm == bm && pi < bi);
        const float cm = takep ? pm : bm; const int ci = takep ? pi : bi;
        if (cm > -1e29f) mask |= 1u << ci;
#pragma unroll
        for (int r = 0; r < 16; ++r) if (crow(r, hi) == ci) gv[r] = NEG;
    }
    return mask;
}
__device__ __forceinline__ void moba_select(const bf16* proj, const float* kmean, unsigned* QM, unsigned long long* SQ, int bh, int chunk, int lane) {
    const int b = bh >> 2, h = bh & 3, qstart = chunk * 64, own = chunk >> 2;
    const bf16* Qb = proj + (size_t)b * SEQ * QKP + h * 64;
    unsigned m0 = 0u, m1 = 0u;
    if (own > 0) { bf16x8 q0[4], q1[4]; load_q<QKP>(q0, Qb + (size_t)qstart * QKP, lane); load_q<QKP>(q1, Qb + (size_t)(qstart + 32) * QKP, lane);
        m0 = topk_mask(kmean + (size_t)bh * 32 * 64, q0, own, lane); m1 = topk_mask(kmean + (size_t)bh * 32 * 64, q1, own, lane); }
    if (lane < 32) { QM[(size_t)bh * SEQ + qstart + lane] = m0; QM[(size_t)bh * SEQ + qstart + 32 + lane] = m1; }
    unsigned long long mine = 0ull;
#pragma unroll
    for (int n = 0; n < 32; ++n) { const unsigned long long b0 = __ballot((m0 >> n) & 1u) & 0xffffffffull, b1 = __ballot((m1 >> n) & 1u) & 0xffffffffull; const unsigned long long v = b0 | (b1 << 32); if (lane == n) mine = v; }
    if (lane < 32) SQ[((size_t)bh * 128 + chunk) * 32 + lane] = mine;
}
__device__ __forceinline__ int select_nth(unsigned long long m, int r) {
    int pos = 0; unsigned w = (unsigned)m; int c = __popc(w);
    if (r >= c) { r -= c; w = (unsigned)(m >> 32); pos = 32; }
    c = __popc(w & 0xffffu); if (r >= c) { r -= c; w >>= 16; pos += 16; }
    c = __popc(w & 0xffu); if (r >= c) { r -= c; w >>= 8; pos += 8; }
    c = __popc(w & 0xfu); if (r >= c) { r -= c; w >>= 4; pos += 4; }
    c = __popc(w & 3u); if (r >= c) { r -= c; w >>= 2; pos += 2; }
    if (r >= (int)(w & 1u)) pos += 1;
    return pos;
}
__device__ __forceinline__ void moba_past(const bf16* proj, const bf16* vt, const unsigned* QM, const unsigned long long* SQ, bf16* POUT, f32x2* PML, int bh, int w, int lane) {
    const int b = bh >> 2, h = bh & 3, hi = lane >> 5, ql = lane & 31;
    const bf16* Qb = proj + (size_t)b * SEQ * QKP + h * 64;
    const bf16* Kb = proj + (size_t)b * SEQ * QKP + 256 + h * 64;
    const bf16* VTb = vt + (size_t)bh * 64 * SEQ;
    const unsigned long long* sq = SQ + (size_t)bh * 128 * 32;
    int gbase = 0;
    const int c0 = 2 * lane;
    unsigned long long nm0 = (c0 >= 4) ? sq[c0 * 32] : 0ull, nm1 = (c0 + 1 >= 4) ? sq[(c0 + 1) * 32] : 0ull;
    for (int n = 0; n < 31; ++n) {
        const unsigned long long m0 = nm0, m1 = nm1;
        if (n + 1 < 31) { nm0 = (c0 >= 4 * (n + 2)) ? sq[c0 * 32 + n + 1] : 0ull; nm1 = (c0 + 1 >= 4 * (n + 2)) ? sq[(c0 + 1) * 32 + n + 1] : 0ull; }
        const int cA = __popcll(m0), tot = cA + __popcll(m1);
        int incl = tot;
#pragma unroll
        for (int o = 1; o < 64; o <<= 1) { const int t = __shfl_up(incl, o); if (lane >= o) incl += t; }
        const int ex = incl - tot, T = __builtin_amdgcn_readlane(incl, 63);
        const int ntile = (T + 31) >> 5;
        for (int k = (w - gbase) & 63; k < ntile; k += 64) {
            bf16x8 kf[4], vf[4], kg[4], vg[4];
            load_k<QKP>(kf, Kb, n * 256, lane); load_v(vf, VTb, n * 256, lane);
            const int p = 32 * k + ql;
            unsigned long long cand = __ballot(tot > 0 && ex < 32 * k + 32 && ex + tot > 32 * k);
            int qidx = (n + 1) * 256;
            while (cand) {
                const int j = __ffsll((long long)cand) - 1; cand &= cand - 1ull;
                const int exj = __builtin_amdgcn_readlane(ex, j), totj = __builtin_amdgcn_readlane(tot, j), cAj = __builtin_amdgcn_readlane(cA, j);
                const unsigned m0lo = __builtin_amdgcn_readlane((unsigned)m0, j), m0hi = __builtin_amdgcn_readlane((unsigned)(m0 >> 32), j);
                const unsigned m1lo = __builtin_amdgcn_readlane((unsigned)m1, j), m1hi = __builtin_amdgcn_readlane((unsigned)(m1 >> 32), j);
                if (p >= exj && p < exj + totj) { int r = p - exj; unsigned long long mm = ((unsigned long long)m0hi << 32) | m0lo; int ch = 2 * j;
                    if (r >= cAj) { r -= cAj; mm = ((unsigned long long)m1hi << 32) | m1lo; ch += 1; }
                    qidx = ch * 64 + select_nth(mm, r); }
            }
            const bool valid = p < T;
            const unsigned qm = QM[(size_t)bh * SEQ + qidx];
            bf16x8 q[4];
            { const bf16* qp = Qb + (size_t)qidx * QKP + 8 * hi;
#pragma unroll
              for (int kk = 0; kk < 4; ++kk) q[kk] = *(const bf16x8*)(qp + 16 * kk); }
            f32x16 o[2] = {}; float mref = NEG, lsum = 0.f;
            for (int t = 0; t < 8; t += 2) {
                load_k<QKP>(kg, Kb, n * 256 + 32 * (t + 1), lane); load_v(vg, VTb, n * 256 + 32 * (t + 1), lane);
                mb_qt<1>(kf, vf, q, o, mref, lsum, true, ql, hi);
                if (t + 2 < 8) { load_k<QKP>(kf, Kb, n * 256 + 32 * (t + 2), lane); load_v(vf, VTb, n * 256 + 32 * (t + 2), lane); }
                mb_qt<1>(kg, vg, q, o, mref, lsum, true, ql, hi);
            }
            lsum += __shfl_xor(lsum, 32);
            if (valid) { const int slot = __popc(qm & ((1u << n) - 1u));
                const size_t pi = ((size_t)bh * SEQ + qidx) * 3 + slot;
                store_o_p(POUT + pi * 64 + 4 * hi, o, 1.f / lsum);
                if (hi == 0) PML[pi] = (f32x2){mref, lsum}; }
        }
        gbase += ntile;
    }
}
__device__ __forceinline__ void moba_own(const bf16* proj, const bf16* vt, const bf16* POUT, const f32x2* PML, bf16* Y, int bh, int qt, int lane) {
    const int b = bh >> 2, h = bh & 3, hi = lane >> 5, ql = lane & 31, q0r = qt * 32, own = qt >> 3;
    const bf16* Qb = proj + (size_t)b * SEQ * QKP + h * 64;
    const bf16* Kb = proj + (size_t)b * SEQ * QKP + 256 + h * 64;
    const bf16* VTb = vt + (size_t)bh * 64 * SEQ;
    bf16x8 q[4]; load_q<QKP>(q, Qb + (size_t)q0r * QKP, lane);
    f32x16 o[2] = {}; float mref = NEG, lsum = 0.f;
    bf16x8 kf[4], vf[4], kg[4], vg[4];
    load_k<QKP>(kf, Kb, q0r, lane); load_v(vf, VTb, q0r, lane);
    const int kb0 = own * 256;
    if (kb0 < q0r) { load_k<QKP>(kg, Kb, kb0, lane); load_v(vg, VTb, kb0, lane); }
    mb_qt<2>(kf, vf, q, o, mref, lsum, true, ql, hi);
    for (int key0 = kb0; key0 < q0r; key0 += 64) {
        if (key0 + 32 < q0r) { load_k<QKP>(kf, Kb, key0 + 32, lane); load_v(vf, VTb, key0 + 32, lane); }
        mb_qt<1>(kg, vg, q, o, mref, lsum, true, ql, hi);
        if (key0 + 32 >= q0r) break;
        if (key0 + 64 < q0r) { load_k<QKP>(kg, Kb, key0 + 64, lane); load_v(vg, VTb, key0 + 64, lane); }
        mb_qt<1>(kf, vf, q, o, mref, lsum, true, ql, hi);
    }
    lsum += __shfl_xor(lsum, 32);
    const int ns = own < 3 ? own : 3;
    const size_t pi = ((size_t)bh * SEQ + q0r + ql) * 3;
    f32x2 ml[3]; float M = mref;
#pragma unroll
    for (int s = 0; s < 3; ++s) { ml[s] = (f32x2){NEG, 0.f}; if (s < ns) { ml[s] = PML[pi + s]; M = fmaxf(M, ml[s].x); } }
    const float wown = ex2(mref - M); float den = lsum * wown;
    o[0] *= wown; o[1] *= wown;
#pragma unroll
    for (int s = 0; s < 3; ++s) if (s < ns) { const float wsl = ml[s].y * ex2(ml[s].x - M); den += wsl; const bf16* ps = POUT + (pi + s) * 64 + 4 * hi;
#pragma unroll
        for (int dh = 0; dh < 2; ++dh)
#pragma unroll
            for (int g4 = 0; g4 < 4; ++g4) { const u32x2 v = *(const u32x2*)(ps + dh * 32 + 8 * g4);
                o[dh][4 * g4] += wsl * bflo(v.x); o[dh][4 * g4 + 1] += wsl * bfhi(v.x); o[dh][4 * g4 + 2] += wsl * bflo(v.y); o[dh][4 * g4 + 3] += wsl * bfhi(v.y); } }
    store_o(Y + (size_t)(b * SEQ + q0r) * DM + 512 + h * 64, o, 1.f / den, lane);
}

#define XB_TMO      128
#define XB_XCNT(j)  (256  + 64 * (j))
#define XB_XSUB(j)  (1280 + 64 * (j))
#define XB_XGEN(j)  (2304 + 64 * (j))
#define XB_TOP      3328
#define XB_TOPGEN   3392
#define XCD_BAR_WORDS 3456
#define XB_SPIN_CAP (1u << 18)

__device__ __forceinline__ unsigned xb_ld(unsigned* p)              { return __hip_atomic_load(p, __ATOMIC_RELAXED, __HIP_MEMORY_SCOPE_AGENT); }
__device__ __forceinline__ unsigned xb_add(unsigned* p, unsigned v) { return __hip_atomic_fetch_add(p, v, __ATOMIC_RELAXED, __HIP_MEMORY_SCOPE_AGENT); }
__device__ __forceinline__ unsigned xb_xcc_id() { return (unsigned)__builtin_amdgcn_s_getreg((3 << 11) | 20) & 0xFu; }
#define XB_SPIN(cond, bar) do { unsigned _sp = 0; while (cond) { __builtin_amdgcn_s_sleep(1); \
    if ((++_sp & 255u) == 0u) { if (xb_ld(&(bar)[XB_TMO])) break; if (_sp > XB_SPIN_CAP) { atomicAdd(&(bar)[XB_TMO], 1u); break; } } } } while (0)

struct XcdBarrier {
    unsigned* bar; unsigned x;
    volatile LAS unsigned* st;
};

__device__ __forceinline__ XcdBarrier xcd_barrier_post(unsigned* bar, volatile LAS unsigned* st, bool t0) {
    XcdBarrier b; b.bar = bar; b.x = xb_xcc_id(); b.st = st;
    if (t0) (void)xb_add(&bar[XB_XCNT(b.x)], 1u);
    return b;
}
__device__ __forceinline__ void xcd_barrier_complete(unsigned* bar, unsigned x, unsigned& nloc, unsigned& nx) {
    const unsigned G = gridDim.x * gridDim.y * gridDim.z;
    unsigned sum, cnt, mine, sp = 0u;
    for (;;) {
        sum = 0u; cnt = 0u; mine = 0u;
#pragma unroll
        for (unsigned j = 0; j < 16; ++j) { const unsigned c = xb_ld(&bar[XB_XCNT(j)]); sum += c; cnt += (c > 0u) ? 1u : 0u; mine = (j == x) ? c : mine; }
        if (sum == G) break;
        __builtin_amdgcn_s_sleep(1);
        if ((++sp & 255u) == 0u) { if (xb_ld(&bar[XB_TMO])) break; if (sp > XB_SPIN_CAP) { atomicAdd(&bar[XB_TMO], 1u); break; } }
    }
    nloc = mine > 0u ? mine : 1u; nx = cnt > 0u ? cnt : 1u;
}

__device__ __forceinline__ void xcd_barrier(const XcdBarrier& b, bool t0) {
    asm volatile("s_waitcnt vmcnt(0)" ::: "memory");
    __syncthreads();
    if (t0) {
        unsigned* bar = b.bar; unsigned bx_ = __builtin_amdgcn_readfirstlane(b.x); asm volatile("" : "+s"(bx_));
        __builtin_amdgcn_s_waitcnt(0);
        unsigned nloc = b.st[0], nx = b.st[1];
        if (nloc == 0u) { xcd_barrier_complete(bar, bx_, nloc, nx); b.st[0] = nloc; b.st[1] = nx; }
        const unsigned old = xb_add(&bar[XB_XSUB(bx_)], 1u);
        const unsigned gen = old / nloc;
        if (old + 1u == (gen + 1u) * nloc) {
            __builtin_amdgcn_fence(__ATOMIC_RELEASE, "agent");
            asm volatile("s_waitcnt vmcnt(0)" ::: "memory");
            const unsigned og = xb_add(&bar[XB_TOP], 1u);
            const unsigned tg = og / nx;
            if (og + 1u == (tg + 1u) * nx) xb_add(&bar[XB_TOPGEN], 1u);
            else XB_SPIN(xb_ld(&bar[XB_TOPGEN]) == tg, bar);
            __builtin_amdgcn_fence(__ATOMIC_ACQUIRE, "agent");
            xb_add(&bar[XB_XGEN(bx_)], 1u);
            asm volatile("s_waitcnt vmcnt(0)" ::: "memory");
        } else {
            XB_SPIN(xb_ld(&bar[XB_XGEN(bx_)]) == gen, bar);
            __builtin_amdgcn_fence(__ATOMIC_ACQUIRE, "agent");
            asm volatile("s_waitcnt vmcnt(0)" ::: "memory");
        }
    }
    __syncthreads();
}
#ifndef STG_B
#define STG_B 8
#endif
#ifndef STG_G
#define STG_G 6
#endif
#ifndef MK_PER_PHASE
#define MK_PER_PHASE 0
#endif
__global__ void __launch_bounds__(NWAVES * 64, 2) hybrid_fwd(Args a) {
    extern __shared__ __attribute__((aligned(16))) unsigned char lds[];
    cg::grid_group grid = cg::this_grid();
    const int G0 = gridDim.x, bx0 = blockIdx.x;
    volatile LAS unsigned* MISC = (volatile LAS unsigned*)((LAS unsigned char*)lds + 131072);
    if (threadIdx.x < 32) MISC[threadIdx.x] = 0u;
    __syncthreads();
    const int wave0 = __builtin_amdgcn_readfirstlane((int)threadIdx.x >> 6);
#define PHASE_IDS int lane; asm volatile("v_mbcnt_lo_u32_b32 %0, -1, 0\n\tv_mbcnt_hi_u32_b32 %0, -1, %0" : "=v"(lane));     int bx = bx0, G = G0; asm volatile("" : "+s"(bx), "+s"(G));   \
    const int wave = wave0; const int tid = wave * 64 + lane; const int gw = bx * NWAVES + wave, NGW = G * NWAVES; const int vcu = (G % 8 == 0) ? (bx % 8) * (G / 8) + bx / 8 : bx; (void)tid; (void)gw; (void)NGW; (void)vcu;
    XcdBarrier bar = xcd_barrier_post((unsigned*)(a.ws + WS_CTL), MISC + 8, threadIdx.x == 0);
#define STAGGER(us) do { const int cohort_ = ((bx >> 3) & 7) >> 1; if (cohort_) { const unsigned long long t0_ = __builtin_amdgcn_s_memrealtime(); const unsigned long long d_ = (unsigned long long)(cohort_ * (us) * 100); \
        while (__builtin_amdgcn_s_memrealtime() - t0_ < d_) __builtin_amdgcn_s_sleep(16); } } while (0)
    unsigned char* ws = a.ws;
    float* mod = (float*)(ws + WS_MOD);
    float* kmean = (float*)(ws + WS_KMEAN);
    bf16* XN = (bf16*)(ws + WS_XN); bf16* Yb = (bf16*)(ws + WS_Y); bf16* PROJ = (bf16*)(ws + WS_PROJ); bf16* HB = (bf16*)(ws + WS_PROJ);
    bf16* VTSB = (bf16*)(ws + WS_VTSB); bf16* VTMB = (bf16*)(ws + WS_VTMB);
    bf16* QK2 = (bf16*)(ws + WS_QK2);
    float* ROWSS = (float*)(ws + WS_ROWSS); float* BIAS2 = (float*)(ws + WS_BIAS2);
    bf16* POUT = (bf16*)(ws + WS_POUT); f32x2* PML = (f32x2*)(ws + WS_PML); unsigned* QM = (unsigned*)(ws + WS_QM); unsigned long long* SQ = (unsigned long long*)(ws + WS_SQ);
    const int lo = a.ph_lo, hi_ = a.ph_hi; (void)lo; (void)hi_;
#if MK_PER_PHASE
#define IN(k) (lo <= (k) && (k) < hi_)
#define SEAM(k) do { if (IN(k) && IN((k) + 1)) grid.sync(); } while (0)
#else
#define IN(k) true
#define SEAM(k) do { unsigned ln_; asm volatile("v_mbcnt_lo_u32_b32 %0, -1, 0\n\tv_mbcnt_hi_u32_b32 %0, -1, %0" : "=v"(ln_)); const bool t0_ = (wave0 == 0) && (ln_ == 0u); xcd_barrier(bar, t0_); } while (0)
#endif

#ifndef NO_P0
    if (IN(0)) { PHASE_IDS for (int i = bx * 512 + tid; i < 3 * MTOK; i += G * 512) ROWSS[MTOK + i] = 0.f;
        p0_prologue(a, lds, tid, lane, wave, bx, G); }
#endif
    if (a.ph_lo < 0) grid.sync();
    SEAM(0);
    for (int l = 0; l < 2; ++l) {
        const int pb = 1 + 9 * l - (l ? 1 : 0);
        const float* mod_l = mod + (size_t)l * 8 * 6144;
        const float* xin = (l == 0) ? a.in[0] : a.out;
        float* bias_in = BIAS2 + (size_t)l * BIAS2_L; float* bias_m1 = bias_in + 8 * INW;
        if (l == 0) {
            if (IN(pb + 0)) { PHASE_IDS
                for (int it = gw; it < 2 * (INW + FF); it += NGW) { const int ll = it / (INW + FF), r = it % (INW + FF); const float* md = mod + (size_t)ll * 8 * 6144; float* bi = BIAS2 + (size_t)ll * BIAS2_L;
                    if (r < INW) bias2_item((const bf16*)(ws + WS_WIN) + (size_t)ll * INW * DM, md, bi, INW, r, lane);
                    else bias2_item((const bf16*)(ws + WS_W1) + (size_t)ll * FF * DM, md + 3 * 1024, bi + 8 * INW, FF, r - INW, lane); }
                norm_phase0(xin, XN, (unsigned short*)(ws + WS_R16), ROWSS, a.in[5], mod_l, 0, gw, NGW, lane); }
            SEAM(pb + 0);
        }
        if (IN(pb + 1)) { PHASE_IDS
            pg8::Gemm g{XN, (const bf16*)(ws + WS_WIN) + (size_t)l * INW * DM, MTOK, INW, DM}; pg8::StaticOrder S; S.init(MTOK, INW, G, bx);
            pg8::EpiProj E{PROJ, INW, VTSB, VTMB, ROWSS + (size_t)(2 * l) * MTOK, bias_in, QK2, (const int*)a.in[2], a.in[12] + l * 64, a.in[13] + l * 64, kmean, (PG8_LAS float*)((PG8_LAS unsigned char*)lds + 131072 + 256)};
            pg8::gemm_phase<pg8::EpiProj, pg8::StaticOrder, true, true>((PG8_LAS unsigned char*)lds, g, S, E, tid);
        }
        SEAM(pb + 1);
        if (IN(pb + 2)) { PHASE_IDS
#ifndef NO_CF
            for (int it = bx; it < 256; it += G) kmean_item(QK2, kmean, lds, it, tid);
            cf_phase(PROJ, Yb, a.in[8] + l * 31 * 256, a.in[9] + l * 256, a.in[10] + l * 256, a.in[11] + l * 256, lds, bx, G, tid, lane, wave);
#endif
#ifndef NO_SC
            for (int it = bx; it < MTOK / 64; it += G) sc_item(PROJ, Yb, a.in[7] + l * 3 * 256, it, tid);
#endif
#ifndef NO_SB
            for (int it = vcu * NWAVES + wave; it < 32 * 256; it += NGW) sb_item(PROJ, VTSB, Yb, it >> 8, it & 255, lane);
#endif
        }
        SEAM(pb + 2);
        if (IN(pb + 3)) { PHASE_IDS
#ifndef NO_MOBA
            for (int it = vcu * NWAVES + wave; it < 32 * 128; it += NGW) moba_select(QK2, kmean, QM, SQ, it >> 7, it & 127, lane);
#endif
        }
        SEAM(pb + 3);
        if (IN(pb + 4)) { PHASE_IDS
#ifndef NO_MOBA
            for (int wi = vcu * NWAVES + wave; wi < 32 * 64; wi += NGW) moba_past(QK2, VTMB, QM, SQ, POUT, PML, wi >> 6, wi & 63, lane);
#endif
        }
        SEAM(pb + 4);
        if (IN(pb + 5)) { PHASE_IDS
#ifndef NO_MOBA
            for (int it = vcu * NWAVES + wave, kq = 0; it < 32 * 256; it += NGW, ++kq) { const int qt = (kq & 1) ? 255 - (it & 255) : (it & 255);
                moba_own(QK2, VTMB, POUT, PML, Yb, it >> 8, qt, lane); }
#endif
        }
        SEAM(pb + 5);
        if (IN(pb + 6)) { PHASE_IDS
            pg8::Gemm g{Yb, (const bf16*)(ws + WS_WOUT) + (size_t)l * DM * DM, MTOK, DM, DM}; pg8::StaticOrder S; S.init(MTOK, DM, G, bx);
            pg8::EpiRes E{(const unsigned short*)(ws + WS_R16), (void*)(ws + WS_R16), mod_l + 2 * 1024, XN, ROWSS + (size_t)(2 * l + 1) * MTOK, a.in[15] + l * DM, mod_l + 4 * 1024, 1};
            pg8::gemm_phase<pg8::EpiRes, pg8::StaticOrder, true, true>((PG8_LAS unsigned char*)lds, g, S, E, tid);
        }
        SEAM(pb + 6);
        if (IN(pb + 7)) { PHASE_IDS
            pg8::Gemm g{XN, (const bf16*)(ws + WS_W1) + (size_t)l * FF * DM, MTOK, FF, DM}; pg8::StaticOrder S; S.init(MTOK, FF, G, bx);
            pg8::EpiRelu2 E{HB, FF, ROWSS + (size_t)(2 * l + 1) * MTOK, bias_m1};
            pg8::gemm_phase<pg8::EpiRelu2, pg8::StaticOrder, true, true>((PG8_LAS unsigned char*)lds, g, S, E, tid);
        }
        SEAM(pb + 7);
        if (IN(pb + 8)) { PHASE_IDS
            pg8::Gemm g{HB, (const bf16*)(ws + WS_W2) + (size_t)l * DM * FF, MTOK, DM, FF}; pg8::StaticOrder S; S.init(MTOK, DM, G, bx);
            pg8::EpiRes E{(const unsigned short*)(ws + WS_R16), (l == 0) ? (void*)(ws + WS_R16) : (void*)a.out, mod_l + 5 * 1024, (l == 0) ? XN : (bf16*)nullptr, ROWSS + (size_t)2 * MTOK, a.in[5] + DM, mod + (size_t)8 * 6144 + 1 * 1024, l == 0};
            pg8::gemm_phase<pg8::EpiRes, pg8::StaticOrder, true, true>((PG8_LAS unsigned char*)lds, g, S, E, tid);
        }
        if (l == 0) SEAM(pb + 8);
    }
#undef IN
#undef SEAM
}

extern "C" void kernel_launch(void* const* d_in, const int* in_sizes, int n_in, void* d_out, int out_size, void* d_ws, size_t ws_size, hipStream_t stream) {
    static int grid = 0;
    if (grid == 0) {
        if (n_in != 18 || out_size != MTOK * DM || ws_size < WS_END) { fprintf(stderr, "kernel_launch: unexpected shapes (n_in %d out %d ws %zu)\n", n_in, out_size, ws_size); grid = -1; return; }
        int dev = 0, cus = 0, per_cu = 0;
        hipGetDevice(&dev); hipDeviceGetAttribute(&cus, hipDeviceAttributeMultiprocessorCount, dev);
        if (hipFuncSetAttribute((const void*)hybrid_fwd, hipFuncAttributeMaxDynamicSharedMemorySize, LDS_BYTES) != hipSuccess) { fprintf(stderr, "kernel_launch: hipFuncSetAttribute failed\n"); grid = -1; return; }
        if (hipOccupancyMaxActiveBlocksPerMultiprocessor(&per_cu, (const void*)hybrid_fwd, NWAVES * 64, LDS_BYTES) != hipSuccess || per_cu < 1) { fprintf(stderr, "kernel_launch: occupancy query says %d\n", per_cu); per_cu = 1; }
        (void)hipGetLastError();
        grid = cus * per_cu;
    }
    if (grid < 0) return;
    if (hipMemsetAsync((char*)d_ws + WS_CTL, 0, CTL_ZERO_BYTES, stream) != hipSuccess) { fprintf(stderr, "kernel_launch: memset failed\n"); return; }
    Args a{};
    for (int i = 0; i < 18; ++i) a.in[i] = (const float*)d_in[i];
    a.out = (float*)d_out; a.ws = (unsigned char*)d_ws;
#if MK_PER_PHASE
    for (int p = 0; p < N_PHASES; ++p) { a.ph_lo = p; a.ph_hi = p + 1; void* args[] = {&a};
        hipError_t e = hipLaunchCooperativeKernel((const void*)hybrid_fwd, dim3(grid), dim3(NWAVES * 64), args, LDS_BYTES, stream);
        if (e != hipSuccess) { fprintf(stderr, "cooperative launch failed (phase %d): %s (grid %d)\n", p, hipGetErrorString(e), grid); break; } }
#else
    a.ph_lo = 0; a.ph_hi = N_PHASES; void* args[] = {&a};
    hipError_t e = hipLaunchCooperativeKernel((const void*)hybrid_fwd, dim3(grid), dim3(NWAVES * 64), args, LDS_BYTES, stream);
    if (e != hipSuccess) fprintf(stderr, "cooperative launch failed: %s (grid %d)\n", hipGetErrorString(e), grid);
#endif
}
```

```cpp
#include <hip/hip_runtime.h>
#include <hip/hip_cooperative_groups.h>
#include <cstdio>
#include <cstdint>
namespace cg = cooperative_groups;
namespace pg8 {
#define PG8_LAS __attribute__((address_space(3)))
typedef unsigned short bf16_t;
typedef short bf16x8 __attribute__((ext_vector_type(8)));
typedef float f32x4 __attribute__((ext_vector_type(4)));
typedef unsigned u32x4 __attribute__((ext_vector_type(4)));
constexpr int BM = 256, BK = 64, HALF = 128, HTB = HALF * BK * 2  , STAGE_BYTES = 8 * HTB, NXCD = 8, WGM = 8;

__host__ __device__ __forceinline__ int lds_byte(int r, int c) { const int st = (r >> 4) * 2 + (c >> 5), rr = r & 15, cc = c & 31, ob = rr * 64 + cc * 2; return st * 1024 + (ob ^ (((ob >> 9) & 1) << 5)); }
__host__ __device__ __forceinline__ void stage_rc(int b, int& R, int& C) { const int st = b / 1024, sb = b % 1024, swz = sb ^ (((sb >> 9) & 1) << 5); R = (st >> 1) * 16 + swz / 64; C = (st & 1) * 32 + (swz % 64) / 2; }
__host__ __device__ __forceinline__ int perm32(int rho) { const int n = rho >> 4, i = rho & 15; return 8 * (i >> 2) + 4 * n + (i & 3); }

struct Unit { int pm, pn; };
struct Gemm { const bf16_t* A; const bf16_t* Bt; int M, N, K; };

struct StaticOrder {
    int nM, nN, nwg, G, c;
    __host__ __device__ void init(int M, int N, int G_, int c_) { nM = M / BM; nN = N / BM; nwg = nM * nN; G = G_; c = c_; }
    __host__ __device__ bool next(int i, Unit& u) const {
        const long L = (long)i * G + c; if (L >= nwg) return false;
        int wgid = (int)L; { const int q = nwg / NXCD, r = nwg % NXCD, xcd = wgid % NXCD, off = wgid / NXCD; wgid = (xcd < r ? xcd * (q + 1) : r * (q + 1) + (xcd - r) * q) + off; }
        const int nig = WGM * nN, gid = wgid / nig, fm = gid * WGM, gsz = (nM - fm) < WGM ? (nM - fm) : WGM;
        u.pm = fm + ((wgid % nig) % gsz); u.pn = (wgid % nig) / gsz; return true;
    }
    __device__ __forceinline__ void a_ready(const Unit&) const {}
    __device__ __forceinline__ void done(const Unit&) const {}
};
__device__ __forceinline__ unsigned cvt_pk_bf16(float lo, float hi) { unsigned r; asm volatile("v_cvt_pk_bf16_f32 %0, %1, %2" : "=v"(r) : "v"(lo), "v"(hi)); return r; }
typedef float f32x2 __attribute__((ext_vector_type(2)));
__device__ __forceinline__ unsigned short bf16_1(float v) { return (unsigned short)(cvt_pk_bf16(v, v) & 0xffffu); }
struct EpiProj {
    static constexpr bool PERM = true, AFTER_DRAIN = false;
    bf16_t* O; int ldc; bf16_t* vt_sb; bf16_t* vt_mb; const float* rowss; const float* bias2; bf16_t* qk2; const int* pos; const float* gq; const float* gk; float* kmean; PG8_LAS float* gl;
    __device__ __forceinline__ void operator()(const f32x4 (&acc)[2][2][4][2], const Unit& u, int wr, int wc, int fr, int fq) const {
        const float* bb = bias2 + (size_t)(u.pm >> 5) * ldc + u.pn * BM + wc * 32 + 8 * fq;
        f32x4 bv[2][2]; float rs[2][4];
#pragma unroll
        for (int bj = 0; bj < 2; ++bj)
#pragma unroll
            for (int n = 0; n < 2; ++n) bv[bj][n] = *(const f32x4*)(bb + bj * HALF + 4 * n);
#pragma unroll
        for (int ai = 0; ai < 2; ++ai)
#pragma unroll
            for (int m = 0; m < 4; ++m) rs[ai][m] = rsqrtf(rowss[u.pm * BM + ai * HALF + wr * 64 + m * 16 + fr] * (1.f / 1024.f) + 1e-6f);
        if (u.pn == 1 || u.pn == 2 || u.pn == 9 || u.pn == 10) {
            const bool glu = u.pn >= 9;
            const int row0 = u.pm * BM + wr * 64 + fr, col0 = (glu ? 2304 : 256) + ((u.pn & 1) ? 0 : 128) + wc * 32 + 8 * fq;
#pragma unroll
            for (int ai = 0; ai < 2; ++ai)
#pragma unroll
                for (int m = 0; m < 4; ++m) { bf16_t* rowp = O + (size_t)(row0 + ai * HALF + m * 16) * ldc + col0;
                    f32x4 p0 = acc[ai][0][m][0] * rs[ai][m] + bv[0][0], p1 = acc[ai][0][m][1] * rs[ai][m] + bv[0][1];
                    f32x4 q0 = acc[ai][1][m][0] * rs[ai][m] + bv[1][0], q1 = acc[ai][1][m][1] * rs[ai][m] + bv[1][1];
                    if (glu) {
#pragma unroll
                        for (int e = 0; e < 4; ++e) { q0[e] = 1.f / (1.f + __expf(-q0[e])); q1[e] = 1.f / (1.f + __expf(-q1[e])); } }
                    p0 = p0 * q0; p1 = p1 * q1;
                    u32x4 w; w.x = cvt_pk_bf16(p0[0], p0[1]); w.y = cvt_pk_bf16(p0[2], p0[3]); w.z = cvt_pk_bf16(p1[0], p1[1]); w.w = cvt_pk_bf16(p1[2], p1[3]);
                    *(u32x4*)rowp = w; }
        } else if (u.pn == 6 || u.pn == 7) {
            const bool isk = (u.pn == 7);
            float invf[8]; int fql = fq; asm volatile("" : "+v"(fql));
#pragma unroll
            for (int e = 0; e < 8; ++e) invf[e] = expf((-9.210340371976184f * (float)(8 * fql + e)) / 32.0f);
            const float* gg = (isk ? gk : gq) + 8 * fql;
            const int rowb = u.pm * BM + wr * 64 + fr;
#pragma unroll
            for (int ai = 0; ai < 2; ++ai)
#pragma unroll
                for (int m = 0; m < 4; ++m) {
                    const int row = rowb + ai * HALF + m * 16; const float r_ = rsqrtf(rowss[row] * (1.f / 1024.f) + 1e-6f);
                    const f32x4 a0 = acc[ai][0][m][0] * r_ + *(const f32x4*)bb, a1 = acc[ai][0][m][1] * r_ + *(const f32x4*)(bb + 4), b0 = acc[ai][1][m][0] * r_ + *(const f32x4*)(bb + HALF), b1 = acc[ai][1][m][1] * r_ + *(const f32x4*)(bb + HALF + 4);
                    float ss = ((a0[0] * a0[0] + a0[1] * a0[1]) + (a0[2] * a0[2] + a0[3] * a0[3])) + ((a1[0] * a1[0] + a1[1] * a1[1]) + (a1[2] * a1[2] + a1[3] * a1[3]))
                             + ((b0[0] * b0[0] + b0[1] * b0[1]) + (b0[2] * b0[2] + b0[3] * b0[3])) + ((b1[0] * b1[0] + b1[1] * b1[1]) + (b1[2] * b1[2] + b1[3] * b1[3]));
                    ss += __shfl_xor(ss, 16); ss += __shfl_xor(ss, 32);
                    const float rstd = rsqrtf(ss * (1.f / 64.f) + 1e-6f);
                    const f32x4 ya0 = a0 * rstd * *(const f32x4*)gg, ya1 = a1 * rstd * *(const f32x4*)(gg + 4), yb0 = b0 * rstd * *(const f32x4*)(gg + 32), yb1 = b1 * rstd * *(const f32x4*)(gg + 36);
                    const float lo[8] = {ya0[0], ya0[1], ya0[2], ya0[3], ya1[0], ya1[1], ya1[2], ya1[3]}, hi[8] = {yb0[0], yb0[1], yb0[2], yb0[3], yb1[0], yb1[1], yb1[2], yb1[3]};
                    const float posf = (float)pos[row];
                    float ol[8], oh[8];
#pragma unroll
                    for (int e = 0; e < 8; ++e) { const float ang = posf * invf[e]; const float rv = ang * 0.15915494309189535f; const float rf = rv - floorf(rv);
                        const float c = __builtin_amdgcn_cosf(rf), sn = __builtin_amdgcn_sinf(rf);
                        ol[e] = lo[e] * c - hi[e] * sn; oh[e] = hi[e] * c + lo[e] * sn; }
                    if (!isk) {
#pragma unroll
                        for (int e = 0; e < 8; ++e) { ol[e] *= 0.125f * 1.4426950408889634f; oh[e] *= 0.125f * 1.4426950408889634f; }
                    }
                    bf16_t* qp = qk2 + (size_t)row * 512 + (isk ? 256 : 0) + wc * 64 + 8 * fql;
                    u32x4 w0, w1;
                    w0.x = cvt_pk_bf16(ol[0], ol[1]); w0.y = cvt_pk_bf16(ol[2], ol[3]); w0.z = cvt_pk_bf16(ol[4], ol[5]); w0.w = cvt_pk_bf16(ol[6], ol[7]);
                    w1.x = cvt_pk_bf16(oh[0], oh[1]); w1.y = cvt_pk_bf16(oh[2], oh[3]); w1.z = cvt_pk_bf16(oh[4], oh[5]); w1.w = cvt_pk_bf16(oh[6], oh[7]);
                    *(u32x4*)qp = w0; *(u32x4*)(qp + 32) = w1;
                }
        } else if (u.pn == 5 || u.pn == 8) {
            bf16_t* vt = (u.pn == 5) ? vt_sb : vt_mb;
            const int b = u.pm >> 5, s0 = (u.pm & 31) * 256 + wr * 64 + fr;
#pragma unroll
            for (int bj = 0; bj < 2; ++bj)
#pragma unroll
                for (int n = 0; n < 2; ++n)
#pragma unroll
                    for (int e = 0; e < 4; ++e) {
                        const int c = 128 * bj + 32 * wc + 8 * fq + 4 * n + e;
                        bf16_t* col = vt + ((size_t)((b * 4 + (c >> 6)) * 64 + (c & 63))) * 8192 + s0;
#pragma unroll
                        for (int ai = 0; ai < 2; ++ai)
#pragma unroll
                            for (int m = 0; m < 4; ++m) col[ai * 128 + m * 16] = bf16_1(acc[ai][bj][m][n][e] * rs[ai][m] + bv[bj][n][e]);
                    }
        } else {
            const int row0 = u.pm * BM + wr * 64 + fr, col0 = u.pn * BM + wc * 32 + 8 * fq;
#pragma unroll
            for (int ai = 0; ai < 2; ++ai)
#pragma unroll
                for (int m = 0; m < 4; ++m) { bf16_t* rowp = O + (size_t)(row0 + ai * HALF + m * 16) * ldc + col0;
#pragma unroll
                    for (int bj = 0; bj < 2; ++bj) { const f32x4 v0 = acc[ai][bj][m][0] * rs[ai][m] + bv[bj][0], v1 = acc[ai][bj][m][1] * rs[ai][m] + bv[bj][1];
                        u32x4 w; w.x = cvt_pk_bf16(v0[0], v0[1]); w.y = cvt_pk_bf16(v0[2], v0[3]); w.z = cvt_pk_bf16(v1[0], v1[1]); w.w = cvt_pk_bf16(v1[2], v1[3]);
                        *(u32x4*)(rowp + bj * HALF) = w; } }
        }
    }
};
struct EpiRelu2 {
    static constexpr bool PERM = true, AFTER_DRAIN = false;
    bf16_t* O; int ldc; const float* rowss; const float* bias2;
    __device__ __forceinline__ void operator()(const f32x4 (&acc)[2][2][4][2], const Unit& u, int wr, int wc, int fr, int fq) const {
        const int row0 = u.pm * BM + wr * 64 + fr, col0 = u.pn * BM + wc * 32 + 8 * fq;
        const float* bb = bias2 + (size_t)(u.pm >> 5) * ldc + col0;
        f32x4 bv[2][2];
#pragma unroll
        for (int bj = 0; bj < 2; ++bj)
#pragma unroll
            for (int n = 0; n < 2; ++n) bv[bj][n] = *(const f32x4*)(bb + bj * HALF + 4 * n);
#pragma unroll
        for (int ai = 0; ai < 2; ++ai)
#pragma unroll
            for (int m = 0; m < 4; ++m) { bf16_t* rowp = O + (size_t)(row0 + ai * HALF + m * 16) * ldc + col0; const float rs = rsqrtf(rowss[row0 + ai * HALF + m * 16] * (1.f / 1024.f) + 1e-6f);
#pragma unroll
                for (int bj = 0; bj < 2; ++bj) { f32x4 v0 = acc[ai][bj][m][0] * rs + bv[bj][0], v1 = acc[ai][bj][m][1] * rs + bv[bj][1];
#pragma unroll
                    for (int e = 0; e < 4; ++e) { const float a0 = fmaxf(v0[e], 0.f), a1 = fmaxf(v1[e], 0.f); v0[e] = a0 * a0; v1[e] = a1 * a1; }
                    u32x4 w; w.x = cvt_pk_bf16(v0[0], v0[1]); w.y = cvt_pk_bf16(v0[2], v0[3]); w.z = cvt_pk_bf16(v1[0], v1[1]); w.w = cvt_pk_bf16(v1[2], v1[3]);
                    *(u32x4*)(rowp + bj * HALF) = w; } }
    }
};
typedef _Float16 h16x8 __attribute__((ext_vector_type(8)));
typedef float f32x8 __attribute__((ext_vector_type(8)));
struct EpiRes {
    static constexpr bool PERM = true, AFTER_DRAIN = false;
    const unsigned short* base; void* out; const float* gate; bf16_t* xn; float* rowss; const float* gnext; const float* scnext; int o16;
    __device__ __forceinline__ void operator()(const f32x4 (&acc)[2][2][4][2], const Unit& u, int wr, int wc, int fr, int fq) const {
        const float* g = gate + (size_t)(u.pm >> 5) * 6144;
        const int col0 = u.pn * BM + wc * 32 + 8 * fq;
        f32x4 gv[2][2], gs[2][2];
#pragma unroll
        for (int bj = 0; bj < 2; ++bj)
#pragma unroll
            for (int n = 0; n < 2; ++n) { gv[bj][n] = *(const f32x4*)(g + col0 + bj * HALF + n * 4);
                if (xn) gs[bj][n] = *(const f32x4*)(gnext + col0 + bj * HALF + n * 4) * (1.f + *(const f32x4*)(scnext + (size_t)(u.pm >> 5) * 6144 + col0 + bj * HALF + n * 4));
                else gs[bj][n] = (f32x4){0.f, 0.f, 0.f, 0.f}; }
#pragma unroll
        for (int ai = 0; ai < 2; ++ai)
#pragma unroll
            for (int mp = 0; mp < 4; mp += 4) {
                u32x4 pre[4][2];
#pragma unroll
                for (int mm = 0; mm < 4; ++mm) { const size_t off = (size_t)(u.pm * BM + ai * HALF + wr * 64 + (mp + mm) * 16 + fr) * 1024 + col0;
#pragma unroll
                    for (int bj = 0; bj < 2; ++bj) {
                        pre[mm][bj] = *(const u32x4*)(base + off + bj * HALF); } }
                asm volatile("" ::: "memory");
#pragma unroll
                for (int mm = 0; mm < 4; ++mm) { const int m = mp + mm; const int row = u.pm * BM + ai * HALF + wr * 64 + m * 16 + fr; const size_t off = (size_t)row * 1024 + col0; float ss = 0.f;
#pragma unroll
                    for (int bj = 0; bj < 2; ++bj) {
                        const f32x8 bf = __builtin_convertvector(__builtin_bit_cast(h16x8, pre[mm][bj]), f32x8);
                        const f32x4 o0 = (f32x4){bf[0], bf[1], bf[2], bf[3]} + gv[bj][0] * acc[ai][bj][m][0], o1 = (f32x4){bf[4], bf[5], bf[6], bf[7]} + gv[bj][1] * acc[ai][bj][m][1];
                        if (o16) { const f32x8 f = {o0[0], o0[1], o0[2], o0[3], o1[0], o1[1], o1[2], o1[3]}; *(u32x4*)((unsigned short*)out + off + bj * HALF) = __builtin_bit_cast(u32x4, __builtin_convertvector(f, h16x8)); }
                        else { *(f32x4*)((float*)out + off + bj * HALF) = o0; *(f32x4*)((float*)out + off + bj * HALF + 4) = o1; }
                        if (xn) { const f32x4 y0 = o0 * gs[bj][0], y1 = o1 * gs[bj][1];
                            u32x4 w; w.x = cvt_pk_bf16(y0[0], y0[1]); w.y = cvt_pk_bf16(y0[2], y0[3]); w.z = cvt_pk_bf16(y1[0], y1[1]); w.w = cvt_pk_bf16(y1[2], y1[3]);
                            *(u32x4*)(xn + off + bj * HALF) = w;
                            ss += ((o0[0] * o0[0] + o0[1] * o0[1]) + (o0[2] * o0[2] + o0[3] * o0[3])) + ((o1[0] * o1[0] + o1[1] * o1[1]) + (o1[2] * o1[2] + o1[3] * o1[3])); } }
                    if (xn) { ss += __shfl_xor(ss, 16); ss += __shfl_xor(ss, 32); if (fq == 0) atomicAdd(rowss + row, ss); } }
            }
    }
};
template <class Epi, class Sched, bool ALIGN_EPI = false, bool SP2 = false>
__device__ __forceinline__ void gemm_phase(PG8_LAS unsigned char* lds, const Gemm g, const Sched& S, const Epi& E, int tid_in) {
    int tid_l = tid_in; asm volatile("" : "+v"(tid_l));
    const int tid = tid_l, wid = __builtin_amdgcn_readfirstlane(tid >> 6), lane = tid & 63, wr = wid >> 2, wc = wid & 3, fr = lane & 15, fq = lane >> 4;
    const int K = g.K, nt = K / BK;
    unsigned voffA[2], voffB[2];
#pragma unroll
    for (int i = 0; i < 2; ++i) { int R, C; stage_rc(tid * 16 + i * 8192, R, C); const int Rb = Epi::PERM ? ((R & ~31) + perm32(R & 31)) : R;
        voffA[i] = (unsigned)(R * K + C) * 2u; voffB[i] = (unsigned)(Rb * K + C) * 2u; }
    const size_t kstep = (size_t)(BK * 2);
    const size_t hstep = (size_t)HALF * K * 2;
    const size_t tstep = 2 * hstep;
    const unsigned ldsw = (unsigned)wid * 1024u;
    const int aoff = lds_byte(wr * 64 + fr, fq * 8), boff = lds_byte(wc * 32 + fr, fq * 8);
#define PG8_SA(b, h) (((b) * 2 + (h)) * HTB)
#define PG8_SB(b, h) ((4 + (b) * 2 + (h)) * HTB)
#define PG8_STAGE(bufoff, gbase, voff) do { _Pragma("unroll") for (int _i = 0; _i < 2; ++_i) \
        __builtin_amdgcn_global_load_lds((const unsigned*)((const char*)(gbase) + (voff)[_i]), (PG8_LAS unsigned*)(lds + (bufoff) + ldsw + _i * 8192), 16, 0, 0); } while (0)
#define PG8_LDA(dst, b, h) do { _Pragma("unroll") for (int m = 0; m < 4; ++m) _Pragma("unroll") for (int k = 0; k < 2; ++k) dst[m][k] = *(const PG8_LAS bf16x8*)(lds + PG8_SA(b, h) + aoff + m * 2048 + k * 1024); } while (0)
#define PG8_LDB(dst, b, h) do { _Pragma("unroll") for (int n = 0; n < 2; ++n) _Pragma("unroll") for (int k = 0; k < 2; ++k) dst[n][k] = *(const PG8_LAS bf16x8*)(lds + PG8_SB(b, h) + boff + n * 2048 + k * 1024); } while (0)
#define PG8_MMA(ai, bj, At, Bt) do { __builtin_amdgcn_s_setprio(1); _Pragma("unroll") for (int m = 0; m < 4; ++m) _Pragma("unroll") for (int n = 0; n < 2; ++n) _Pragma("unroll") for (int k = 0; k < 2; ++k) \
        acc[ai][bj][m][n] = __builtin_amdgcn_mfma_f32_16x16x32_bf16(Bt[n][k], At[m][k], acc[ai][bj][m][n], 0, 0, 0); __builtin_amdgcn_s_setprio(0); } while (0)
#define PG8_WAIT_V(n) asm volatile("s_waitcnt vmcnt(" #n ")" ::: "memory")
#define PG8_WAIT_L(n) asm volatile("s_waitcnt lgkmcnt(" #n ")" ::: "memory")
#define PG8_BAR __builtin_amdgcn_s_barrier()
#define PG8_SCHED __builtin_amdgcn_sched_barrier(0)
    Unit cur, nxt; int ui = 0;
    if (!S.next(0, cur)) return;
    f32x4 acc[2][2][4][2];
#pragma unroll
    for (int a = 0; a < 2; ++a)
#pragma unroll
        for (int b = 0; b < 2; ++b)
#pragma unroll
            for (int m = 0; m < 4; ++m)
#pragma unroll
                for (int n = 0; n < 2; ++n) acc[a][b][m][n] = (f32x4){0.f, 0.f, 0.f, 0.f};
    bf16x8 At[4][2], B0[2][2], B1[2][2];
    const char* cA = (const char*)g.A + (size_t)cur.pm * tstep; const char* cB = (const char*)g.Bt + (size_t)cur.pn * tstep;
    S.a_ready(cur);
    if constexpr (SP2) {
        PG8_STAGE(PG8_SB(0, 0), cB, voffB); PG8_STAGE(PG8_SB(0, 1), cB + hstep, voffB); PG8_STAGE(PG8_SA(0, 0), cA, voffA); PG8_STAGE(PG8_SA(0, 1), cA + hstep, voffA);
        if (wr == 1) PG8_BAR;
        PG8_WAIT_V(2); PG8_BAR;
        PG8_STAGE(PG8_SB(1, 0), cB + kstep, voffB); PG8_STAGE(PG8_SA(1, 0), cA + kstep, voffA); PG8_STAGE(PG8_SB(1, 1), cB + hstep + kstep, voffB);
        PG8_WAIT_V(6); PG8_BAR;
    } else {
        PG8_STAGE(PG8_SB(0, 0), cB, voffB); PG8_STAGE(PG8_SA(0, 0), cA, voffA); PG8_STAGE(PG8_SB(0, 1), cB + hstep, voffB); PG8_STAGE(PG8_SA(0, 1), cA + hstep, voffA);
        if (wr == 1) PG8_BAR;
        PG8_WAIT_V(4); PG8_BAR;
        PG8_STAGE(PG8_SB(1, 0), cB + kstep, voffB); PG8_STAGE(PG8_SA(1, 0), cA + kstep, voffA); PG8_STAGE(PG8_SB(1, 1), cB + hstep + kstep, voffB);
        PG8_WAIT_V(6); PG8_BAR;
    }
    for (;;) {
        const bool has_next = S.next(ui + 1, nxt);
        const char* nA = has_next ? (const char*)g.A + (size_t)nxt.pm * tstep : cA; const char* nB = has_next ? (const char*)g.Bt + (size_t)nxt.pn * tstep : cB;
        for (int t = 0; t < nt; t += 2) {
            const bool last = (t == nt - 2);
            const char* a1 = cA + (size_t)(t + 1) * kstep;
            const char* a2 = last ? nA : cA + (size_t)(t + 2) * kstep; const char* b2 = last ? nB : cB + (size_t)(t + 2) * kstep;
            const char* a3 = a2 + kstep; const char* b3 = b2 + kstep;
            if (last && has_next) S.a_ready(nxt);
            if constexpr (SP2) {
            PG8_LDB(B0, 0, 0); PG8_LDB(B1, 0, 1); PG8_SCHED; PG8_LDA(At, 0, 0); PG8_STAGE(PG8_SA(1, 1), a1 + hstep, voffA);
            PG8_WAIT_V(8); PG8_WAIT_L(0); PG8_BAR; PG8_MMA(0, 0, At, B0); PG8_MMA(0, 1, At, B1); PG8_BAR; PG8_SCHED;
            PG8_LDA(At, 0, 1); PG8_STAGE(PG8_SB(0, 0), b2, voffB); PG8_STAGE(PG8_SB(0, 1), b2 + hstep, voffB); PG8_STAGE(PG8_SA(0, 0), a2, voffA);
            PG8_WAIT_V(8); PG8_WAIT_L(0); PG8_BAR; PG8_MMA(1, 0, At, B0); PG8_MMA(1, 1, At, B1); PG8_BAR; PG8_SCHED;
            PG8_LDB(B0, 1, 0); PG8_LDB(B1, 1, 1); PG8_SCHED; PG8_LDA(At, 1, 0); PG8_STAGE(PG8_SA(0, 1), a2 + hstep, voffA);
            PG8_WAIT_V(8); PG8_WAIT_L(0); PG8_BAR; PG8_MMA(0, 0, At, B0); PG8_MMA(0, 1, At, B1); PG8_BAR; PG8_SCHED;
            PG8_LDA(At, 1, 1); PG8_STAGE(PG8_SB(1, 0), b3, voffB); PG8_STAGE(PG8_SB(1, 1), b3 + hstep, voffB); PG8_STAGE(PG8_SA(1, 0), a3, voffA);
            PG8_WAIT_V(8); PG8_WAIT_L(0); PG8_BAR; PG8_MMA(1, 0, At, B0); PG8_MMA(1, 1, At, B1); PG8_BAR; PG8_SCHED;
            } else {
            PG8_LDB(B0, 0, 0); PG8_SCHED; PG8_LDA(At, 0, 0); PG8_STAGE(PG8_SA(1, 1), a1 + hstep, voffA);
            PG8_WAIT_L(8); PG8_BAR; PG8_WAIT_L(0); PG8_MMA(0, 0, At, B0); PG8_BAR; PG8_SCHED;
            PG8_LDB(B1, 0, 1); PG8_STAGE(PG8_SB(0, 0), b2, voffB);
            PG8_BAR; PG8_WAIT_L(0); PG8_MMA(0, 1, At, B1); PG8_BAR;
            PG8_LDA(At, 0, 1); PG8_STAGE(PG8_SA(0, 0), a2, voffA);
            PG8_BAR; PG8_WAIT_L(0); PG8_MMA(1, 0, At, B0); PG8_BAR; PG8_SCHED;
            PG8_STAGE(PG8_SB(0, 1), b2 + hstep, voffB);
            PG8_WAIT_V(6); PG8_BAR; PG8_MMA(1, 1, At, B1); PG8_BAR;
            PG8_LDB(B0, 1, 0); PG8_SCHED; PG8_LDA(At, 1, 0); PG8_STAGE(PG8_SA(0, 1), a2 + hstep, voffA);
            PG8_WAIT_L(8); PG8_BAR; PG8_WAIT_L(0); PG8_MMA(0, 0, At, B0); PG8_BAR; PG8_SCHED;
            PG8_LDB(B1, 1, 1); PG8_STAGE(PG8_SB(1, 0), b3, voffB);
            PG8_BAR; PG8_WAIT_L(0); PG8_MMA(0, 1, At, B1); PG8_BAR;
            PG8_LDA(At, 1, 1); PG8_STAGE(PG8_SA(1, 0), a3, voffA);
            PG8_BAR; PG8_WAIT_L(0); PG8_MMA(1, 0, At, B0); PG8_BAR; PG8_SCHED;
            PG8_STAGE(PG8_SB(1, 1), b3 + hstep, voffB);
            PG8_WAIT_V(6); PG8_BAR; PG8_MMA(1, 1, At, B1); PG8_BAR;
            }
        }
        if constexpr (ALIGN_EPI) { if (wr == 0) PG8_BAR; }
        if constexpr (!Epi::AFTER_DRAIN) { E(acc, cur, wr, wc, fr, fq); S.done(cur); }
        if (!has_next) break;
#pragma unroll
        for (int a = 0; a < 2; ++a)
#pragma unroll
            for (int b = 0; b < 2; ++b)
#pragma unroll
                for (int m = 0; m < 4; ++m)
#pragma unroll
                    for (int n = 0; n < 2; ++n) acc[a][b][m][n] = (f32x4){0.f, 0.f, 0.f, 0.f};
        cur = nxt; cA = nA; cB = nB; ++ui;
        if constexpr (ALIGN_EPI) { if (wr == 1) PG8_BAR; }
    }
    PG8_WAIT_V(0);
    if constexpr (!ALIGN_EPI) { if (wr == 0) PG8_BAR; }
    PG8_BAR;
    if constexpr (Epi::AFTER_DRAIN) { E.fused(acc, cur, wr, wc, fr, fq, lds, wid, lane); S.done(cur); }
#undef PG8_SA
#undef PG8_SB
#undef PG8_STAGE
#undef PG8_LDA
#undef PG8_LDB
#undef PG8_MMA
#undef PG8_WAIT_V
#undef PG8_WAIT_L
#undef PG8_BAR
#undef PG8_SCHED
}
}

constexpr int NB = 8, SEQ = 8192, DM = 1024, MTOK = NB * SEQ, INW = 2816, FF = 4096, NWAVES = 8;
constexpr size_t MiB = 1u << 20;
constexpr size_t WS_CTL = 1 * MiB, CTL_ZERO_BYTES = 16384;
constexpr size_t WS_MOD = 0, WS_KMEAN = 512 * 1024;
constexpr size_t WS_WIN = 2 * MiB, WS_WOUT = 14 * MiB, WS_W1 = 18 * MiB, WS_W2 = 34 * MiB;
constexpr size_t WS_VTSB = 50 * MiB, WS_VTMB = 82 * MiB;
constexpr size_t WS_XN = 128 * MiB, WS_Y = 256 * MiB, WS_PROJ = 384 * MiB;
constexpr size_t WS_POUT = WS_XN;
constexpr size_t WS_PML = 114 * MiB, WS_QM = 122 * MiB, WS_SQ = 124 * MiB, WS_ROWSS = 126 * MiB, WS_BIAS2 = 127 * MiB;
constexpr size_t WS_QK2 = 736 * MiB;
constexpr size_t WS_R16 = 896 * MiB, WS_END = 1024 * MiB;
constexpr int LDS_BYTES = 135168;
constexpr int N_PHASES = 18;
constexpr int QKP = 512;
constexpr int BIAS2_L = 8 * INW + 8 * FF;

typedef unsigned short bf16;
typedef short bf16x8 __attribute__((ext_vector_type(8)));
typedef float f32x4 __attribute__((ext_vector_type(4)));
typedef float f32x2 __attribute__((ext_vector_type(2)));
typedef float f32x16 __attribute__((ext_vector_type(16)));
typedef unsigned u32x4 __attribute__((ext_vector_type(4)));
typedef unsigned u32x2 __attribute__((ext_vector_type(2)));
typedef __bf16 bf16x2_t __attribute__((ext_vector_type(2)));
#define LAS __attribute__((address_space(3)))
__device__ __forceinline__ unsigned pk2(float lo, float hi) { f32x2 v = {lo, hi}; bf16x2_t b = __builtin_convertvector(v, bf16x2_t); return __builtin_bit_cast(unsigned, b); }
__device__ __forceinline__ float bflo(unsigned w) { return __uint_as_float(w << 16); }
__device__ __forceinline__ float bfhi(unsigned w) { return __uint_as_float(w & 0xffff0000u); }
__device__ __forceinline__ void unpack8(const u32x4 w, float (&f)[8]) {
    f[0] = bflo(w.x); f[1] = bfhi(w.x); f[2] = bflo(w.y); f[3] = bfhi(w.y); f[4] = bflo(w.z); f[5] = bfhi(w.z); f[6] = bflo(w.w); f[7] = bfhi(w.w); }
__device__ __forceinline__ u32x4 pack8(const float (&f)[8]) { u32x4 w; w.x = pk2(f[0], f[1]); w.y = pk2(f[2], f[3]); w.z = pk2(f[4], f[5]); w.w = pk2(f[6], f[7]); return w; }
__device__ __forceinline__ float wave_sum(float v) {
#pragma unroll
    for (int o = 1; o < 64; o <<= 1) v += __shfl_xor(v, o);
    return v;
}
__device__ __forceinline__ float ex2(float x) { return __builtin_amdgcn_exp2f(x); }
__device__ __forceinline__ float lg2(float x) { return __builtin_amdgcn_logf(x); }

struct Args { const float* in[18]; float* out; unsigned char* ws; int ph_lo, ph_hi; };

__device__ __forceinline__ int win_src_block(int nb) {
    const int t = nb >> 3, j = nb & 7;
    if (t == 1 || t == 9) return (j < 4) ? nb : nb + 4;
    if (t == 2 || t == 10) return (j < 4) ? nb - 4 : nb;
    if (t == 6 || t == 7) return t * 8 + ((j < 4) ? 2 * j : 2 * (j - 4) + 1);
    return nb;
}
template <bool PERMUTE = false> __device__ __forceinline__ void p0_transpose_item(const float* W, int K, int N, bf16* WT, LAS float* scr, int item, int lane) {
    const int nblk = N / 32, kb = item / nblk, nb = item % nblk, k0 = 64 * kb, n0 = 32 * nb, ns0 = 32 * (PERMUTE ? win_src_block(nb) : nb);
#pragma unroll 8
    for (int i = 0; i < 32; ++i) { const int kk = 2 * i + (lane >> 5); scr[kk * 33 + (lane & 31)] = W[(size_t)(k0 + kk) * N + ns0 + (lane & 31)]; }
    asm volatile("s_waitcnt lgkmcnt(0)" ::: "memory");
    const int c = lane & 7;
#pragma unroll
    for (int j = 0; j < 4; ++j) { const int n = (lane >> 3) + 8 * j; const LAS float* s = scr + (8 * c) * 33 + n;
        u32x4 o; o.x = pk2(s[0 * 33], s[1 * 33]); o.y = pk2(s[2 * 33], s[3 * 33]); o.z = pk2(s[4 * 33], s[5 * 33]); o.w = pk2(s[6 * 33], s[7 * 33]);
        *(u32x4*)(WT + (size_t)(n0 + n) * K + k0 + 8 * c) = o; }
    asm volatile("s_waitcnt lgkmcnt(0)" ::: "memory");
}

__device__ __forceinline__ void p0_prologue(const Args& a, unsigned char* lds, int tid, int lane, int wave, int bx, int G) {
    {
        float* cact = (float*)lds;
        float* red = (float*)(lds + 32768);
        const float* c = a.in[1]; const float* w_ada = a.in[3]; const float* b_ada = a.in[4];
        float* mod = (float*)(a.ws + WS_MOD);
        if (bx < 192) { for (int i = tid; i < 8192; i += 512) { const float v = c[i]; cact[i] = v / (1.f + __expf(-v)); } }
        __syncthreads();
        for (int it = bx; it < 192; it += G) {
            const int l = it / 96, cgp = it % 96;
            const float* W = w_ada + (size_t)l * 1024 * 6144 + cgp * 64 + lane;
            float acc[8];
#pragma unroll
            for (int b = 0; b < 8; ++b) acc[b] = 0.f;
            for (int k0 = wave * 128; k0 < wave * 128 + 128; k0 += 32) {
                float wv[32];
#pragma unroll
                for (int i = 0; i < 32; ++i) wv[i] = W[(size_t)(k0 + i) * 6144];
#pragma unroll
                for (int i = 0; i < 32; i += 4)
#pragma unroll
                    for (int b = 0; b < 8; ++b) { const f32x4 cv = *(const f32x4*)(cact + b * 1024 + k0 + i); acc[b] += cv.x * wv[i] + cv.y * wv[i + 1] + cv.z * wv[i + 2] + cv.w * wv[i + 3]; }
            }
#pragma unroll
            for (int b = 0; b < 8; ++b) red[(wave * 8 + b) * 64 + lane] = acc[b];
            __syncthreads();
            { const int b = tid >> 6, j = tid & 63; float s = 0.f;
#pragma unroll
              for (int w = 0; w < 8; ++w) s += red[(w * 8 + b) * 64 + j];
              mod[(size_t)(l * 8 + b) * 6144 + cgp * 64 + j] = s + b_ada[l * 6144 + cgp * 64 + j]; }
            __syncthreads();
        }
        __syncthreads();
    }
    {
        LAS float* scr = (LAS float*)((LAS unsigned char*)lds + wave * 16384);
        const int gw = bx * NWAVES + wave, NGW = G * NWAVES;
        constexpr int I_IN = (DM / 64) * (INW / 32), I_OUT = (DM / 64) * (DM / 32), I_1 = (DM / 64) * (FF / 32), I_2 = (FF / 64) * (DM / 32);
        constexpr int PER_L = I_IN + I_OUT + I_1 + I_2;
        for (int it = gw; it < 2 * PER_L; it += NGW) {
            const int l = it / PER_L; int r = it % PER_L;
            if (r < I_IN) { p0_transpose_item<true>(a.in[6] + (size_t)l * DM * INW, DM, INW, (bf16*)(a.ws + WS_WIN) + (size_t)l * INW * DM, scr, r, lane); continue; } r -= I_IN;
            if (r < I_OUT) { p0_transpose_item(a.in[14] + (size_t)l * DM * DM, DM, DM, (bf16*)(a.ws + WS_WOUT) + (size_t)l * DM * DM, scr, r, lane); continue; } r -= I_OUT;
            if (r < I_1) { p0_transpose_item(a.in[16] + (size_t)l * DM * FF, DM, FF, (bf16*)(a.ws + WS_W1) + (size_t)l * FF * DM, scr, r, lane); continue; } r -= I_1;
            p0_transpose_item(a.in[17] + (size_t)l * FF * DM, FF, DM, (bf16*)(a.ws + WS_W2) + (size_t)l * DM * FF, scr, r, lane);
        }
    }
}

__device__ __forceinline__ void norm_phase0(const float* x, bf16* xn, unsigned short* r16, float* rowss, const float* g, const float* mod_l, int shift_chunk, int gw, int NGW, int lane) {
    for (int r0 = gw * 32; r0 < MTOK; r0 += NGW * 32) {
        const float* mb = mod_l + (size_t)(r0 >> 13) * 6144 + shift_chunk * 1024;
        f32x4 gs[4];
#pragma unroll
        for (int j = 0; j < 4; ++j) { const int c = 4 * lane + 256 * j; const f32x4 g4 = *(const f32x4*)(g + c), sc = *(const f32x4*)(mb + 1024 + c); gs[j] = g4 * (1.f + sc); }
#pragma unroll 2
        for (int i = 0; i < 32; ++i) {
            const float* xr = x + (size_t)(r0 + i) * DM + 4 * lane;
            f32x4 v[4]; float ss = 0.f;
#pragma unroll
            for (int j = 0; j < 4; ++j) { v[j] = *(const f32x4*)(xr + 256 * j); ss += (v[j].x * v[j].x + v[j].y * v[j].y) + (v[j].z * v[j].z + v[j].w * v[j].w); }
            const float tot = wave_sum(ss); if (lane == 0) rowss[r0 + i] = tot;
            bf16* orow = xn + (size_t)(r0 + i) * DM + 4 * lane; unsigned short* rrow = r16 + (size_t)(r0 + i) * DM + 4 * lane;
#pragma unroll
            for (int j = 0; j < 4; ++j) { const f32x4 o = v[j] * gs[j]; u32x2 w; w.x = pk2(o.x, o.y); w.y = pk2(o.z, o.w); *(u32x2*)(orow + 256 * j) = w;
                typedef _Float16 h16x4 __attribute__((ext_vector_type(4))); *(u32x2*)(rrow + 256 * j) = __builtin_bit_cast(u32x2, __builtin_convertvector(v[j], h16x4)); }
        }
    }
}

__device__ __forceinline__ void bias2_item(const bf16* WT, const float* shift  , float* outp  , int N, int n, int lane) {
    const bf16* wr = WT + (size_t)n * DM + 8 * lane;
    float w[16]; { float t[8]; unpack8(*(const u32x4*)wr, t);
#pragma unroll
        for (int e = 0; e < 8; ++e) w[e] = t[e];
        unpack8(*(const u32x4*)(wr + 512), t);
#pragma unroll
        for (int e = 0; e < 8; ++e) w[8 + e] = t[e]; }
#pragma unroll
    for (int b = 0; b < 8; ++b) { const float* sp = shift + (size_t)b * 6144 + 8 * lane;
        const f32x4 s0 = *(const f32x4*)sp, s1 = *(const f32x4*)(sp + 4), s2 = *(const f32x4*)(sp + 512), s3 = *(const f32x4*)(sp + 516);
        float acc = (s0.x * w[0] + s0.y * w[1]) + (s0.z * w[2] + s0.w * w[3]) + (s1.x * w[4] + s1.y * w[5]) + (s1.z * w[6] + s1.w * w[7])
                  + (s2.x * w[8] + s2.y * w[9]) + (s2.z * w[10] + s2.w * w[11]) + (s3.x * w[12] + s3.y * w[13]) + (s3.z * w[14] + s3.w * w[15]);
        acc = wave_sum(acc);
        if (lane == 0) outp[(size_t)b * N + n] = acc; }
}

__device__ __forceinline__ void sc_item(const bf16* __restrict__ proj, bf16* __restrict__ Y, const float* __restrict__ wsc, int item, int tid) {
    const int cgp = tid & 31, ts = tid >> 5;
    float w[3][8];
#pragma unroll
    for (int k = 0; k < 3; ++k)
#pragma unroll
        for (int e = 0; e < 8; ++e) w[k][e] = wsc[k * 256 + cgp * 8 + e];
    const int r0 = item * 64;
#pragma unroll
    for (int p = 0; p < 4; ++p) {
        const int row = r0 + p * 16 + ts, t = row & (SEQ - 1);
        const bf16* pr = proj + (size_t)row * INW + cgp * 8;
        const u32x4 Bv = *(const u32x4*)pr;
        float acc[8];
#pragma unroll
        for (int e = 0; e < 8; ++e) acc[e] = 0.f;
#pragma unroll
        for (int k = 0; k < 3; ++k) { const int dt = 2 - k;
            if (t - dt >= 0) { const bf16* q = pr - (size_t)dt * INW; float ch[8]; unpack8(*(const u32x4*)(q + 256), ch);
#pragma unroll
                for (int e = 0; e < 8; ++e) acc[e] += w[k][e] * ch[e]; } }
        float bb[8]; unpack8(Bv, bb);
#pragma unroll
        for (int e = 0; e < 8; ++e) bb[e] *= acc[e];
        *(u32x4*)(Y + (size_t)row * DM + cgp * 8) = pack8(bb);
    }
}

__device__ __forceinline__ void cf_load(u32x4 (&av)[4], u32x4 (&gv)[4], const bf16* __restrict__ proj, int item, int tid) {
    const int r0 = item * 32, t0 = r0 & (SEQ - 1);
#pragma unroll
    for (int r = 0; r < 4; ++r) { const int idx = tid + 512 * r, rr = idx >> 5, cgp = idx & 31; av[r] = (u32x4){0u, 0u, 0u, 0u}; gv[r] = (u32x4){0u, 0u, 0u, 0u};
        if (idx < 62 * 32 && t0 - 30 + rr >= 0) { const bf16* p = proj + (size_t)(r0 - 30 + rr) * INW + 2304 + cgp * 8; av[r] = *(const u32x4*)p; } }
}
__device__ __forceinline__ void cf_phase(const bf16* __restrict__ proj, bf16* __restrict__ Y, const float* __restrict__ wcc, const float* __restrict__ bcc, const float* __restrict__ gcl, const float* __restrict__ bcl, unsigned char* lds, int bx, int G, int tid, int lane, int wave) {
    float* U = (float*)lds;
    float* CO = (float*)(lds + 62 * 256 * 4);
    const int nitems = MTOK / 32;
    if (bx >= nitems) return;
    u32x4 av[4], gv[4];
    cf_load(av, gv, proj, bx, tid);
    for (int item = bx; item < nitems; item += G) {
        const int r0 = item * 32;
#pragma unroll
        for (int r = 0; r < 4; ++r) { const int idx = tid + 512 * r, rr = idx >> 5, cgp = idx & 31;
            if (idx < 62 * 32) { float u[8]; unpack8(av[r], u);
                *(f32x4*)(U + rr * 256 + cgp * 8) = (f32x4){u[0], u[1], u[2], u[3]}; *(f32x4*)(U + rr * 256 + cgp * 8 + 4) = (f32x4){u[4], u[5], u[6], u[7]}; } }
        __syncthreads();
        if (item + G < nitems) cf_load(av, gv, proj, item + G, tid);
        {
            const int ch = tid & 255, half = tid >> 8;
            float w[31];
#pragma unroll
            for (int k = 0; k < 31; ++k) w[k] = wcc[k * 256 + ch];
            float uu[46];
#pragma unroll
            for (int i = 0; i < 46; ++i) uu[i] = U[(half * 16 + i) * 256 + ch];
            const float bias = bcc[ch];
#pragma unroll
            for (int tt = 0; tt < 16; ++tt) { float acc = bias;
#pragma unroll
                for (int k = 0; k < 31; ++k) acc += w[k] * uu[tt + k];
                CO[(half * 16 + tt) * 256 + ch] = acc; }
        }
        __syncthreads();
        {
            const f32x4 g4 = *(const f32x4*)(gcl + lane * 4), b4 = *(const f32x4*)(bcl + lane * 4);
#pragma unroll
            for (int i = 0; i < 4; ++i) { const int tl = wave * 4 + i;
                const f32x4 v = *(const f32x4*)(CO + tl * 256 + lane * 4);
                const float mean = wave_sum((v.x + v.y) + (v.z + v.w)) * (1.f / 256.f);
                const f32x4 d = v - mean;
                const float var = wave_sum((d.x * d.x + d.y * d.y) + (d.z * d.z + d.w * d.w)) * (1.f / 256.f);
                const float rstd = rsqrtf(var + 1e-6f);
                f32x4 y = d * rstd * g4 + b4;
                y.x = y.x / (1.f + __expf(-y.x)); y.y = y.y / (1.f + __expf(-y.y)); y.z = y.z / (1.f + __expf(-y.z)); y.w = y.w / (1.f + __expf(-y.w));
                u32x2 w2; w2.x = pk2(y.x, y.y); w2.y = pk2(y.z, y.w);
                *(u32x2*)(Y + (size_t)(r0 + tl) * DM + 768 + lane * 4) = w2; }
        }
        __syncthreads();
    }
}

constexpr float C2 = 0.125f * 1.4426950408889634f;
__device__ __forceinline__ void prep_item(const bf16* __restrict__ proj, bf16* __restrict__ qk2, const int* __restrict__ positions, const float* gq, const float* gk, float* kmean, unsigned char* lds, int item, int tid) {
    f32x2* cs = (f32x2*)lds;
    float* kacc = (float*)(lds + 4096);
    const int b = item >> 5, n = item & 31;
    const int g = tid >> 3, j = tid & 7, tk = g >> 2, h = g & 3;
    if (tid < 256) kacc[tid] = 0.f;
    float gqv[8], gkv[8], ksum[8];
#pragma unroll
    for (int e = 0; e < 8; ++e) { gqv[e] = gq[8 * j + e]; gkv[e] = gk[8 * j + e]; ksum[e] = 0.f; }
    const int f_t = tid & 31, tk_t = tid >> 5;
    const float inv_freq = expf((-9.210340371976184f * (float)f_t) / 32.0f);
    for (int p = 0; p < 16; ++p) {
        const int rowb = b * SEQ + n * 256 + p * 16;
        { const int pos = positions[rowb + tk_t]; const float ang = (float)pos * inv_freq;
          double rev = (double)ang * 0.15915494309189535; rev -= floor(rev); const float rf = (float)rev;
          cs[tk_t * 32 + f_t] = (f32x2){__builtin_amdgcn_cosf(rf), __builtin_amdgcn_sinf(rf)}; }
        __syncthreads();
#pragma unroll
        for (int which = 0; which < 2; ++which) {
            const bf16* ptr = proj + (size_t)(rowb + tk) * INW + (which ? 1792 : 1536) + h * 64 + j * 8;
            bf16* optr = qk2 + (size_t)(rowb + tk) * QKP + which * 256 + h * 64 + j * 8;
            float v[8]; unpack8(*(const u32x4*)ptr, v);
            float ss = 0.f;
#pragma unroll
            for (int e = 0; e < 8; ++e) ss += v[e] * v[e];
            ss += __shfl_xor(ss, 1); ss += __shfl_xor(ss, 2); ss += __shfl_xor(ss, 4);
            const float rstd = rsqrtf(ss * (1.f / 64.f) + 1e-6f);
            float o[8];
#pragma unroll
            for (int e = 0; e < 8; ++e) { const float y = v[e] * rstd * (which ? gkv[e] : gqv[e]); const float pt = __shfl_xor(y, 4); const f32x2 c = cs[tk * 32 + ((8 * j + e) & 31)];
                o[e] = (j < 4) ? (y * c.x - pt * c.y) : (y * c.x + pt * c.y); }
            if (which == 0) {
#pragma unroll
                for (int e = 0; e < 8; ++e) o[e] *= C2;
            } else {
#pragma unroll
                for (int e = 0; e < 8; ++e) ksum[e] += o[e];
            }
            *(u32x4*)optr = pack8(o);
        }
        __syncthreads();
    }
#pragma unroll
    for (int e = 0; e < 8; ++e) atomicAdd(&kacc[h * 64 + 8 * j + e], ksum[e]);
    __syncthreads();
    if (tid < 256) kmean[((size_t)(b * 4 + (tid >> 6)) * 32 + n) * 64 + (tid & 63)] = kacc[tid] * (1.f / 256.f);
    __syncthreads();
}

__device__ __forceinline__ void kmean_item(const bf16* __restrict__ qk2, float* __restrict__ kmean, unsigned char* lds, int item, int tid) {
    float* kacc = (float*)lds;
    const int b = item >> 5, n = item & 31, cg = tid & 31, rg = tid >> 5;
    if (tid < 256) kacc[tid] = 0.f;
    __syncthreads();
    float sm[8];
#pragma unroll
    for (int e = 0; e < 8; ++e) sm[e] = 0.f;
    const bf16* p = qk2 + (size_t)(b * SEQ + n * 256 + rg) * QKP + 256 + cg * 8;
#pragma unroll 8
    for (int i = 0; i < 16; ++i) { float v[8]; unpack8(*(const u32x4*)(p + (size_t)i * 16 * QKP), v);
#pragma unroll
        for (int e = 0; e < 8; ++e) sm[e] += v[e]; }
#pragma unroll
    for (int e = 0; e < 8; ++e) atomicAdd(&kacc[cg * 8 + e], sm[e]);
    __syncthreads();
    if (tid < 256) kmean[((size_t)(b * 4 + (tid >> 6)) * 32 + n) * 64 + (tid & 63)] = kacc[tid] * (1.f / 256.f);
    __syncthreads();
}

#define MFMA32(a, b, c) __builtin_amdgcn_mfma_f32_32x32x16_bf16((a), (b), (c), 0, 0, 0)
__device__ __forceinline__ int kperm(int rho) { return (rho & 19) | ((rho & 4) << 1) | ((rho & 8) >> 1); }
__device__ __forceinline__ constexpr int kidx(int r, int hi) { return (r & 7) + 8 * hi + 16 * (r >> 3); }
__device__ __forceinline__ constexpr int crow(int r, int hi) { return (r & 3) + 8 * (r >> 2) + 4 * hi; }
constexpr float NEG = -1e30f;

template <int PITCH = INW> __device__ __forceinline__ void load_k(bf16x8 (&kf)[4], const bf16* Kb, int key0, int lane) {
    const bf16* p = Kb + (size_t)(key0 + kperm(lane & 31)) * PITCH + (lane >> 5) * 8;
#pragma unroll
    for (int kk = 0; kk < 4; ++kk) kf[kk] = *(const bf16x8*)(p + 16 * kk);
}
__device__ __forceinline__ void load_v(bf16x8 (&vf)[4], const bf16* VTb, int key0, int lane) {
    const bf16* p = VTb + (size_t)(lane & 31) * SEQ + key0 + 8 * (lane >> 5);
    vf[0] = *(const bf16x8*)p; vf[1] = *(const bf16x8*)(p + 16); vf[2] = *(const bf16x8*)(p + 32 * SEQ); vf[3] = *(const bf16x8*)(p + 32 * SEQ + 16);
}
template <int PITCH = INW> __device__ __forceinline__ void load_q(bf16x8 (&qf)[4], const bf16* Qrow0, int lane) {
    const bf16* p = Qrow0 + (size_t)(lane & 31) * PITCH + 8 * (lane >> 5);
#pragma unroll
    for (int kk = 0; kk < 4; ++kk) qf[kk] = *(const bf16x8*)(p + 16 * kk);
}
__device__ __forceinline__ void pv_acc(f32x16 (&o)[2], const bf16x8 (&vf)[4], const float (&a)[16]) {
    u32x4 w0, w1;
    w0.x = pk2(a[0], a[1]); w0.y = pk2(a[2], a[3]); w0.z = pk2(a[4], a[5]); w0.w = pk2(a[6], a[7]);
    w1.x = pk2(a[8], a[9]); w1.y = pk2(a[10], a[11]); w1.z = pk2(a[12], a[13]); w1.w = pk2(a[14], a[15]);
    const bf16x8 p0 = __builtin_bit_cast(bf16x8, w0), p1 = __builtin_bit_cast(bf16x8, w1);
    o[0] = MFMA32(vf[0], p0, o[0]); o[0] = MFMA32(vf[1], p1, o[0]);
    o[1] = MFMA32(vf[2], p0, o[1]); o[1] = MFMA32(vf[3], p1, o[1]);
}
__device__ __forceinline__ void store_o_p(bf16* p, const f32x16 (&o)[2], float sc) {
#pragma unroll
    for (int dh = 0; dh < 2; ++dh)
#pragma unroll
        for (int g4 = 0; g4 < 4; ++g4) { u32x2 w; w.x = pk2(o[dh][4 * g4] * sc, o[dh][4 * g4 + 1] * sc); w.y = pk2(o[dh][4 * g4 + 2] * sc, o[dh][4 * g4 + 3] * sc); *(u32x2*)(p + dh * 32 + 8 * g4) = w; }
}
__device__ __forceinline__ void store_o(bf16* Yb, const f32x16 (&o)[2], float sc, int lane) { store_o_p(Yb + (size_t)(lane & 31) * DM + 4 * (lane >> 5), o, sc); }

constexpr float SBSC = 0.125f * 1.4426950408889634f, SBTH = -160.f;
template <bool DIAG> __device__ __forceinline__ void sb_qt(const bf16x8 (&kf)[4], const bf16x8 (&vf)[4], const bf16x8 (&qf)[4], f32x16 (&o)[2], float& carry, int ql, int hi) {
    f32x16 s = {};
#pragma unroll
    for (int kk = 0; kk < 4; ++kk) s = MFMA32(kf[kk], qf[kk], s);
    float L[16], zl[16];
    float lo = 0.f, up = 0.f;
#pragma unroll
    for (int r = 0; r < 16; ++r) { const float z = s[r] * SBSC; const float e = ex2(-fabsf(z)); const float sp = fmaxf(z, 0.f) + lg2(1.f + e);
        const bool valid = !DIAG || (kidx(r, hi) < ql);
        L[r] = valid ? -sp : 0.f; zl[r] = valid ? (z - sp) : -INFINITY;
        if (r < 8) lo += L[r]; else up += L[r]; }
    const float plo = __shfl_xor(lo, 32), pup = __shfl_xor(up, 32);
    const float offU = hi ? carry : carry + pup;
    const float offL = hi ? (carry + up + pup) : (carry + pup + up + plo);
    carry += (lo + plo) + (up + pup);
    float a[16];
    float run = offU;
#pragma unroll
    for (int r = 15; r >= 8; --r) { a[r] = ex2(zl[r] + run); run += L[r]; }
    run = offL;
#pragma unroll
    for (int r = 7; r >= 0; --r) { a[r] = ex2(zl[r] + run); run += L[r]; }
    pv_acc(o, vf, a);
}
__device__ __forceinline__ void sb_item(const bf16* proj, const bf16* vt, bf16* Y, int bh, int qt, int lane) {
    const int b = bh >> 2, h = bh & 3, hi = lane >> 5, ql = lane & 31, q0r = qt * 32;
    const bf16* Qb = proj + (size_t)b * SEQ * INW + 768 + h * 64;
    const bf16* Kb = proj + (size_t)b * SEQ * INW + 1024 + h * 64;
    const bf16* VTb = vt + (size_t)bh * 64 * SEQ;
    bf16x8 q[4]; load_q(q, Qb + (size_t)q0r * INW, lane);
    f32x16 o[2] = {}; float c = 0.f;
    bf16x8 kf[4], vf[4], kg[4], vg[4];
    load_k(kf, Kb, q0r, lane); load_v(vf, VTb, q0r, lane);
    if (q0r >= 32) { load_k(kg, Kb, q0r - 32, lane); load_v(vg, VTb, q0r - 32, lane); }
    sb_qt<true>(kf, vf, q, o, c, ql, hi);
    for (int key0 = q0r - 32; key0 >= 0; key0 -= 64) {
        if (__all(c < SBTH)) break;
        if (key0 >= 32) { load_k(kf, Kb, key0 - 32, lane); load_v(vf, VTb, key0 - 32, lane); }
        sb_qt<false>(kg, vg, q, o, c, ql, hi);
        if (key0 < 32 || __all(c < SBTH)) break;
        if (key0 >= 64) { load_k(kg, Kb, key0 - 64, lane); load_v(vg, VTb, key0 - 64, lane); }
        sb_qt<false>(kf, vf, q, o, c, ql, hi);
    }
    store_o(Y + (size_t)(b * SEQ + q0r) * DM + 256 + h * 64, o, 1.f, lane);
}

template <int MODE  > __device__ __forceinline__ void mb_qt(const bf16x8 (&kf)[4], const bf16x8 (&vf)[4], const bf16x8 (&qf)[4], f32x16 (&o)[2], float& mref, float& lsum, bool sel, int ql, int hi) {
    f32x16 s = {};
#pragma unroll
    for (int kk = 0; kk < 4; ++kk) s = MFMA32(kf[kk], qf[kk], s);
    if (MODE == 2) {
#pragma unroll
        for (int r = 0; r < 16; ++r) if (kidx(r, hi) > ql) s[r] = NEG;
    }
    float tm = s[0];
#pragma unroll
    for (int r = 1; r < 16; ++r) tm = fmaxf(tm, s[r]);
    tm = fmaxf(tm, __shfl_xor(tm, 32));
    tm = sel ? tm : NEG;
    if (__any(tm > mref + 16.f)) { const float mn = fmaxf(mref, tm), al = ex2(mref - mn); lsum *= al; o[0] *= al; o[1] *= al; mref = mn; }
    const float me = sel ? mref : INFINITY;
    float p[16];
#pragma unroll
    for (int r = 0; r < 16; ++r) { p[r] = ex2(s[r] - me); lsum += p[r]; }
    pv_acc(o, vf, p);
}
__device__ __forceinline__ unsigned topk_mask(const float* km, const bf16x8 (&qf)[4], int own, int lane) {
    const int hi = lane >> 5;
    f32x16 g = {};
#pragma unroll
    for (int kk = 0; kk < 4; ++kk) { const float* kp = km + (lane & 31) * 64 + 16 * kk + 8 * hi; const f32x4 x0 = *(const f32x4*)kp, x1 = *(const f32x4*)(kp + 4);
        u32x4 wh; wh.x = pk2(x0.x, x0.y); wh.y = pk2(x0.z, x0.w); wh.z = pk2(x1.x, x1.y); wh.w = pk2(x1.z, x1.w);
        u32x4 wl; wl.x = pk2(x0.x - bflo(wh.x), x0.y - bfhi(wh.x)); wl.y = pk2(x0.z - bflo(wh.y), x0.w - bfhi(wh.y)); wl.z = pk2(x1.x - bflo(wh.z), x1.y - bfhi(wh.z)); wl.w = pk2(x1.z - bflo(wh.w), x1.w - bfhi(wh.w));
        g = MFMA32(__builtin_bit_cast(bf16x8, wh), qf[kk], g); g = MFMA32(__builtin_bit_cast(bf16x8, wl), qf[kk], g); }
    float gv[16];
#pragma unroll
    for (int r = 0; r < 16; ++r) gv[r] = (crow(r, hi) < own) ? g[r] : NEG;
    unsigned mask = 0u;
#pragma unroll
    for (int round = 0; round < 3; ++round) {
        float bm = gv[0]; int bi = crow(0, hi);
#pragma unroll
        for (int r = 1; r < 16; ++r) if (gv[r] > bm) { bm = gv[r]; bi = crow(r, hi); }
        const float pm = __shfl_xor(bm, 32); const int pi = __shfl_xor(bi, 32);
        const bool takep = (pm > bm) || (pm == bm && pi < bi);
        const float cm = takep ? pm : bm; const int ci = takep ? pi : bi;
        if (cm > -1e29f) mask |= 1u << ci;
#pragma unroll
        for (int r = 0; r < 16; ++r) if (crow(r, hi) == ci) gv[r] = NEG;
    }
    return mask;
}
__device__ __forceinline__ void moba_select(const bf16* proj, const float* kmean, unsigned* QM, unsigned long long* SQ, int bh, int chunk, int lane) {
    const int b = bh >> 2, h = bh & 3, qstart = chunk * 64, own = chunk >> 2;
    const bf16* Qb = proj + (size_t)b * SEQ * QKP + h * 64;
    unsigned m0 = 0u, m1 = 0u;
    if (own > 0) { bf16x8 q0[4], q1[4]; load_q<QKP>(q0, Qb + (size_t)qstart * QKP, lane); load_q<QKP>(q1, Qb + (size_t)(qstart + 32) * QKP, lane);
        m0 = topk_mask(kmean + (size_t)bh * 32 * 64, q0, own, lane); m1 = topk_mask(kmean + (size_t)bh * 32 * 64, q1, own, lane); }
    if (lane < 32) { QM[(size_t)bh * SEQ + qstart + lane] = m0; QM[(size_t)bh * SEQ + qstart + 32 + lane] = m1; }
    unsigned long long mine = 0ull;
#pragma unroll
    for (int n = 0; n < 32; ++n) { const unsigned long long b0 = __ballot((m0 >> n) & 1u) & 0xffffffffull, b1 = __ballot((m1 >> n) & 1u) & 0xffffffffull; const unsigned long long v = b0 | (b1 << 32); if (lane == n) mine = v; }
    if (lane < 32) SQ[((size_t)bh * 128 + chunk) * 32 + lane] = mine;
}
__device__ __forceinline__ int select_nth(unsigned long long m, int r) {
    int pos = 0; unsigned w = (unsigned)m; int c = __popc(w);
    if (r >= c) { r -= c; w = (unsigned)(m >> 32); pos = 32; }
    c = __popc(w & 0xffffu); if (r >= c) { r -= c; w >>= 16; pos += 16; }
    c = __popc(w & 0xffu); if (r >= c) { r -= c; w >>= 8; pos += 8; }
    c = __popc(w & 0xfu); if (r >= c) { r -= c; w >>= 4; pos += 4; }
    c = __popc(w & 3u); if (r >= c) { r -= c; w >>= 2; pos += 2; }
    if (r >= (int)(w & 1u)) pos += 1;
    return pos;
}
__device__ __forceinline__ void moba_past(const bf16* proj, const bf16* vt, const unsigned* QM, const unsigned long long* SQ, bf16* POUT, f32x2* PML, int bh, int w, int lane) {
    const int b = bh >> 2, h = bh & 3, hi = lane >> 5, ql = lane & 31;
    const bf16* Qb = proj + (size_t)b * SEQ * QKP + h * 64;
    const bf16* Kb = proj + (size_t)b * SEQ * QKP + 256 + h * 64;
    const bf16* VTb = vt + (size_t)bh * 64 * SEQ;
    const unsigned long long* sq = SQ + (size_t)bh * 128 * 32;
    int gbase = 0;
    const int c0 = 2 * lane;
    unsigned long long nm0 = (c0 >= 4) ? sq[c0 * 32] : 0ull, nm1 = (c0 + 1 >= 4) ? sq[(c0 + 1) * 32] : 0ull;
    for (int n = 0; n < 31; ++n) {
        const unsigned long long m0 = nm0, m1 = nm1;
        if (n + 1 < 31) { nm0 = (c0 >= 4 * (n + 2)) ? sq[c0 * 32 + n + 1] : 0ull; nm1 = (c0 + 1 >= 4 * (n + 2)) ? sq[(c0 + 1) * 32 + n + 1] : 0ull; }
        const int cA = __popcll(m0), tot = cA + __popcll(m1);
        int incl = tot;
#pragma unroll
        for (int o = 1; o < 64; o <<= 1) { const int t = __shfl_up(incl, o); if (lane >= o) incl += t; }
        const int ex = incl - tot, T = __builtin_amdgcn_readlane(incl, 63);
        const int ntile = (T + 63) >> 6;
        for (int k = (w - gbase) & 63; k < ntile; k += 64) {
            bf16x8 kf[4], vf[4];
            load_k<QKP>(kf, Kb, n * 256, lane);
            const int p0 = 64 * k + ql, p1 = p0 + 32;
            unsigned long long cand = __ballot(tot > 0 && ex < 64 * k + 64 && ex + tot > 64 * k);
            int qi0 = (n + 1) * 256, qi1 = (n + 1) * 256;
            while (cand) {
                const int j = __ffsll((long long)cand) - 1; cand &= cand - 1ull;
                const int exj = __builtin_amdgcn_readlane(ex, j), totj = __builtin_amdgcn_readlane(tot, j), cAj = __builtin_amdgcn_readlane(cA, j);
                const unsigned m0lo = __builtin_amdgcn_readlane((unsigned)m0, j), m0hi = __builtin_amdgcn_readlane((unsigned)(m0 >> 32), j);
                const unsigned m1lo = __builtin_amdgcn_readlane((unsigned)m1, j), m1hi = __builtin_amdgcn_readlane((unsigned)(m1 >> 32), j);
                const unsigned long long mA = ((unsigned long long)m0hi << 32) | m0lo, mB = ((unsigned long long)m1hi << 32) | m1lo;
                if (p0 >= exj && p0 < exj + totj) { int r = p0 - exj; unsigned long long mm = mA; int ch = 2 * j; if (r >= cAj) { r -= cAj; mm = mB; ch += 1; } qi0 = ch * 64 + select_nth(mm, r); }
                if (p1 >= exj && p1 < exj + totj) { int r = p1 - exj; unsigned long long mm = mA; int ch = 2 * j; if (r >= cAj) { r -= cAj; mm = mB; ch += 1; } qi1 = ch * 64 + select_nth(mm, r); }
            }
            const bool valid0 = p0 < T, valid1 = p1 < T;
            const bool two = (64 * k + 32) < T;
            const unsigned qm0 = QM[(size_t)bh * SEQ + qi0], qm1 = QM[(size_t)bh * SEQ + qi1];
            bf16x8 q0[4], q1[4];
            { const bf16* qp0 = Qb + (size_t)qi0 * QKP + 8 * hi; const bf16* qp1 = Qb + (size_t)qi1 * QKP + 8 * hi;
#pragma unroll
              for (int kk = 0; kk < 4; ++kk) { q0[kk] = *(const bf16x8*)(qp0 + 16 * kk); q1[kk] = *(const bf16x8*)(qp1 + 16 * kk); } }
            f32x16 o0[2] = {}, o1[2] = {}; float mr0 = NEG, mr1 = NEG, l0 = 0.f, l1 = 0.f;
            for (int t = 0; t < 8; ++t) {
                if (t > 0) load_k<QKP>(kf, Kb, n * 256 + 32 * t, lane);
                load_v(vf, VTb, n * 256 + 32 * t, lane);
                mb_qt<1>(kf, vf, q0, o0, mr0, l0, true, ql, hi); if (two) mb_qt<1>(kf, vf, q1, o1, mr1, l1, true, ql, hi);
            }
            l0 += __shfl_xor(l0, 32); l1 += __shfl_xor(l1, 32);
            if (valid0) { const int slot = __popc(qm0 & ((1u << n) - 1u)); const size_t pi = ((size_t)bh * SEQ + qi0) * 3 + slot;
                store_o_p(POUT + pi * 64 + 4 * hi, o0, 1.f / l0); if (hi == 0) PML[pi] = (f32x2){mr0, l0}; }
            if (valid1) { const int slot = __popc(qm1 & ((1u << n) - 1u)); const size_t pi = ((size_t)bh * SEQ + qi1) * 3 + slot;
                store_o_p(POUT + pi * 64 + 4 * hi, o1, 1.f / l1); if (hi == 0) PML[pi] = (f32x2){mr1, l1}; }
        }
        gbase += ntile;
    }
}
__device__ __forceinline__ void moba_own(const bf16* proj, const bf16* vt, const bf16* POUT, const f32x2* PML, bf16* Y, int bh, int qt, int lane) {
    const int b = bh >> 2, h = bh & 3, hi = lane >> 5, ql = lane & 31, q0r = qt * 32, own = qt >> 3;
    const bf16* Qb = proj + (size_t)b * SEQ * QKP + h * 64;
    const bf16* Kb = proj + (size_t)b * SEQ * QKP + 256 + h * 64;
    const bf16* VTb = vt + (size_t)bh * 64 * SEQ;
    bf16x8 q[4]; load_q<QKP>(q, Qb + (size_t)q0r * QKP, lane);
    f32x16 o[2] = {}; float mref = NEG, lsum = 0.f;
    bf16x8 kf[4], vf[4], kg[4], vg[4];
    load_k<QKP>(kf, Kb, q0r, lane); load_v(vf, VTb, q0r, lane);
    const int kb0 = own * 256;
    if (kb0 < q0r) { load_k<QKP>(kg, Kb, kb0, lane); load_v(vg, VTb, kb0, lane); }
    mb_qt<2>(kf, vf, q, o, mref, lsum, true, ql, hi);
    for (int key0 = kb0; key0 < q0r; key0 += 64) {
        if (key0 + 32 < q0r) { load_k<QKP>(kf, Kb, key0 + 32, lane); load_v(vf, VTb, key0 + 32, lane); }
        mb_qt<1>(kg, vg, q, o, mref, lsum, true, ql, hi);
        if (key0 + 32 >= q0r) break;
        if (key0 + 64 < q0r) { load_k<QKP>(kg, Kb, key0 + 64, lane); load_v(vg, VTb, key0 + 64, lane); }
        mb_qt<1>(kf, vf, q, o, mref, lsum, true, ql, hi);
    }
    lsum += __shfl_xor(lsum, 32);
    const int ns = own < 3 ? own : 3;
    const size_t pi = ((size_t)bh * SEQ + q0r + ql) * 3;
    f32x2 ml[3]; float M = mref;
#pragma unroll
    for (int s = 0; s < 3; ++s) { ml[s] = (f32x2){NEG, 0.f}; if (s < ns) { ml[s] = PML[pi + s]; M = fmaxf(M, ml[s].x); } }
    const float wown = ex2(mref - M); float den = lsum * wown;
    o[0] *= wown; o[1] *= wown;
#pragma unroll
    for (int s = 0; s < 3; ++s) if (s < ns) { const float wsl = ml[s].y * ex2(ml[s].x - M); den += wsl; const bf16* ps = POUT + (pi + s) * 64 + 4 * hi;
#pragma unroll
        for (int dh = 0; dh < 2; ++dh)
#pragma unroll
            for (int g4 = 0; g4 < 4; ++g4) { const u32x2 v = *(const u32x2*)(ps + dh * 32 + 8 * g4);
                o[dh][4 * g4] += wsl * bflo(v.x); o[dh][4 * g4 + 1] += wsl * bfhi(v.x); o[dh][4 * g4 + 2] += wsl * bflo(v.y); o[dh][4 * g4 + 3] += wsl * bfhi(v.y); } }
    store_o(Y + (size_t)(b * SEQ + q0r) * DM + 512 + h * 64, o, 1.f / den, lane);
}

#define XB_TMO      128
#define XB_XCNT(j)  (256  + 64 * (j))
#define XB_XSUB(j)  (1280 + 64 * (j))
#define XB_XGEN(j)  (2304 + 64 * (j))
#define XB_TOP      3328
#define XB_TOPGEN   3392
#define XCD_BAR_WORDS 3456
#define XB_SPIN_CAP (1u << 18)

__device__ __forceinline__ unsigned xb_ld(unsigned* p)              { return __hip_atomic_load(p, __ATOMIC_RELAXED, __HIP_MEMORY_SCOPE_AGENT); }
__device__ __forceinline__ unsigned xb_add(unsigned* p, unsigned v) { return __hip_atomic_fetch_add(p, v, __ATOMIC_RELAXED, __HIP_MEMORY_SCOPE_AGENT); }
__device__ __forceinline__ unsigned xb_xcc_id() { return (unsigned)__builtin_amdgcn_s_getreg((3 << 11) | 20) & 0xFu; }
#define XB_SPIN(cond, bar) do { unsigned _sp = 0; while (cond) { __builtin_amdgcn_s_sleep(1); \
    if ((++_sp & 255u) == 0u) { if (xb_ld(&(bar)[XB_TMO])) break; if (_sp > XB_SPIN_CAP) { atomicAdd(&(bar)[XB_TMO], 1u); break; } } } } while (0)

struct XcdBarrier {
    unsigned* bar; unsigned x;
    volatile LAS unsigned* st;
};

__device__ __forceinline__ XcdBarrier xcd_barrier_post(unsigned* bar, volatile LAS unsigned* st, bool t0) {
    XcdBarrier b; b.bar = bar; b.x = xb_xcc_id(); b.st = st;
    if (t0) (void)xb_add(&bar[XB_XCNT(b.x)], 1u);
    return b;
}
__device__ __forceinline__ void xcd_barrier_complete(unsigned* bar, unsigned x, unsigned& nloc, unsigned& nx) {
    const unsigned G = gridDim.x * gridDim.y * gridDim.z;
    unsigned sum, cnt, mine, sp = 0u;
    for (;;) {
        sum = 0u; cnt = 0u; mine = 0u;
#pragma unroll
        for (unsigned j = 0; j < 16; ++j) { const unsigned c = xb_ld(&bar[XB_XCNT(j)]); sum += c; cnt += (c > 0u) ? 1u : 0u; mine = (j == x) ? c : mine; }
        if (sum == G) break;
        __builtin_amdgcn_s_sleep(1);
        if ((++sp & 255u) == 0u) { if (xb_ld(&bar[XB_TMO])) break; if (sp > XB_SPIN_CAP) { atomicAdd(&bar[XB_TMO], 1u); break; } }
    }
    nloc = mine > 0u ? mine : 1u; nx = cnt > 0u ? cnt : 1u;
}

__device__ __forceinline__ void xcd_barrier(const XcdBarrier& b, bool t0) {
    asm volatile("s_waitcnt vmcnt(0)" ::: "memory");
    __syncthreads();
    if (t0) {
        unsigned* bar = b.bar; unsigned bx_ = __builtin_amdgcn_readfirstlane(b.x); asm volatile("" : "+s"(bx_));
        __builtin_amdgcn_s_waitcnt(0);
        unsigned nloc = b.st[0], nx = b.st[1];
        if (nloc == 0u) { xcd_barrier_complete(bar, bx_, nloc, nx); b.st[0] = nloc; b.st[1] = nx; }
        const unsigned old = xb_add(&bar[XB_XSUB(bx_)], 1u);
        const unsigned gen = old / nloc;
        if (old + 1u == (gen + 1u) * nloc) {
            __builtin_amdgcn_fence(__ATOMIC_RELEASE, "agent");
            asm volatile("s_waitcnt vmcnt(0)" ::: "memory");
            const unsigned og = xb_add(&bar[XB_TOP], 1u);
            const unsigned tg = og / nx;
            if (og + 1u == (tg + 1u) * nx) xb_add(&bar[XB_TOPGEN], 1u);
            else XB_SPIN(xb_ld(&bar[XB_TOPGEN]) == tg, bar);
            __builtin_amdgcn_fence(__ATOMIC_ACQUIRE, "agent");
            xb_add(&bar[XB_XGEN(bx_)], 1u);
            asm volatile("s_waitcnt vmcnt(0)" ::: "memory");
        } else {
            XB_SPIN(xb_ld(&bar[XB_XGEN(bx_)]) == gen, bar);
            __builtin_amdgcn_fence(__ATOMIC_ACQUIRE, "agent");
            asm volatile("s_waitcnt vmcnt(0)" ::: "memory");
        }
    }
    __syncthreads();
}
#ifndef STG_B
#define STG_B 8
#endif
#ifndef STG_G
#define STG_G 6
#endif
#ifndef MK_PER_PHASE
#define MK_PER_PHASE 0
#endif
__global__ void __launch_bounds__(NWAVES * 64, 2) hybrid_fwd(Args a) {
    extern __shared__ __attribute__((aligned(16))) unsigned char lds[];
    cg::grid_group grid = cg::this_grid();
    const int G0 = gridDim.x, bx0 = blockIdx.x;
    volatile LAS unsigned* MISC = (volatile LAS unsigned*)((LAS unsigned char*)lds + 131072);
    if (threadIdx.x < 32) MISC[threadIdx.x] = 0u;
    __syncthreads();
    const int wave0 = __builtin_amdgcn_readfirstlane((int)threadIdx.x >> 6);
#define PHASE_IDS int lane; asm volatile("v_mbcnt_lo_u32_b32 %0, -1, 0\n\tv_mbcnt_hi_u32_b32 %0, -1, %0" : "=v"(lane));     int bx = bx0, G = G0; asm volatile("" : "+s"(bx), "+s"(G));   \
    const int wave = wave0; const int tid = wave * 64 + lane; const int gw = bx * NWAVES + wave, NGW = G * NWAVES; const int vcu = (G % 8 == 0) ? (bx % 8) * (G / 8) + bx / 8 : bx; (void)tid; (void)gw; (void)NGW; (void)vcu;
    XcdBarrier bar = xcd_barrier_post((unsigned*)(a.ws + WS_CTL), MISC + 8, threadIdx.x == 0);
#define STAGGER(us) do { const int cohort_ = ((bx >> 3) & 7) >> 1; if (cohort_) { const unsigned long long t0_ = __builtin_amdgcn_s_memrealtime(); const unsigned long long d_ = (unsigned long long)(cohort_ * (us) * 100); \
        while (__builtin_amdgcn_s_memrealtime() - t0_ < d_) __builtin_amdgcn_s_sleep(16); } } while (0)
    unsigned char* ws = a.ws;
    float* mod = (float*)(ws + WS_MOD);
    float* kmean = (float*)(ws + WS_KMEAN);
    bf16* XN = (bf16*)(ws + WS_XN); bf16* Yb = (bf16*)(ws + WS_Y); bf16* PROJ = (bf16*)(ws + WS_PROJ); bf16* HB = (bf16*)(ws + WS_PROJ);
    bf16* VTSB = (bf16*)(ws + WS_VTSB); bf16* VTMB = (bf16*)(ws + WS_VTMB);
    bf16* QK2 = (bf16*)(ws + WS_QK2);
    float* ROWSS = (float*)(ws + WS_ROWSS); float* BIAS2 = (float*)(ws + WS_BIAS2);
    bf16* POUT = (bf16*)(ws + WS_POUT); f32x2* PML = (f32x2*)(ws + WS_PML); unsigned* QM = (unsigned*)(ws + WS_QM); unsigned long long* SQ = (unsigned long long*)(ws + WS_SQ);
    const int lo = a.ph_lo, hi_ = a.ph_hi; (void)lo; (void)hi_;
#if MK_PER_PHASE
#define IN(k) (lo <= (k) && (k) < hi_)
#define SEAM(k) do { if (IN(k) && IN((k) + 1)) grid.sync(); } while (0)
#else
#define IN(k) true
#define SEAM(k) do { unsigned ln_; asm volatile("v_mbcnt_lo_u32_b32 %0, -1, 0\n\tv_mbcnt_hi_u32_b32 %0, -1, %0" : "=v"(ln_)); const bool t0_ = (wave0 == 0) && (ln_ == 0u); xcd_barrier(bar, t0_); } while (0)
#endif

#ifndef NO_P0
    if (IN(0)) { PHASE_IDS for (int i = bx * 512 + tid; i < 3 * MTOK; i += G * 512) ROWSS[MTOK + i] = 0.f;
        p0_prologue(a, lds, tid, lane, wave, bx, G); }
#endif
    if (a.ph_lo < 0) grid.sync();
    SEAM(0);
    for (int l = 0; l < 2; ++l) {
        const int pb = 1 + 9 * l - (l ? 1 : 0);
        const float* mod_l = mod + (size_t)l * 8 * 6144;
        const float* xin = (l == 0) ? a.in[0] : a.out;
        float* bias_in = BIAS2 + (size_t)l * BIAS2_L; float* bias_m1 = bias_in + 8 * INW;
        if (l == 0) {
            if (IN(pb + 0)) { PHASE_IDS
                for (int it = gw; it < 2 * (INW + FF); it += NGW) { const int ll = it / (INW + FF), r = it % (INW + FF); const float* md = mod + (size_t)ll * 8 * 6144; float* bi = BIAS2 + (size_t)ll * BIAS2_L;
                    if (r < INW) bias2_item((const bf16*)(ws + WS_WIN) + (size_t)ll * INW * DM, md, bi, INW, r, lane);
                    else bias2_item((const bf16*)(ws + WS_W1) + (size_t)ll * FF * DM, md + 3 * 1024, bi + 8 * INW, FF, r - INW, lane); }
                norm_phase0(xin, XN, (unsigned short*)(ws + WS_R16), ROWSS, a.in[5], mod_l, 0, gw, NGW, lane); }
            SEAM(pb + 0);
        }
        if (IN(pb + 1)) { PHASE_IDS
            pg8::Gemm g{XN, (const bf16*)(ws + WS_WIN) + (size_t)l * INW * DM, MTOK, INW, DM}; pg8::StaticOrder S; S.init(MTOK, INW, G, bx);
            pg8::EpiProj E{PROJ, INW, VTSB, VTMB, ROWSS + (size_t)(2 * l) * MTOK, bias_in, QK2, (const int*)a.in[2], a.in[12] + l * 64, a.in[13] + l * 64, kmean, (PG8_LAS float*)((PG8_LAS unsigned char*)lds + 131072 + 256)};
            pg8::gemm_phase<pg8::EpiProj, pg8::StaticOrder, true, true>((PG8_LAS unsigned char*)lds, g, S, E, tid);
        }
        SEAM(pb + 1);
        if (IN(pb + 2)) { PHASE_IDS
#ifndef NO_CF
            for (int it = bx; it < 256; it += G) kmean_item(QK2, kmean, lds, it, tid);
            cf_phase(PROJ, Yb, a.in[8] + l * 31 * 256, a.in[9] + l * 256, a.in[10] + l * 256, a.in[11] + l * 256, lds, bx, G, tid, lane, wave);
#endif
#ifndef NO_SC
            for (int it = bx; it < MTOK / 64; it += G) sc_item(PROJ, Yb, a.in[7] + l * 3 * 256, it, tid);
#endif
#ifndef NO_SB
            for (int it = vcu * NWAVES + wave; it < 32 * 256; it += NGW) sb_item(PROJ, VTSB, Yb, it >> 8, it & 255, lane);
#endif
        }
        SEAM(pb + 2);
        if (IN(pb + 3)) { PHASE_IDS
#ifndef NO_MOBA
            for (int it = vcu * NWAVES + wave; it < 32 * 128; it += NGW) moba_select(QK2, kmean, QM, SQ, it >> 7, it & 127, lane);
#endif
        }
        SEAM(pb + 3);
        if (IN(pb + 4)) { PHASE_IDS
#ifndef NO_MOBA
            for (int wi = vcu * NWAVES + wave; wi < 32 * 64; wi += NGW) moba_past(QK2, VTMB, QM, SQ, POUT, PML, wi >> 6, wi & 63, lane);
#endif
        }
        SEAM(pb + 4);
        if (IN(pb + 5)) { PHASE_IDS
#ifndef NO_MOBA
            for (int it = vcu * NWAVES + wave, kq = 0; it < 32 * 256; it += NGW, ++kq) { const int qt = (kq & 1) ? 255 - (it & 255) : (it & 255);
                moba_own(QK2, VTMB, POUT, PML, Yb, it >> 8, qt, lane); }
#endif
        }
        SEAM(pb + 5);
        if (IN(pb + 6)) { PHASE_IDS
            pg8::Gemm g{Yb, (const bf16*)(ws + WS_WOUT) + (size_t)l * DM * DM, MTOK, DM, DM}; pg8::StaticOrder S; S.init(MTOK, DM, G, bx);
            pg8::EpiRes E{(const unsigned short*)(ws + WS_R16), (void*)(ws + WS_R16), mod_l + 2 * 1024, XN, ROWSS + (size_t)(2 * l + 1) * MTOK, a.in[15] + l * DM, mod_l + 4 * 1024, 1};
            pg8::gemm_phase<pg8::EpiRes, pg8::StaticOrder, true, true>((PG8_LAS unsigned char*)lds, g, S, E, tid);
        }
        SEAM(pb + 6);
        if (IN(pb + 7)) { PHASE_IDS
            pg8::Gemm g{XN, (const bf16*)(ws + WS_W1) + (size_t)l * FF * DM, MTOK, FF, DM}; pg8::StaticOrder S; S.init(MTOK, FF, G, bx);
            pg8::EpiRelu2 E{HB, FF, ROWSS + (size_t)(2 * l + 1) * MTOK, bias_m1};
            pg8::gemm_phase<pg8::EpiRelu2, pg8::StaticOrder, true, true>((PG8_LAS unsigned char*)lds, g, S, E, tid);
        }
        SEAM(pb + 7);
        if (IN(pb + 8)) { PHASE_IDS
            pg8::Gemm g{HB, (const bf16*)(ws + WS_W2) + (size_t)l * DM * FF, MTOK, DM, FF}; pg8::StaticOrder S; S.init(MTOK, DM, G, bx);
            pg8::EpiRes E{(const unsigned short*)(ws + WS_R16), (l == 0) ? (void*)(ws + WS_R16) : (void*)a.out, mod_l + 5 * 1024, (l == 0) ? XN : (bf16*)nullptr, ROWSS + (size_t)2 * MTOK, a.in[5] + DM, mod + (size_t)8 * 6144 + 1 * 1024, l == 0};
            pg8::gemm_phase<pg8::EpiRes, pg8::StaticOrder, true, true>((PG8_LAS unsigned char*)lds, g, S, E, tid);
        }
        if (l == 0) SEAM(pb + 8);
    }
#undef IN
#undef SEAM
}

extern "C" void kernel_launch(void* const* d_in, const int* in_sizes, int n_in, void* d_out, int out_size, void* d_ws, size_t ws_size, hipStream_t stream) {
    static int grid = 0;
    if (grid == 0) {
        if (n_in != 18 || out_size != MTOK * DM || ws_size < WS_END) { fprintf(stderr, "kernel_launch: unexpected shapes (n_in %d out %d ws %zu)\n", n_in, out_size, ws_size); grid = -1; return; }
        int dev = 0, cus = 0, per_cu = 0;
        hipGetDevice(&dev); hipDeviceGetAttribute(&cus, hipDeviceAttributeMultiprocessorCount, dev);
        if (hipFuncSetAttribute((const void*)hybrid_fwd, hipFuncAttributeMaxDynamicSharedMemorySize, LDS_BYTES) != hipSuccess) { fprintf(stderr, "kernel_launch: hipFuncSetAttribute failed\n"); grid = -1; return; }
        if (hipOccupancyMaxActiveBlocksPerMultiprocessor(&per_cu, (const void*)hybrid_fwd, NWAVES * 64, LDS_BYTES) != hipSuccess || per_cu < 1) { fprintf(stderr, "kernel_launch: occupancy query says %d\n", per_cu); per_cu = 1; }
        (void)hipGetLastError();
        grid = cus * per_cu;
    }
    if (grid < 0) return;
    if (hipMemsetAsync((char*)d_ws + WS_CTL, 0, CTL_ZERO_BYTES, stream) != hipSuccess) { fprintf(stderr, "kernel_launch: memset failed\n"); return; }
    Args a{};
    for (int i = 0; i < 18; ++i) a.in[i] = (const float*)d_in[i];
    a.out = (float*)d_out; a.ws = (unsigned char*)d_ws;
#if MK_PER_PHASE
    for (int p = 0; p < N_PHASES; ++p) { a.ph_lo = p; a.ph_hi = p + 1; void* args[] = {&a};
        hipError_t e = hipLaunchCooperativeKernel((const void*)hybrid_fwd, dim3(grid), dim3(NWAVES * 64), args, LDS_BYTES, stream);
        if (e != hipSuccess) { fprintf(stderr, "cooperative launch failed (phase %d): %s (grid %d)\n", p, hipGetErrorString(e), grid); break; } }
#else
    a.ph_lo = 0; a.ph_hi = N_PHASES; void* args[] = {&a};
    hipError_t e = hipLaunchCooperativeKernel((const void*)hybrid_fwd, dim3(grid), dim3(NWAVES * 64), args, LDS_BYTES, stream);
    if (e != hipSuccess) fprintf(stderr, "cooperative launch failed: %s (grid %d)\n", hipGetErrorString(e), grid);
#endif
}
```
